# Optimizing an MI355X kernel written in HIP

```python
import math
import jax, jax.numpy as jnp
from jax import lax
import numpy as np

D_MODEL = 1024
BATCH = 4
SEQ = 4096
DEPTH = 1

CTX_LEN = 256
GRID_W = 64
N_MOD = 9
D_FF = ((8 * D_MODEL // 3 + 127) // 128) * 128
NORM_EPS = 1e-6
RW_HEAD_DIM = 64
RW_HEADS = D_MODEL // RW_HEAD_DIM
D_RW = RW_HEADS * RW_HEAD_DIM
W_LORA = 64
A_LORA = 64
G_LORA = 128
LN_X_EPS = 64e-5
DECAY_SCALE = math.exp(-0.5)
D_LRU = D_MODEL
LRU_BLOCKS = 4
LRU_BLOCK = D_LRU // LRU_BLOCKS
LRU_CONV = 4
LRU_C = 8.0
RW_SIZES = (D_RW, D_RW, D_RW, W_LORA, W_LORA, A_LORA, A_LORA, G_LORA)
N_RW_SHIFT = sum(RW_SIZES)
IN_SIZES = (N_RW_SHIFT, D_LRU, D_LRU, D_MODEL, D_MODEL)
N_IN = sum(IN_SIZES)

kernel_name = "hybrid_rwkv7_rglru_prefix_dit_block"


def split_cols(p, sizes):
    idx = np.cumsum(np.array(sizes))[:-1].tolist()
    return jnp.split(p, idx, axis=-1)


def rms_norm(x, g):
    xf = x.astype(jnp.float32)
    y = xf * lax.rsqrt(jnp.mean(xf * xf, axis=-1, keepdims=True) + NORM_EPS)
    return (y * g.astype(jnp.float32)).astype(x.dtype)


def modulate(xn, shift, scale):
    return xn * (1 + scale) + shift


def swiglu(h, wg, wu, wd):
    return (jax.nn.silu(h @ wg) * (h @ wu)) @ wd


def ffn_half_step(h, mod, g, wg, wu, wd):
    shift, scale, gate = mod
    hn = modulate(rms_norm(h, g), shift, scale)
    return h + 0.5 * gate * swiglu(hn, wg, wu, wd)


def shift_seq(p):
    pad = jnp.pad(p, ((0, 0), (1, 1), (0, 0)))
    return 0.5 * (pad[:, :-2] + pad[:, 2:])


def shift_grid(p):
    bsz, t, ch = p.shape
    rows = t // GRID_W
    g = p.reshape(bsz, rows, GRID_W, ch)
    pad = jnp.pad(g, ((0, 0), (1, 1), (1, 1), (0, 0)))
    nb = 0.25 * (pad[:, :-2, 1:-1] + pad[:, 2:, 1:-1] + pad[:, 1:-1, :-2] + pad[:, 1:-1, 2:])
    return nb.reshape(bsz, t, ch)


def depthwise_conv_centred(x, w, b):
    k = w.shape[0]
    left = (k - 1) // 2
    right = k - 1 - left
    ch = x.shape[-1]
    y = lax.conv_general_dilated(
        x.astype(jnp.float32), w.astype(jnp.float32)[:, None, :], window_strides=(1,),
        padding=[(left, right)], dimension_numbers=('NWC', 'WIO', 'NWC'), feature_group_count=ch)
    return y + b.astype(jnp.float32)


def rwkv_step(s, inp):
    r, w, k, v, kk, kka = inp
    sa = jnp.einsum('bhvk,bhk->bhv', s, -kk)
    s = s * w[:, :, None, :] + sa[..., None] * kka[:, :, None, :] + v[..., None] * k[:, :, None, :]
    y = jnp.einsum('bhvk,bhk->bhv', s, r)
    return s, y


def rwkv_scan(r, w, k, v, kk, kka, s0, reverse):
    xs = tuple(jnp.moveaxis(u, 1, 0) for u in (r, w, k, v, kk, kka))
    s_fin, ys = lax.scan(rwkv_step, s0, xs, reverse=reverse)
    return jnp.moveaxis(ys, 0, 1), s_fin


def linear_scan(a, u, h0, reverse):
    def comb(e1, e2):
        a1, b1 = e1
        a2, b2 = e2
        return a1 * a2, a2 * b1 + b2
    if reverse:
        a, u = a[:, ::-1], u[:, ::-1]
    acum, bcum = lax.associative_scan(comb, (a, u), axis=1)
    h = bcum + acum * h0[:, None, :]
    h_fin = h[:, -1]
    if reverse:
        h = h[:, ::-1]
    return h, h_fin


def rwkv_branch(z, s0_f, s0_b, need_out, w0, w_up, a0, a_up, g_up, k_k, k_a, r_k, ln_w, ln_b):
    z = z.astype(jnp.float32)
    r, k, v, wd_f, wd_b, ad_f, ad_b, gd = split_cols(z, RW_SIZES)
    bsz, t = z.shape[0], z.shape[1]
    heads = lambda u: u.reshape(bsz, t, RW_HEADS, RW_HEAD_DIM)
    kk = heads(k * k_k)
    kk = kk / jnp.maximum(jnp.sqrt(jnp.sum(kk * kk, axis=-1, keepdims=True)), 1e-12)
    ys = []
    finals = []
    for d, (wd, ad, s0) in enumerate(((wd_f, ad_f, s0_f), (wd_b, ad_b, s0_b))):
        w = jnp.exp(-DECAY_SCALE * jax.nn.sigmoid(w0[d] + jnp.tanh(wd) @ w_up[d]))
        a = jax.nn.sigmoid(a0[d] + ad @ a_up[d])
        kd = k * (1 + (a - 1) * k_a)
        y, s_fin = rwkv_scan(heads(r), heads(w), heads(kd), heads(v), kk, kk * heads(a), s0, d == 1)
        ys.append(y)
        finals.append(s_fin)
    if not need_out:
        return None, finals
    y = ys[0] + ys[1]
    mu = jnp.mean(y, axis=-1, keepdims=True)
    var = jnp.mean(jnp.square(y - mu), axis=-1, keepdims=True)
    y = ((y - mu) * lax.rsqrt(var + LN_X_EPS)).reshape(bsz, t, D_RW) * ln_w + ln_b
    bonus = jnp.sum(heads(r) * heads(k) * r_k, axis=-1, keepdims=True) * heads(v)
    g = jax.nn.sigmoid(gd) @ g_up
    return (y + bonus.reshape(bsz, t, D_RW)) * g, finals


def lru_branch(xl, gl, h0_f, h0_b, need_out, conv_w, conv_b, lam, wa, ba, wx, bx):
    xc = depthwise_conv_centred(xl, conv_w, conv_b)
    bsz, t = xc.shape[0], xc.shape[1]
    xb = xc.reshape(bsz, t, LRU_BLOCKS, LRU_BLOCK)
    hs = []
    finals = []
    for d, h0 in enumerate((h0_f, h0_b)):
        gate_r = jax.nn.sigmoid(jnp.einsum('btni,nij->btnj', xb, wa[d]).reshape(bsz, t, D_LRU) + ba[d])
        gate_i = jax.nn.sigmoid(jnp.einsum('btni,nij->btnj', xb, wx[d]).reshape(bsz, t, D_LRU) + bx[d])
        log_a = LRU_C * gate_r * jax.nn.log_sigmoid(lam[d])
        a = jnp.exp(log_a)
        u = jnp.sqrt(-jnp.expm1(2 * log_a)) * (gate_i * xc)
        h, h_fin = linear_scan(a, u, h0, d == 1)
        hs.append(h)
        finals.append(h_fin)
    if not need_out:
        return None, finals
    return (hs[0] + hs[1]) * jax.nn.gelu(gl.astype(jnp.float32)), finals


def token_mixer(xn, shift_fn, init, need_out, w_in, rw_mu, rw_w0, rw_w_up, rw_a0, rw_a_up, rw_g_up,
                rw_k_k, rw_k_a, rw_r_k, rw_ln_w, rw_ln_b, w_proj_rw, lru_conv_w, lru_conv_b, lru_lam,
                lru_wa, lru_ba, lru_wx, lru_bx, w_proj_lru, w_out):
    p = xn @ w_in
    p_rw, p_lx, p_lg, p_mrw, p_mlru = split_cols(p, IN_SIZES)
    z = p_rw + (shift_fn(p_rw) - p_rw) * rw_mu
    s_f0, s_b0, h_f0, h_b0 = init
    y_rw, (s_f, s_b) = rwkv_branch(z, s_f0, s_b0, need_out, rw_w0, rw_w_up, rw_a0, rw_a_up, rw_g_up,
                                   rw_k_k, rw_k_a, rw_r_k, rw_ln_w, rw_ln_b)
    y_lru, (h_f, h_b) = lru_branch(p_lx, p_lg, h_f0, h_b0, need_out, lru_conv_w, lru_conv_b, lru_lam,
                                   lru_wa, lru_ba, lru_wx, lru_bx)
    final = (s_f, s_b, h_f, h_b)
    if not need_out:
        return None, final
    merged = (jax.nn.sigmoid(p_mrw) * (y_rw @ w_proj_rw)
              + jax.nn.sigmoid(p_mlru) * (y_lru @ w_proj_lru))
    return merged @ w_out, final


def setup_inputs(seed: int = 0) -> dict:
    key = jax.random.key(seed)
    kit = iter(jax.random.split(key, 48))
    L = DEPTH
    f32 = jnp.float32
    nrm = lambda shape, s: jax.random.normal(next(kit), shape, f32) * s
    uni = lambda shape, lo, hi: jax.random.uniform(next(kit), shape, f32, minval=lo, maxval=hi)
    d = D_MODEL
    u_lam = uni((L, 2, D_LRU), 0.9, 0.999)
    s_lam = u_lam ** (1.0 / LRU_C)
    return {
        "x": nrm((BATCH, SEQ, d), 1.0),
        "c": nrm((BATCH, d), 1.0),
        "ctx": nrm((BATCH, CTX_LEN, d), 1.0),
        "c_ctx": nrm((d,), 1.0),
        "w_mod": nrm((L, d, N_MOD * d), 0.5 * d ** -0.5),
        "b_mod": nrm((L, N_MOD * d), 0.01),
        "g_ffn1": 1.0 + nrm((L, d), 0.02),
        "ffn1_wg": nrm((L, d, D_FF), d ** -0.5),
        "ffn1_wu": nrm((L, d, D_FF), d ** -0.5),
        "ffn1_wd": nrm((L, D_FF, d), D_FF ** -0.5),
        "g_mix": 1.0 + nrm((L, d), 0.02),
        "w_in": nrm((L, d, N_IN), d ** -0.5),
        "rw_mu": uni((L, N_RW_SHIFT), 0.0, 1.0),
        "rw_w0": uni((L, 2, D_RW), -3.0, 1.0),
        "rw_w_up": nrm((L, 2, W_LORA, D_RW), 0.5 * W_LORA ** -0.5),
        "rw_a0": nrm((L, 2, D_RW), 0.5),
        "rw_a_up": nrm((L, 2, A_LORA, D_RW), 0.5 * A_LORA ** -0.5),
        "rw_g_up": nrm((L, G_LORA, D_RW), G_LORA ** -0.5),
        "rw_k_k": 0.85 + nrm((L, D_RW), 0.05),
        "rw_k_a": 1.0 + nrm((L, D_RW), 0.05),
        "rw_r_k": nrm((L, RW_HEADS, RW_HEAD_DIM), 0.1),
        "rw_ln_w": 1.0 + nrm((L, D_RW), 0.02),
        "rw_ln_b": nrm((L, D_RW), 0.01),
        "w_proj_rw": nrm((L, D_RW, d), D_RW ** -0.5),
        "lru_conv_w": nrm((L, LRU_CONV, D_LRU), LRU_CONV ** -0.5),
        "lru_conv_b": nrm((L, D_LRU), 0.01),
        "lru_lam": jnp.log(s_lam) - jnp.log1p(-s_lam),
        "lru_wa": nrm((L, 2, LRU_BLOCKS, LRU_BLOCK, LRU_BLOCK), LRU_BLOCK ** -0.5),
        "lru_ba": nrm((L, 2, D_LRU), 0.01),
        "lru_wx": nrm((L, 2, LRU_BLOCKS, LRU_BLOCK, LRU_BLOCK), LRU_BLOCK ** -0.5),
        "lru_bx": nrm((L, 2, D_LRU), 0.01),
        "w_proj_lru": nrm((L, D_LRU, d), D_LRU ** -0.5),
        "w_out": nrm((L, d, d), d ** -0.5),
        "g_ffn2": 1.0 + nrm((L, d), 0.02),
        "ffn2_wg": nrm((L, d, D_FF), d ** -0.5),
        "ffn2_wu": nrm((L, d, D_FF), d ** -0.5),
        "ffn2_wd": nrm((L, D_FF, d), D_FF ** -0.5),
        "g_final": 1.0 + nrm((d,), 0.02),
    }


def reference(x, c, ctx, c_ctx, w_mod, b_mod, g_ffn1, ffn1_wg, ffn1_wu, ffn1_wd, g_mix, w_in, rw_mu,
              rw_w0, rw_w_up, rw_a0, rw_a_up, rw_g_up, rw_k_k, rw_k_a, rw_r_k, rw_ln_w, rw_ln_b,
              w_proj_rw, lru_conv_w, lru_conv_b, lru_lam, lru_wa, lru_ba, lru_wx, lru_bx, w_proj_lru,
              w_out, g_ffn2, ffn2_wg, ffn2_wu, ffn2_wd, g_final):
    bsz = x.shape[0]
    for l in range(DEPTH):
        last = l == DEPTH - 1
        mod_x = jnp.split((jax.nn.silu(c) @ w_mod[l] + b_mod[l])[:, None, :], N_MOD, axis=-1)
        mod_c = jnp.split((jax.nn.silu(c_ctx) @ w_mod[l] + b_mod[l])[None, None, :], N_MOD, axis=-1)
        x = ffn_half_step(x, mod_x[0:3], g_ffn1[l], ffn1_wg[l], ffn1_wu[l], ffn1_wd[l])
        ctx = ffn_half_step(ctx, mod_c[0:3], g_ffn1[l], ffn1_wg[l], ffn1_wu[l], ffn1_wd[l])
        mixer_params = (w_in[l], rw_mu[l], rw_w0[l], rw_w_up[l], rw_a0[l], rw_a_up[l], rw_g_up[l],
                        rw_k_k[l], rw_k_a[l], rw_r_k[l], rw_ln_w[l], rw_ln_b[l], w_proj_rw[l],
                        lru_conv_w[l], lru_conv_b[l], lru_lam[l], lru_wa[l], lru_ba[l], lru_wx[l],
                        lru_bx[l], w_proj_lru[l], w_out[l])
        zero_state = (jnp.zeros((bsz, RW_HEADS, RW_HEAD_DIM, RW_HEAD_DIM), jnp.float32),
                      jnp.zeros((bsz, RW_HEADS, RW_HEAD_DIM, RW_HEAD_DIM), jnp.float32),
                      jnp.zeros((bsz, D_LRU), jnp.float32),
                      jnp.zeros((bsz, D_LRU), jnp.float32))
        cn = modulate(rms_norm(ctx, g_mix[l]), mod_c[3], mod_c[4])
        ctx_mix, ctx_state = token_mixer(cn, shift_seq, zero_state, not last, *mixer_params)
        xn = modulate(rms_norm(x, g_mix[l]), mod_x[3], mod_x[4])
        x_mix, _ = token_mixer(xn, shift_grid, ctx_state, True, *mixer_params)
        x = x + mod_x[5] * x_mix
        x = ffn_half_step(x, mod_x[6:9], g_ffn2[l], ffn2_wg[l], ffn2_wu[l], ffn2_wd[l])
        if not last:
            ctx = ctx + mod_c[5] * ctx_mix
            ctx = ffn_half_step(ctx, mod_c[6:9], g_ffn2[l], ffn2_wg[l], ffn2_wu[l], ffn2_wd[l])
    return rms_norm(x, g_final)
```

```cpp
#include <hip/hip_runtime.h>
#include <hip/hip_cooperative_groups.h>
#include <cstdio>
#include <cstdint>
namespace cg = cooperative_groups;

#define LAS __attribute__((address_space(3)))
typedef unsigned short bf16_t;
typedef short bf16x8 __attribute__((ext_vector_type(8)));
typedef float f32x4 __attribute__((ext_vector_type(4)));
typedef float f32x2 __attribute__((ext_vector_type(2)));
typedef unsigned u32x4 __attribute__((ext_vector_type(4)));
typedef unsigned u32x2 __attribute__((ext_vector_type(2)));

constexpr int D = 1024, DFF = 2816, MLAT = 16384, MCTX = 1024, MALL = 17408, NMOD = 9216;
constexpr int NTHREADS = 512, LDS_BYTES = 131072;
constexpr size_t MiB = 1048576;
constexpr size_t W0 = 0, W1 = 18 * MiB, SP = 34 * MiB, ACT = 50 * MiB;
constexpr size_t O_UP1 = W0, O_RW = W0, O_LATE = W0, O_PRW = W0 + 6 * MiB, O_PLRU = W0 + 8 * MiB, O_WOUT = W0 + 10 * MiB, O_DN2 = W0 + 12 * MiB;
constexpr size_t O_DN1 = W1 + 10 * MiB, O_LSCW = W1, O_LSCA = W1 + 256 * 1024, O_GUP = W1 + 512 * 1024, O_LX = W1 + 1 * MiB, O_LRUW = W1 + 3 * MiB, O_UP2 = W1;
constexpr size_t O_MOD = SP, O_RN = SP + 256 * 1024, O_CB = O_RN + 1280 * 1024, O_PQ = SP + 3 * MiB, O_CTXX1 = SP + 8 * MiB, O_CL = SP + 12 * MiB, O_BAR = SP + 13 * MiB, O_PLXC = SP + 14 * MiB, O_XCNT_B = SP + 13 * MiB + 16384, O_XCNT_A = SP + 13 * MiB + 32768, O_XSLOT_B = SP + 15 * MiB, O_XSLOT_A = SP + 15 * MiB + 262144, O_XCNT_C = SP + 13 * MiB + 49152, O_XSLOT_C = SP + 15 * MiB + 524288, O_CTXP2 = ACT + 200 * MiB, O_X2B = ACT + 136 * MiB;
constexpr size_t O_HN = ACT, O_U = ACT + 34 * MiB;
constexpr size_t O_XNXS = ACT, O_R = ACT + 68 * MiB, O_K = ACT + 102 * MiB, O_V = ACT + 136 * MiB, O_LIN = ACT + 170 * MiB, O_GD = ACT + 178 * MiB + 512 * 1024;
constexpr size_t O_YF = ACT, O_YB = ACT + 32 * MiB, O_XN2 = ACT + 68 * MiB, O_PLX = ACT + 102 * MiB, O_XC = ACT + 136 * MiB;
constexpr size_t O_GRF = ACT + 32 * MiB, O_UF = ACT + 66 * MiB, O_GRB = ACT + 100 * MiB, O_UB = ACT + 170 * MiB;
constexpr size_t O_HSUM = ACT + 136 * MiB, O_XN3 = ACT + 32 * MiB, O_SMRW = ACT + 66 * MiB, O_SMLRU = ACT + 98 * MiB;
constexpr size_t O_HN2 = ACT, O_U2 = ACT + 34 * MiB;
constexpr size_t WS_NEED = 256 * MiB;

struct Params { const float* in[38]; float* out; unsigned char* ws; };

__device__ __forceinline__ float bf2f(unsigned short b) { return __uint_as_float(((unsigned)b) << 16); }
__device__ __forceinline__ float bflo(unsigned u) { return __uint_as_float(u << 16); }
__device__ __forceinline__ float bfhi(unsigned u) { return __uint_as_float(u & 0xffff0000u); }
typedef __bf16 bf16x2_t __attribute__((ext_vector_type(2)));
__device__ __forceinline__ unsigned pk2(float lo, float hi) { const f32x2 v = {lo, hi}; const bf16x2_t b = __builtin_convertvector(v, bf16x2_t); return __builtin_bit_cast(unsigned, b); }
__device__ __forceinline__ int tidx() { int t = threadIdx.x; asm volatile("" : "+v"(t)); return t; }
__device__ __forceinline__ float frcp(float x) { return __builtin_amdgcn_rcpf(x); }
__device__ __forceinline__ float sigm(float x) { return frcp(1.0f + __expf(-x)); }
__device__ __forceinline__ float tanh_f(float x) { return 1.0f - 2.0f * frcp(__expf(2.0f * x) + 1.0f); }
__device__ __forceinline__ float silu_f(float x) { return x * sigm(x); }
__device__ __forceinline__ float gelu_f(float x) { return x * sigm(1.5957691216f * (x + 0.044715f * x * x * x)); }
__device__ __forceinline__ float wave_sum(float v) {
#pragma unroll
    for (int o = 1; o < 64; o <<= 1) v += __shfl_xor(v, o);
    return v;
}
template <int CTRL> __device__ __forceinline__ float dppf(float v) {
    return __builtin_bit_cast(float, __builtin_amdgcn_update_dpp(0, __builtin_bit_cast(int, v), CTRL, 0xF, 0xF, true));
}
__device__ __forceinline__ float red16(float v) {
    v += dppf<0xB1>(v); v += dppf<0x4E>(v); v += dppf<0x141>(v); v += dppf<0x140>(v); return v;
}

namespace pg8 {
constexpr int BM = 256, BK = 64, HALF = 128, HTB = HALF * BK * 2, NXCD = 8, WGM = 8;
__device__ __forceinline__ int lds_byte(int r, int c) { const int st = (r >> 4) * 2 + (c >> 5), rr = r & 15, cc = c & 31, ob = rr * 64 + cc * 2; return st * 1024 + (ob ^ (((ob >> 9) & 1) << 5)); }
__device__ __forceinline__ void stage_rc(int b, int& R, int& C) { const int st = b / 1024, sb = b % 1024, swz = sb ^ (((sb >> 9) & 1) << 5); R = (st >> 1) * 16 + swz / 64; C = (st & 1) * 32 + (swz % 64) / 2; }
struct Unit { int pm, pn; };
struct Gemm { const bf16_t* A; const bf16_t* Bt; int M, N, K, lda, ldb, ksh, kmask, kmul; };
struct StaticOrder {
    int nM, nN, nwg, G, c;
    __device__ void init(int M, int N, int G_, int c_) { nM = M / BM; nN = N / BM; nwg = nM * nN; G = G_; c = c_; }
    __device__ bool next(int i, Unit& u) const {
        const long L = (long)i * G + c; if (L >= nwg) return false;
        int wgid = (int)L; { const int q = nwg / NXCD, r = nwg % NXCD, xcd = wgid % NXCD, off = wgid / NXCD; wgid = (xcd < r ? xcd * (q + 1) : r * (q + 1) + (xcd - r) * q) + off; }
        const int nig = WGM * nN, gid = wgid / nig, fm = gid * WGM, gsz = (nM - fm) < WGM ? (nM - fm) : WGM;
        u.pm = fm + ((wgid % nig) % gsz); u.pn = (wgid % nig) / gsz; return true;
    }
};

template <class E, class = void> struct is_ad { static constexpr bool value = false; };
template <class E> struct is_ad<E, decltype((void)E::AFTER_DRAIN)> { static constexpr bool value = true; };

template <class Epi>
__device__ __forceinline__ void gemm_phase(LAS unsigned char* lds, const Gemm g, const StaticOrder& S, const Epi& E) {
    const int tid = tidx(), wid = __builtin_amdgcn_readfirstlane(tid >> 6), lane = tid & 63, wr = wid >> 2, wc = wid & 3, fr = lane & 15, fq = lane >> 4;
    const int K = g.K, nt = K / BK;
    unsigned voffA[2], voffB[2];
#pragma unroll
    for (int i = 0; i < 2; ++i) { int R, C; stage_rc(tid * 16 + i * 8192, R, C);
        voffA[i] = (unsigned)(R * g.lda + C) * 2u; voffB[i] = (unsigned)(R * g.ldb + C) * 2u; }
    const size_t kstep = (size_t)(BK * 2);
    const size_t hstepA = (size_t)HALF * g.lda * 2, hstepB = (size_t)HALF * g.ldb * 2;
    const size_t tstepA = 2 * hstepA, tstepB = 2 * hstepB;
    const unsigned ldsw = (unsigned)wid * 1024u;
    const int aoff = lds_byte(wr * 64 + fr, fq * 8), boff = lds_byte(wc * 32 + fr, fq * 8);
#define PG8_SA(b, h) (((b) * 2 + (h)) * HTB)
#define PG8_SB(b, h) ((4 + (b) * 2 + (h)) * HTB)
#define PG8_STAGE(bufoff, gbase, voff) do { _Pragma("unroll") for (int _i = 0; _i < 2; ++_i) \
        __builtin_amdgcn_global_load_lds((const unsigned*)((const char*)(gbase) + (voff)[_i]), (LAS unsigned*)(lds + (bufoff) + ldsw + _i * 8192), 16, 0, 0); } while (0)
#define PG8_LDA(dst, b, h) do { _Pragma("unroll") for (int m = 0; m < 4; ++m) _Pragma("unroll") for (int k = 0; k < 2; ++k) dst[m][k] = *(const LAS bf16x8*)(lds + PG8_SA(b, h) + aoff + m * 2048 + k * 1024); } while (0)
#define PG8_LDB(dst, b, h) do { _Pragma("unroll") for (int n = 0; n < 2; ++n) _Pragma("unroll") for (int k = 0; k < 2; ++k) dst[n][k] = *(const LAS bf16x8*)(lds + PG8_SB(b, h) + boff + n * 2048 + k * 1024); } while (0)
#define PG8_MMA(ai, bj, At, Bt) do { __builtin_amdgcn_s_setprio(1); _Pragma("unroll") for (int m = 0; m < 4; ++m) _Pragma("unroll") for (int n = 0; n < 2; ++n) _Pragma("unroll") for (int k = 0; k < 2; ++k) \
        acc[ai][bj][m][n] = __builtin_amdgcn_mfma_f32_16x16x32_bf16(Bt[n][k], At[m][k], acc[ai][bj][m][n], 0, 0, 0); __builtin_amdgcn_s_setprio(0); } while (0)
#define PG8_WAIT_V(n) asm volatile("s_waitcnt vmcnt(" #n ")" ::: "memory")
#define PG8_WAIT_L(n) asm volatile("s_waitcnt lgkmcnt(" #n ")" ::: "memory")
#define PG8_BAR __builtin_amdgcn_s_barrier()
#define PG8_SCHED __builtin_amdgcn_sched_barrier(0)
#define PG8_KOFF(u) ((size_t)((((u).pn >> g.ksh) & g.kmask) * g.kmul) * 2)
    Unit cur, nxt; int ui = 0;
    if (!S.next(0, cur)) return;
    f32x4 acc[2][2][4][2];
#pragma unroll
    for (int a = 0; a < 2; ++a)
#pragma unroll
        for (int b = 0; b < 2; ++b)
#pragma unroll
            for (int m = 0; m < 4; ++m)
#pragma unroll
                for (int n = 0; n < 2; ++n) acc[a][b][m][n] = (f32x4){0.f, 0.f, 0.f, 0.f};
    bf16x8 At[4][2], B0[2][2], B1[2][2];
    const char* cA = (const char*)g.A + (size_t)cur.pm * tstepA + PG8_KOFF(cur); const char* cB = (const char*)g.Bt + (size_t)cur.pn * tstepB;
    PG8_STAGE(PG8_SB(0, 0), cB, voffB); PG8_STAGE(PG8_SA(0, 0), cA, voffA); PG8_STAGE(PG8_SB(0, 1), cB + hstepB, voffB); PG8_STAGE(PG8_SA(0, 1), cA + hstepA, voffA);
    if (wr == 1) PG8_BAR;
    PG8_WAIT_V(4); PG8_BAR;
    PG8_STAGE(PG8_SB(1, 0), cB + kstep, voffB); PG8_STAGE(PG8_SA(1, 0), cA + kstep, voffA); PG8_STAGE(PG8_SB(1, 1), cB + hstepB + kstep, voffB);
    PG8_WAIT_V(6); PG8_BAR;
    for (;;) {
        const bool has_next = S.next(ui + 1, nxt);
        const char* nA = has_next ? (const char*)g.A + (size_t)nxt.pm * tstepA + PG8_KOFF(nxt) : cA; const char* nB = has_next ? (const char*)g.Bt + (size_t)nxt.pn * tstepB : cB;
        for (int t = 0; t < nt; t += 2) {
            const bool last = (t == nt - 2);
            const char* a1 = cA + (size_t)(t + 1) * kstep;
            const char* a2 = last ? nA : cA + (size_t)(t + 2) * kstep; const char* b2 = last ? nB : cB + (size_t)(t + 2) * kstep;
            const char* a3 = a2 + kstep; const char* b3 = b2 + kstep;
            PG8_LDB(B0, 0, 0); PG8_SCHED; PG8_LDA(At, 0, 0); PG8_STAGE(PG8_SA(1, 1), a1 + hstepA, voffA);
            PG8_WAIT_L(8); PG8_BAR; PG8_WAIT_L(0); PG8_MMA(0, 0, At, B0); PG8_BAR; PG8_SCHED;
            PG8_LDB(B1, 0, 1); PG8_STAGE(PG8_SB(0, 0), b2, voffB);
            PG8_BAR; PG8_WAIT_L(0); PG8_MMA(0, 1, At, B1); PG8_BAR;
            PG8_LDA(At, 0, 1); PG8_STAGE(PG8_SA(0, 0), a2, voffA);
            PG8_BAR; PG8_WAIT_L(0); PG8_MMA(1, 0, At, B0); PG8_BAR; PG8_SCHED;
            PG8_STAGE(PG8_SB(0, 1), b2 + hstepB, voffB);
            PG8_WAIT_V(6); PG8_BAR; PG8_MMA(1, 1, At, B1); PG8_BAR;
            PG8_LDB(B0, 1, 0); PG8_SCHED; PG8_LDA(At, 1, 0); PG8_STAGE(PG8_SA(0, 1), a2 + hstepA, voffA);
            PG8_WAIT_L(8); PG8_BAR; PG8_WAIT_L(0); PG8_MMA(0, 0, At, B0); PG8_BAR; PG8_SCHED;
            PG8_LDB(B1, 1, 1); PG8_STAGE(PG8_SB(1, 0), b3, voffB);
            PG8_BAR; PG8_WAIT_L(0); PG8_MMA(0, 1, At, B1); PG8_BAR;
            PG8_LDA(At, 1, 1); PG8_STAGE(PG8_SA(1, 0), a3, voffA);
            PG8_BAR; PG8_WAIT_L(0); PG8_MMA(1, 0, At, B0); PG8_BAR; PG8_SCHED;
            PG8_STAGE(PG8_SB(1, 1), b3 + hstepB, voffB);
            PG8_WAIT_V(6); PG8_BAR; PG8_MMA(1, 1, At, B1); PG8_BAR;
        }
        if constexpr (!is_ad<Epi>::value) E(acc, cur, wr, wc, fr, fq);
        if (!has_next) break;
#pragma unroll
        for (int a = 0; a < 2; ++a)
#pragma unroll
            for (int b = 0; b < 2; ++b)
#pragma unroll
                for (int m = 0; m < 4; ++m)
#pragma unroll
                    for (int n = 0; n < 2; ++n) acc[a][b][m][n] = (f32x4){0.f, 0.f, 0.f, 0.f};
        cur = nxt; cA = nA; cB = nB; ++ui;
    }
    PG8_WAIT_V(0);
    if (wr == 0) PG8_BAR;
    PG8_BAR;
    if constexpr (is_ad<Epi>::value) E.fused(acc, cur, wr, wc, fr, fq, lds, wid, lane);
#undef PG8_SA
#undef PG8_SB
#undef PG8_STAGE
#undef PG8_LDA
#undef PG8_LDB
#undef PG8_MMA
#undef PG8_WAIT_V
#undef PG8_WAIT_L
#undef PG8_BAR
#undef PG8_SCHED
#undef PG8_KOFF
}
}
using pg8::Unit;
using pg8::Gemm;

#define EPI_ROWS(...) _Pragma("unroll") for (int ai = 0; ai < 2; ++ai) _Pragma("unroll") for (int m = 0; m < 4; ++m) { const int row = u.pm * 256 + ai * 128 + wr * 64 + m * 16 + fr; __VA_ARGS__ }
#define EPI_ALL(...) _Pragma("unroll") for (int ai = 0; ai < 2; ++ai) _Pragma("unroll") for (int m = 0; m < 4; ++m) _Pragma("unroll") for (int bj = 0; bj < 2; ++bj) _Pragma("unroll") for (int n = 0; n < 2; ++n) { \
        const int row = u.pm * 256 + ai * 128 + wr * 64 + m * 16 + fr; __VA_ARGS__ }
typedef const f32x4 (&AccRef)[2][2][4][2];

struct EpiUp {
    bf16_t* U;
    __device__ __forceinline__ void operator()(AccRef acc, const Unit& u, int wr, int wc, int fr, int fq) const {
        EPI_ROWS(
            _Pragma("unroll") for (int bj = 0; bj < 2; ++bj) {
                const f32x4 g = acc[ai][bj][m][0], v = acc[ai][bj][m][1];
                const int f0 = ((u.pn * 256 + bj * 128 + wc * 32) >> 1) + 4 * fq;
                u32x2 o; o.x = pk2(silu_f(g[0]) * v[0], silu_f(g[1]) * v[1]); o.y = pk2(silu_f(g[2]) * v[2], silu_f(g[3]) * v[3]);
                *(u32x2*)(U + (size_t)row * DFF + f0) = o; }
        )
    }
};
template <bool RB, bool OB> struct EpiRes {
    const float* res_f; const bf16_t* res_b; float* out_f; bf16_t* out_b; const float* mod; int gidx; float scale;
    __device__ __forceinline__ void operator()(AccRef acc, const Unit& u, int wr, int wc, int fr, int fq) const {
        u32x2 tv[2][4][2][2];
        if constexpr (RB) { EPI_ALL( const int col = u.pn * 256 + bj * 128 + wc * 32 + n * 16 + 4 * fq; tv[ai][m][bj][n] = *(const u32x2*)(res_b + (size_t)row * D + col); ) }
        EPI_ROWS(
            const float* gp = mod + (size_t)(row >> 12) * NMOD + gidx * D;
            _Pragma("unroll") for (int bj = 0; bj < 2; ++bj) _Pragma("unroll") for (int n = 0; n < 2; ++n) {
                const int col = u.pn * 256 + bj * 128 + wc * 32 + n * 16 + 4 * fq; const size_t off = (size_t)row * D + col;
                f32x4 r;
                if constexpr (RB) { const u32x2 t = tv[ai][m][bj][n]; r = (f32x4){bflo(t.x), bfhi(t.x), bflo(t.y), bfhi(t.y)}; } else r = *(const f32x4*)(res_f + off);
                const f32x4 gt = *(const f32x4*)(gp + col);
                const f32x4 o = r + scale * gt * acc[ai][bj][m][n];
                if constexpr (OB) { u32x2 w; w.x = pk2(o[0], o[1]); w.y = pk2(o[2], o[3]); *(u32x2*)(out_b + off) = w; } else *(f32x4*)(out_f + off) = o; }
        )
    }
};
struct EpiCtx {
    const float* res; float* out; const float* gate; float scale;
    __device__ __forceinline__ void operator()(AccRef acc, const Unit& u, int wr, int wc, int fr, int fq) const {
        EPI_ROWS(
            _Pragma("unroll") for (int bj = 0; bj < 2; ++bj) _Pragma("unroll") for (int n = 0; n < 2; ++n) {
                const int col = u.pn * 256 + bj * 128 + wc * 32 + n * 16 + 4 * fq; const size_t off = (size_t)row * D + col;
                const f32x4 gt = *(const f32x4*)(gate + col); f32x4 r = (f32x4){0.f, 0.f, 0.f, 0.f};
                if (res) r = *(const f32x4*)(res + off);
                *(f32x4*)(out + off) = r + scale * gt * acc[ai][bj][m][n]; }
        )
    }
};
struct EpiRw {
    bf16_t *RKV, *LIN, *GD;
    __device__ __forceinline__ void operator()(AccRef acc, const Unit& u, int wr, int wc, int fr, int fq) const {
        const int pn = u.pn;
        if (pn < 12) {
            bf16_t* base = RKV + (size_t)(pn >> 2) * ((size_t)MALL * D) + (pn & 3) * 256;
            EPI_ROWS(
                _Pragma("unroll") for (int bj = 0; bj < 2; ++bj) _Pragma("unroll") for (int n = 0; n < 2; ++n) {
                    const int cl = bj * 128 + wc * 32 + n * 16 + 4 * fq; const f32x4 a = acc[ai][bj][m][n];
                    u32x2 o; o.x = pk2(a[0], a[1]); o.y = pk2(a[2], a[3]);
                    *(u32x2*)(base + (size_t)row * D + cl) = o; }
            )
        } else if (pn == 12) {
            EPI_ROWS(
                _Pragma("unroll") for (int bj = 0; bj < 2; ++bj) _Pragma("unroll") for (int n = 0; n < 2; ++n) {
                    const int cl = bj * 128 + wc * 32 + n * 16 + 4 * fq; f32x4 a = acc[ai][bj][m][n];
                    if (bj == 0) { a[0] = tanh_f(a[0]); a[1] = tanh_f(a[1]); a[2] = tanh_f(a[2]); a[3] = tanh_f(a[3]); }
                    u32x2 o; o.x = pk2(a[0], a[1]); o.y = pk2(a[2], a[3]);
                    *(u32x2*)(LIN + (size_t)row * 256 + cl) = o; }
            )
        } else {
            EPI_ROWS(
                _Pragma("unroll") for (int bj = 0; bj < 2; ++bj) _Pragma("unroll") for (int n = 0; n < 2; ++n) {
                    const int cl = bj * 128 + wc * 32 + n * 16 + 4 * fq; const f32x4 a = acc[ai][bj][m][n];
                    u32x2 o; o.x = 0u; o.y = 0u;
                    if (bj == 0) { o.x = pk2(sigm(a[0]), sigm(a[1])); o.y = pk2(sigm(a[2]), sigm(a[3])); }
                    *(u32x2*)(GD + (size_t)row * 256 + cl) = o; }
            )
        }
    }
};
struct EpiBf {
    bf16_t* O; int ldo;
    __device__ __forceinline__ void operator()(AccRef acc, const Unit& u, int wr, int wc, int fr, int fq) const {
        EPI_ROWS(
            _Pragma("unroll") for (int bj = 0; bj < 2; ++bj) _Pragma("unroll") for (int n = 0; n < 2; ++n) {
                const int col = u.pn * 256 + bj * 128 + wc * 32 + n * 16 + 4 * fq; const f32x4 a = acc[ai][bj][m][n];
                u32x2 o; o.x = pk2(a[0], a[1]); o.y = pk2(a[2], a[3]);
                *(u32x2*)(O + (size_t)row * ldo + col) = o; }
        )
    }
};
struct EpiMul {
    bf16_t* T; const bf16_t* S2; int mode;
    __device__ __forceinline__ void operator()(AccRef acc, const Unit& u, int wr, int wc, int fr, int fq) const {
        u32x2 tv[2][4][2][2];
        EPI_ALL( const int col = u.pn * 256 + bj * 128 + wc * 32 + n * 16 + 4 * fq; tv[ai][m][bj][n] = *(const u32x2*)(T + (size_t)row * D + col); )
        if (mode == 0) {
            EPI_ALL( const int col = u.pn * 256 + bj * 128 + wc * 32 + n * 16 + 4 * fq; const f32x4 a = acc[ai][bj][m][n]; const u32x2 t = tv[ai][m][bj][n]; u32x2 o;
                o.x = pk2(bflo(t.x) * a[0], bfhi(t.x) * a[1]); o.y = pk2(bflo(t.y) * a[2], bfhi(t.y) * a[3]);
                *(u32x2*)(T + (size_t)row * D + col) = o; )
        } else {
            u32x2 sv[2][4][2][2];
            EPI_ALL( const int col = u.pn * 256 + bj * 128 + wc * 32 + n * 16 + 4 * fq; sv[ai][m][bj][n] = *(const u32x2*)(S2 + (size_t)row * D + col); )
            EPI_ALL( const int col = u.pn * 256 + bj * 128 + wc * 32 + n * 16 + 4 * fq; const f32x4 a = acc[ai][bj][m][n]; const u32x2 t = tv[ai][m][bj][n]; const u32x2 q = sv[ai][m][bj][n]; u32x2 o;
                o.x = pk2(bflo(t.x) + bflo(q.x) * a[0], bfhi(t.x) + bfhi(q.x) * a[1]); o.y = pk2(bflo(t.y) + bflo(q.y) * a[2], bfhi(t.y) + bfhi(q.y) * a[3]);
                *(u32x2*)(T + (size_t)row * D + col) = o; )
        }
    }
};
struct EpiLru {
    const bf16_t* XC; bf16_t *GR0, *U0, *GR1, *U1; const float *ba, *bx, *cl;
    __device__ __forceinline__ void operator()(AccRef acc, const Unit& u, int wr, int wc, int fr, int fq) const {
        const int d = u.pn >> 3, pn8 = u.pn & 7;
        bf16_t* GR = GR0 + (size_t)d * ((size_t)(O_GRB - O_GRF) / 2); bf16_t* UU = U0 + (size_t)d * ((size_t)(O_UB - O_UF) / 2);
#pragma unroll
        for (int bj = 0; bj < 2; ++bj) { const int c0 = 128 * pn8 + 16 * (4 * bj + wc) + 4 * fq;
            const f32x4 vba = *(const f32x4*)(ba + d * D + c0), vbx = *(const f32x4*)(bx + d * D + c0), vcl = *(const f32x4*)(cl + d * D + c0);
            u32x2 xv[2][4];
            EPI_ROWS( xv[ai][m] = *(const u32x2*)(XC + (size_t)row * D + c0); )
            EPI_ROWS(
                const size_t off = (size_t)row * D + c0;
                const u32x2 xcv = xv[ai][m];
                const float xc[4] = {bflo(xcv.x), bfhi(xcv.x), bflo(xcv.y), bfhi(xcv.y)};
                float gr[4]; float uu[4];
                _Pragma("unroll") for (int j = 0; j < 4; ++j) {
                    gr[j] = sigm(acc[ai][bj][m][0][j] + vba[j]);
                    const float gi = sigm(acc[ai][bj][m][1][j] + vbx[j]);
                    const float x = 2.0f * gr[j] * vcl[j];
                    const float om = -x * (1.0f + 0.5f * x * (1.0f + (1.0f / 3.0f) * x * (1.0f + 0.25f * x)));
                    uu[j] = __builtin_amdgcn_sqrtf(om) * gi * xc[j]; }
                u32x2 o1; u32x2 o2; o1.x = pk2(gr[0], gr[1]); o1.y = pk2(gr[2], gr[3]); o2.x = pk2(uu[0], uu[1]); o2.y = pk2(uu[2], uu[3]);
                *(u32x2*)(GR + off) = o1; *(u32x2*)(UU + off) = o2;
            )
        }
    }
};
struct EpiLate {
    bf16_t *HS, *S1, *S2;
    __device__ __forceinline__ void operator()(AccRef acc, const Unit& u, int wr, int wc, int fr, int fq) const {
        const int part = u.pn >> 2;
        if (part == 0) {
            u32x2 tv[2][4][2][2];
            EPI_ALL( const int col = (u.pn & 3) * 256 + bj * 128 + wc * 32 + n * 16 + 4 * fq; tv[ai][m][bj][n] = *(const u32x2*)(HS + (size_t)row * D + col); )
            EPI_ALL( const int col = (u.pn & 3) * 256 + bj * 128 + wc * 32 + n * 16 + 4 * fq; const f32x4 a = acc[ai][bj][m][n]; const u32x2 t = tv[ai][m][bj][n]; u32x2 o;
                o.x = pk2(bflo(t.x) * gelu_f(a[0]), bfhi(t.x) * gelu_f(a[1])); o.y = pk2(bflo(t.y) * gelu_f(a[2]), bfhi(t.y) * gelu_f(a[3]));
                *(u32x2*)(HS + (size_t)row * D + col) = o; )
        } else {
            bf16_t* O = part == 1 ? S1 : S2;
            EPI_ALL( const int col = (u.pn & 3) * 256 + bj * 128 + wc * 32 + n * 16 + 4 * fq; const f32x4 a = acc[ai][bj][m][n]; u32x2 o;
                o.x = pk2(sigm(a[0]), sigm(a[1])); o.y = pk2(sigm(a[2]), sigm(a[3])); *(u32x2*)(O + (size_t)row * D + col) = o; )
        }
    }
};

struct EpiPostG {
    static constexpr bool AFTER_DRAIN = true;
    bf16_t* YF; const bf16_t* YB; const bf16_t* V; const float* cb; const float* lnw; const float* lnb;
    __device__ __forceinline__ void fused(f32x4 (&acc)[2][2][4][2], const Unit& u, int wr, int wc, int fr, int fq, LAS unsigned char* lds, int wid, int lane) const {
        LAS f32x2* P = (LAS f32x2*)lds;
#pragma unroll
        for (int ai = 0; ai < 2; ++ai)
#pragma unroll
            for (int bj = 0; bj < 2; ++bj) { const int qd = ai * 2 + bj;
                u32x2 a[4][2], b[4][2], vv[4][2];
#pragma unroll
                for (int m = 0; m < 4; ++m)
#pragma unroll
                    for (int n = 0; n < 2; ++n) { const size_t off = (size_t)(u.pm * 256 + ai * 128 + wr * 64 + m * 16 + fr) * D + u.pn * 256 + bj * 128 + wc * 32 + n * 16 + 4 * fq;
                        a[m][n] = *(const u32x2*)(YF + off); b[m][n] = *(const u32x2*)(YB + off); vv[m][n] = *(const u32x2*)(V + off); }
                f32x4 y[4][2];
#pragma unroll
                for (int m = 0; m < 4; ++m) { float s1 = 0.f, s2 = 0.f;
#pragma unroll
                    for (int n = 0; n < 2; ++n) { const f32x4 t = (f32x4){bflo(a[m][n].x) + bflo(b[m][n].x), bfhi(a[m][n].x) + bfhi(b[m][n].x), bflo(a[m][n].y) + bflo(b[m][n].y), bfhi(a[m][n].y) + bfhi(b[m][n].y)};
                        y[m][n] = t; s1 += (t[0] + t[1]) + (t[2] + t[3]); s2 += (t[0] * t[0] + t[1] * t[1]) + (t[2] * t[2] + t[3] * t[3]); }
                    s1 += __shfl_xor(s1, 16); s1 += __shfl_xor(s1, 32); s2 += __shfl_xor(s2, 16); s2 += __shfl_xor(s2, 32);
                    if (fq == 0) P[(qd * 128 + wr * 64 + m * 16 + fr) * 4 + wc] = (f32x2){s1, s2}; }
                __syncthreads();
                const int head = 4 * u.pn + 2 * bj + (wc >> 1);
#pragma unroll
                for (int m = 0; m < 4; ++m) { const int rl = wr * 64 + m * 16 + fr, row = u.pm * 256 + ai * 128 + rl;
                    const f32x2 p0 = P[(qd * 128 + rl) * 4 + wc], p1 = P[(qd * 128 + rl) * 4 + (wc ^ 1)];
                    const float mean = (p0[0] + p1[0]) * (1.0f / 64.0f), var = fmaxf((p0[1] + p1[1]) * (1.0f / 64.0f) - mean * mean, 0.f), rs = rsqrtf(var + 64e-5f);
                    const float cbs = cb[(size_t)row * 16 + head];
#pragma unroll
                    for (int n = 0; n < 2; ++n) { const int col = u.pn * 256 + bj * 128 + wc * 32 + n * 16 + 4 * fq; const size_t off = (size_t)row * D + col;
                        const f32x4 w = *(const f32x4*)(lnw + col), bb = *(const f32x4*)(lnb + col), g = acc[ai][bj][m][n];
                        const f32x4 v4 = (f32x4){bflo(vv[m][n].x), bfhi(vv[m][n].x), bflo(vv[m][n].y), bfhi(vv[m][n].y)};
                        const f32x4 o = ((y[m][n] - mean) * rs * w + bb + cbs * v4) * g;
                        u32x2 q; q.x = pk2(o[0], o[1]); q.y = pk2(o[2], o[3]); *(u32x2*)(YF + off) = q; } }
            }
        __syncthreads();
    }
};
struct RowX { unsigned* slots; unsigned* cnt; };
__device__ __forceinline__ void row_rstd_exchange(f32x4 (&v)[2][2][4][2], const Unit& u, int wr, int wc, int fr, int fq, LAS unsigned char* lds, int wid, int lane, const RowX& X) {
    LAS float* P = (LAS float*)lds; LAS float* S = (LAS float*)(lds + 4096);
#pragma unroll
    for (int ai = 0; ai < 2; ++ai)
#pragma unroll
        for (int m = 0; m < 4; ++m) { float q = 0.f;
#pragma unroll
            for (int bj = 0; bj < 2; ++bj)
#pragma unroll
                for (int n = 0; n < 2; ++n) { const f32x4 x = v[ai][bj][m][n]; q += (x[0] * x[0] + x[1] * x[1]) + (x[2] * x[2] + x[3] * x[3]); }
            q += __shfl_xor(q, 16); q += __shfl_xor(q, 32);
            if (fq == 0) P[(ai * 128 + wr * 64 + m * 16 + fr) * 4 + wc] = q; }
    __syncthreads();
    const int row = wid * 32 + (lane & 31);
    if (lane < 32) { const float t = (P[row * 4] + P[row * 4 + 1]) + (P[row * 4 + 2] + P[row * 4 + 3]);
        __hip_atomic_store(X.slots + ((size_t)(u.pm * 256 + row) * 4 + u.pn), __float_as_uint(t), __ATOMIC_RELAXED, __HIP_MEMORY_SCOPE_AGENT); }
    asm volatile("s_waitcnt vmcnt(0)" ::: "memory");
    if (lane == 0) __hip_atomic_fetch_add(X.cnt + 64 * u.pm, 1u, __ATOMIC_RELAXED, __HIP_MEMORY_SCOPE_AGENT);
    if (wid == 0) { unsigned sp = 0u;
        while ((unsigned)__builtin_amdgcn_readfirstlane(__hip_atomic_load(X.cnt + 64 * u.pm, __ATOMIC_RELAXED, __HIP_MEMORY_SCOPE_AGENT)) < 32u) { __builtin_amdgcn_s_sleep(1); if (++sp > (1u << 22)) break; } }
    __syncthreads();
    if (lane < 32) { const unsigned* sl = X.slots + (size_t)(u.pm * 256 + row) * 4; float t = 0.f;
#pragma unroll
        for (int q = 0; q < 4; ++q) t += __uint_as_float(__hip_atomic_load(sl + q, __ATOMIC_RELAXED, __HIP_MEMORY_SCOPE_AGENT));
        S[row] = rsqrtf(t * (1.0f / D) + 1e-6f); }
    __syncthreads();
}
struct EpiOutNorm {
    static constexpr bool AFTER_DRAIN = true;
    const bf16_t* res_b; bf16_t* x2b; bf16_t* hn; const float* mod; const float* g2; RowX X;
    __device__ __forceinline__ void fused(f32x4 (&acc)[2][2][4][2], const Unit& u, int wr, int wc, int fr, int fq, LAS unsigned char* lds, int wid, int lane) const {
        const float* mb = mod + (size_t)((u.pm * 256) >> 12) * NMOD;
#pragma unroll
        for (int ai = 0; ai < 2; ++ai) { u32x2 tv[4][2][2];
#pragma unroll
            for (int m = 0; m < 4; ++m)
#pragma unroll
                for (int bj = 0; bj < 2; ++bj)
#pragma unroll
                    for (int n = 0; n < 2; ++n) { const int row = u.pm * 256 + ai * 128 + wr * 64 + m * 16 + fr, col = u.pn * 256 + bj * 128 + wc * 32 + n * 16 + 4 * fq; tv[m][bj][n] = *(const u32x2*)(res_b + (size_t)row * D + col); }
#pragma unroll
            for (int m = 0; m < 4; ++m)
#pragma unroll
                for (int bj = 0; bj < 2; ++bj)
#pragma unroll
                    for (int n = 0; n < 2; ++n) { const int row = u.pm * 256 + ai * 128 + wr * 64 + m * 16 + fr, col = u.pn * 256 + bj * 128 + wc * 32 + n * 16 + 4 * fq; const u32x2 t = tv[m][bj][n];
                        const f32x4 gt = *(const f32x4*)(mb + 5 * D + col);
                        const f32x4 o = (f32x4){bflo(t.x), bfhi(t.x), bflo(t.y), bfhi(t.y)} + gt * acc[ai][bj][m][n];
                        acc[ai][bj][m][n] = o;
                        u32x2 w; w.x = pk2(o[0], o[1]); w.y = pk2(o[2], o[3]); *(u32x2*)(x2b + (size_t)row * D + col) = w; }
        }
        row_rstd_exchange(acc, u, wr, wc, fr, fq, lds, wid, lane, X);
        const LAS float* S = (const LAS float*)(lds + 4096);
#pragma unroll
        for (int bj = 0; bj < 2; ++bj)
#pragma unroll
            for (int n = 0; n < 2; ++n) { const int col = u.pn * 256 + bj * 128 + wc * 32 + n * 16 + 4 * fq;
                const f32x4 mul = *(const f32x4*)(g2 + col) * (1.0f + *(const f32x4*)(mb + 7 * D + col)), sh = *(const f32x4*)(mb + 6 * D + col);
#pragma unroll
                for (int ai = 0; ai < 2; ++ai)
#pragma unroll
                    for (int m = 0; m < 4; ++m) { const int rl = ai * 128 + wr * 64 + m * 16 + fr; const float rs = S[rl];
                        const f32x4 y = acc[ai][bj][m][n] * rs * mul + sh;
                        u32x2 w; w.x = pk2(y[0], y[1]); w.y = pk2(y[2], y[3]); *(u32x2*)(hn + (size_t)(u.pm * 256 + rl) * D + col) = w; } }
    }
};
struct EpiDn1Norm {
    static constexpr bool AFTER_DRAIN = true;
    const float* res_f; bf16_t* x1b; bf16_t* xnxs; bf16_t* xnp; const float* mod; const float* gm; RowX X;
    __device__ __forceinline__ void fused(f32x4 (&acc)[2][2][4][2], const Unit& u, int wr, int wc, int fr, int fq, LAS unsigned char* lds, int wid, int lane) const {
        const float* mb = mod + (size_t)((u.pm * 256) >> 12) * NMOD;
        f32x4 gt[2][2];
#pragma unroll
        for (int bj = 0; bj < 2; ++bj)
#pragma unroll
            for (int n = 0; n < 2; ++n) gt[bj][n] = 0.5f * *(const f32x4*)(mb + 2 * D + u.pn * 256 + bj * 128 + wc * 32 + n * 16 + 4 * fq);
#pragma unroll
        for (int ai = 0; ai < 2; ++ai)
#pragma unroll
            for (int mh = 0; mh < 2; ++mh) { f32x4 rv[2][2][2];
#pragma unroll
                for (int mm = 0; mm < 2; ++mm)
#pragma unroll
                    for (int bj = 0; bj < 2; ++bj)
#pragma unroll
                        for (int n = 0; n < 2; ++n) { const int m = 2 * mh + mm, row = u.pm * 256 + ai * 128 + wr * 64 + m * 16 + fr, col = u.pn * 256 + bj * 128 + wc * 32 + n * 16 + 4 * fq; rv[mm][bj][n] = *(const f32x4*)(res_f + (size_t)row * D + col); }
#pragma unroll
                for (int mm = 0; mm < 2; ++mm)
#pragma unroll
                    for (int bj = 0; bj < 2; ++bj)
#pragma unroll
                        for (int n = 0; n < 2; ++n) { const int m = 2 * mh + mm, row = u.pm * 256 + ai * 128 + wr * 64 + m * 16 + fr, col = u.pn * 256 + bj * 128 + wc * 32 + n * 16 + 4 * fq;
                            const f32x4 o = rv[mm][bj][n] + gt[bj][n] * acc[ai][bj][m][n]; acc[ai][bj][m][n] = o;
                            u32x2 w; w.x = pk2(o[0], o[1]); w.y = pk2(o[2], o[3]); *(u32x2*)(x1b + (size_t)row * D + col) = w; }
            }
        row_rstd_exchange(acc, u, wr, wc, fr, fq, lds, wid, lane, X);
        const LAS float* S = (const LAS float*)(lds + 4096);
#pragma unroll
        for (int bj = 0; bj < 2; ++bj)
#pragma unroll
            for (int n = 0; n < 2; ++n) { const int col = u.pn * 256 + bj * 128 + wc * 32 + n * 16 + 4 * fq;
                const f32x4 mul = *(const f32x4*)(gm + col) * (1.0f + *(const f32x4*)(mb + 4 * D + col)), sh = *(const f32x4*)(mb + 3 * D + col);
#pragma unroll
                for (int ai = 0; ai < 2; ++ai)
#pragma unroll
                    for (int m = 0; m < 4; ++m) { const int rl = ai * 128 + wr * 64 + m * 16 + fr; const float rs = S[rl]; const size_t row = (size_t)(u.pm * 256 + rl);
                        const f32x4 y = acc[ai][bj][m][n] * rs * mul + sh;
                        u32x2 w; w.x = pk2(y[0], y[1]); w.y = pk2(y[2], y[3]); *(u32x2*)(xnp + row * D + col) = w; } }
        __syncthreads();
    }
};
struct EpiFinalNorm {
    static constexpr bool AFTER_DRAIN = true;
    const bf16_t* res_b; float* out; const float* mod; const float* gfin; RowX X;
    __device__ __forceinline__ void fused(f32x4 (&acc)[2][2][4][2], const Unit& u, int wr, int wc, int fr, int fq, LAS unsigned char* lds, int wid, int lane) const {
        const float* mb = mod + (size_t)((u.pm * 256) >> 12) * NMOD;
#pragma unroll
        for (int ai = 0; ai < 2; ++ai) { u32x2 tv[4][2][2];
#pragma unroll
            for (int m = 0; m < 4; ++m)
#pragma unroll
                for (int bj = 0; bj < 2; ++bj)
#pragma unroll
                    for (int n = 0; n < 2; ++n) { const int row = u.pm * 256 + ai * 128 + wr * 64 + m * 16 + fr, col = u.pn * 256 + bj * 128 + wc * 32 + n * 16 + 4 * fq; tv[m][bj][n] = *(const u32x2*)(res_b + (size_t)row * D + col); }
#pragma unroll
            for (int m = 0; m < 4; ++m)
#pragma unroll
                for (int bj = 0; bj < 2; ++bj)
#pragma unroll
                    for (int n = 0; n < 2; ++n) { const int col = u.pn * 256 + bj * 128 + wc * 32 + n * 16 + 4 * fq; const u32x2 t = tv[m][bj][n];
                        const f32x4 gt = 0.5f * *(const f32x4*)(mb + 8 * D + col);
                        acc[ai][bj][m][n] = (f32x4){bflo(t.x), bfhi(t.x), bflo(t.y), bfhi(t.y)} + gt * acc[ai][bj][m][n]; }
        }
        row_rstd_exchange(acc, u, wr, wc, fr, fq, lds, wid, lane, X);
        const LAS float* S = (const LAS float*)(lds + 4096);
#pragma unroll
        for (int bj = 0; bj < 2; ++bj)
#pragma unroll
            for (int n = 0; n < 2; ++n) { const int col = u.pn * 256 + bj * 128 + wc * 32 + n * 16 + 4 * fq;
                const f32x4 gg = *(const f32x4*)(gfin + col);
#pragma unroll
                for (int ai = 0; ai < 2; ++ai)
#pragma unroll
                    for (int m = 0; m < 4; ++m) { const int rl = ai * 128 + wr * 64 + m * 16 + fr; const float rs = S[rl];
                        *(f32x4*)(out + (size_t)(u.pm * 256 + rl) * D + col) = acc[ai][bj][m][n] * rs * gg; } }
    }
};

enum { CV_PLAIN = 0, CV_UPI = 1, CV_RW = 2, CV_LRU = 3 };
__device__ __forceinline__ void cvt_store(const LAS float* scr, int tid, int k0, int n0, bf16_t* dst, int ldd, int mode, int p0, const float* sc) {
    const int nl = tid >> 3, kc = (tid & 7) * 8, n = n0 + nl;
    float s[8];
#pragma unroll
    for (int j = 0; j < 8; ++j) s[j] = scr[(kc + j) * 65 + nl];
    int row = n;
    if (mode == CV_UPI) row = 32 * (n >> 4) + 16 * p0 + (n & 15);
    else if (mode == CV_LRU) { const int dd = p0 >> 3, nb = (p0 >> 1) & 3, which = p0 & 1, c = 256 * nb + n; row = dd * 2048 + (c >> 7) * 256 + ((c & 127) >> 4) * 32 + which * 16 + (c & 15); }
    bf16_t* dp = dst + (size_t)row * ldd + k0 + kc;
    if (mode == CV_RW) { const float mu = sc[n], om = 1.0f - mu;
        u32x4 o; o.x = pk2(s[0] * om, s[1] * om); o.y = pk2(s[2] * om, s[3] * om); o.z = pk2(s[4] * om, s[5] * om); o.w = pk2(s[6] * om, s[7] * om);
        *(u32x4*)dp = o;
        o.x = pk2(s[0] * mu, s[1] * mu); o.y = pk2(s[2] * mu, s[3] * mu); o.z = pk2(s[4] * mu, s[5] * mu); o.w = pk2(s[6] * mu, s[7] * mu);
        *(u32x4*)(dp + 1024) = o;
    } else { u32x4 o; o.x = pk2(s[0], s[1]); o.y = pk2(s[2], s[3]); o.z = pk2(s[4], s[5]); o.w = pk2(s[6], s[7]); *(u32x4*)dp = o; }
}
__device__ __forceinline__ void cvt_run2(const float* src, int lds_, int K, int N, bf16_t* dst, int ldd, int mode, int p0, const float* sc, LAS float* scr, int bid, int nb) {
    const int tid = tidx(), ntn = N >> 6, nt = (K >> 6) * ntn;
    for (int t = bid; t < nt; t += 2 * nb) {
        const int t2 = t + nb; const bool has2 = t2 < nt;
        const int k0 = (t / ntn) << 6, n0 = (t % ntn) << 6, k1 = has2 ? (t2 / ntn) << 6 : k0, n1 = has2 ? (t2 % ntn) << 6 : n0;
        float va[8], vb[8];
#pragma unroll
        for (int j = 0; j < 8; ++j) { const int kk = (tid >> 6) + 8 * j, nn = tid & 63; va[j] = src[(size_t)(k0 + kk) * lds_ + n0 + nn]; vb[j] = src[(size_t)(k1 + kk) * lds_ + n1 + nn]; }
#pragma unroll
        for (int j = 0; j < 8; ++j) { const int kk = (tid >> 6) + 8 * j, nn = tid & 63; scr[kk * 65 + nn] = va[j]; scr[4160 + kk * 65 + nn] = vb[j]; }
        __syncthreads();
        cvt_store(scr, tid, k0, n0, dst, ldd, mode, p0, sc);
        if (has2) cvt_store(scr + 4160, tid, k1, n1, dst, ldd, mode, p0, sc);
        __syncthreads();
    }
}
__device__ __forceinline__ void cvt_run(const float* src, int lds_, int K, int N, bf16_t* dst, int ldd, int mode, int p0, const float* sc, LAS float* scr) {
    cvt_run2(src, lds_, K, N, dst, ldd, mode, p0, sc, scr, blockIdx.x, gridDim.x);
}
__device__ __forceinline__ void zero_fill(unsigned char* p, size_t row_bytes, size_t pitch, int rows) {
    const size_t per = row_bytes / 16, tot = per * rows;
    const int ztid = tidx();
    for (size_t i = (size_t)blockIdx.x * NTHREADS + ztid; i < tot; i += (size_t)gridDim.x * NTHREADS) {
        const size_t r = i / per, c = i % per; *(u32x4*)(p + r * pitch + c * 16) = (u32x4){0u, 0u, 0u, 0u}; }
}

__device__ __forceinline__ void mod_phase(const Params& p, float* mod, LAS float* red) {
    const int tid = tidx(), kq = tid >> 4, cq = tid & 15;
    const float* c = p.in[1]; const float* cc = p.in[3]; const float* wm = p.in[4]; const float* bm = p.in[5];
    for (int it = blockIdx.x; it < NMOD / 64; it += gridDim.x) {
        const int j0 = it * 64 + 4 * cq;
        f32x4 acc[5];
#pragma unroll
        for (int b = 0; b < 5; ++b) acc[b] = (f32x4){0.f, 0.f, 0.f, 0.f};
#pragma unroll 4
        for (int i = 0; i < 32; ++i) { const int k = kq + 32 * i;
            const f32x4 w = *(const f32x4*)(wm + (size_t)k * NMOD + j0);
            acc[0] += silu_f(c[k]) * w; acc[1] += silu_f(c[D + k]) * w; acc[2] += silu_f(c[2 * D + k]) * w; acc[3] += silu_f(c[3 * D + k]) * w; acc[4] += silu_f(cc[k]) * w; }
#pragma unroll
        for (int b = 0; b < 5; ++b)
#pragma unroll
            for (int j = 0; j < 4; ++j) red[(kq * 5 + b) * 64 + 4 * cq + j] = acc[b][j];
        __syncthreads();
        if (tid < 320) { const int b = tid >> 6, cl = tid & 63; float s = 0.f;
            for (int q = 0; q < 32; ++q) s += red[(q * 5 + b) * 64 + cl];
            mod[(size_t)b * NMOD + it * 64 + cl] = s + bm[it * 64 + cl]; }
        __syncthreads();
    }
}

template <bool LATB = false> __device__ __forceinline__ void norm_phase(const float* lat, const float* ctx, int nrows, const float* g, const float* mod, int ish, int isc, bf16_t* dst, int ldd, const float* ctx2 = nullptr, const bf16_t* latb = nullptr, bf16_t* dst2 = nullptr, int mstart = 0) {
    const int tid = tidx(), lane = tid & 63, gw = blockIdx.x * 8 + (tid >> 6), ngw = gridDim.x * 8;
    for (int m0 = mstart + gw; m0 < nrows; m0 += 2 * ngw) {
        const int m1 = m0 + ngw; const bool has1 = m1 < nrows; const int mb = has1 ? m1 : m0;
        const float* srca = m0 < MLAT ? lat + (size_t)m0 * D : ctx + (size_t)(m0 - MLAT) * D;
        const float* srcb = mb < MLAT ? lat + (size_t)mb * D : ctx + (size_t)(mb - MLAT) * D;
        f32x4 va[4], vb[4]; float sa = 0.f, sb = 0.f;
#pragma unroll
        for (int j = 0; j < 4; ++j) {
            if (LATB && m0 < MLAT) { const u32x2 t = *(const u32x2*)(latb + (size_t)m0 * D + 4 * lane + 256 * j); va[j] = (f32x4){bflo(t.x), bfhi(t.x), bflo(t.y), bfhi(t.y)}; } else va[j] = *(const f32x4*)(srca + 4 * lane + 256 * j);
            if (LATB && mb < MLAT) { const u32x2 t = *(const u32x2*)(latb + (size_t)mb * D + 4 * lane + 256 * j); vb[j] = (f32x4){bflo(t.x), bfhi(t.x), bflo(t.y), bfhi(t.y)}; } else vb[j] = *(const f32x4*)(srcb + 4 * lane + 256 * j); }
        if (ctx2) {
            if (m0 >= MLAT) { _Pragma("unroll") for (int j = 0; j < 4; ++j) va[j] += *(const f32x4*)(ctx2 + (size_t)(m0 - MLAT) * D + 4 * lane + 256 * j); }
            if (mb >= MLAT) { _Pragma("unroll") for (int j = 0; j < 4; ++j) vb[j] += *(const f32x4*)(ctx2 + (size_t)(mb - MLAT) * D + 4 * lane + 256 * j); } }
#pragma unroll
        for (int j = 0; j < 4; ++j) { sa += va[j][0] * va[j][0] + va[j][1] * va[j][1] + va[j][2] * va[j][2] + va[j][3] * va[j][3]; sb += vb[j][0] * vb[j][0] + vb[j][1] * vb[j][1] + vb[j][2] * vb[j][2] + vb[j][3] * vb[j][3]; }
#pragma unroll
        for (int o = 1; o < 64; o <<= 1) { sa += __shfl_xor(sa, o); sb += __shfl_xor(sb, o); }
        const float ra = rsqrtf(sa * (1.0f / D) + 1e-6f), rb = rsqrtf(sb * (1.0f / D) + 1e-6f);
        const int ba = m0 < MLAT ? (m0 >> 12) : 4, bb = mb < MLAT ? (mb >> 12) : 4;
        const float* sha = mod + (size_t)ba * NMOD + ish * D; const float* sca = mod + (size_t)ba * NMOD + isc * D;
        const float* shb = mod + (size_t)bb * NMOD + ish * D; const float* scb = mod + (size_t)bb * NMOD + isc * D;
#pragma unroll
        for (int j = 0; j < 4; ++j) { const int c = 4 * lane + 256 * j;
            const f32x4 gg = *(const f32x4*)(g + c);
            { const f32x4 s1 = *(const f32x4*)(sha + c), s2 = *(const f32x4*)(sca + c); const f32x4 y = va[j] * ra * gg * (1.0f + s2) + s1;
              u32x2 o; o.x = pk2(y[0], y[1]); o.y = pk2(y[2], y[3]); *(u32x2*)(dst + (size_t)m0 * ldd + c) = o; if (dst2 && m0 < MLAT) *(u32x2*)(dst2 + (size_t)m0 * D + c) = o; }
            if (has1) { const f32x4 s1 = *(const f32x4*)(shb + c), s2 = *(const f32x4*)(scb + c); const f32x4 y = vb[j] * rb * gg * (1.0f + s2) + s1;
              u32x2 o; o.x = pk2(y[0], y[1]); o.y = pk2(y[2], y[3]); *(u32x2*)(dst + (size_t)m1 * ldd + c) = o; if (dst2 && m1 < MLAT) *(u32x2*)(dst2 + (size_t)m1 * D + c) = o; } }
    }
}
__device__ __forceinline__ void final_norm_phase(float* x, const float* g) {
    const int tid = tidx(), lane = tid & 63, gw = blockIdx.x * 8 + (tid >> 6), ngw = gridDim.x * 8;
    for (int m0 = gw; m0 < MLAT; m0 += 2 * ngw) {
        const int m1 = m0 + ngw; const bool has1 = m1 < MLAT;
        float* sa_ = x + (size_t)m0 * D; float* sb_ = x + (size_t)(has1 ? m1 : m0) * D;
        f32x4 va[4], vb[4]; float sa = 0.f, sb = 0.f;
#pragma unroll
        for (int j = 0; j < 4; ++j) { va[j] = *(const f32x4*)(sa_ + 4 * lane + 256 * j); vb[j] = *(const f32x4*)(sb_ + 4 * lane + 256 * j); }
#pragma unroll
        for (int j = 0; j < 4; ++j) { sa += va[j][0] * va[j][0] + va[j][1] * va[j][1] + va[j][2] * va[j][2] + va[j][3] * va[j][3]; sb += vb[j][0] * vb[j][0] + vb[j][1] * vb[j][1] + vb[j][2] * vb[j][2] + vb[j][3] * vb[j][3]; }
#pragma unroll
        for (int o = 1; o < 64; o <<= 1) { sa += __shfl_xor(sa, o); sb += __shfl_xor(sb, o); }
        const float ra = rsqrtf(sa * (1.0f / D) + 1e-6f), rb = rsqrtf(sb * (1.0f / D) + 1e-6f);
#pragma unroll
        for (int j = 0; j < 4; ++j) { const int c = 4 * lane + 256 * j; const f32x4 gg = *(const f32x4*)(g + c);
            *(f32x4*)(sa_ + c) = va[j] * ra * gg; if (has1) *(f32x4*)(sb_ + c) = vb[j] * rb * gg; }
    }
}
__device__ __forceinline__ void add4(f32x4& a, const bf16_t* p) { const u32x2 t = *(const u32x2*)p; a[0] += bflo(t.x); a[1] += bfhi(t.x); a[2] += bflo(t.y); a[3] += bfhi(t.y); }
__device__ __forceinline__ void xs_phase(bf16_t* xnxs, const bf16_t* xnp, int nrows) {
    const int tid = tidx(), lane = tid & 63, gw = blockIdx.x * 8 + (tid >> 6), ngw = gridDim.x * 8;
    for (int m = gw; m < nrows; m += ngw) {
        int n0, n1, n2, n3; bool v0, v1, v2, v3; float wgt;
        if (m < MLAT) { const int t = m & 4095, gr = t >> 6, gc = t & 63; wgt = 0.25f; v0 = gr > 0; v1 = gr < 63; v2 = gc > 0; v3 = gc < 63; n0 = m - 64; n1 = m + 64; n2 = m - 1; n3 = m + 1; }
        else { const int j = (m - MLAT) & 255; wgt = 0.5f; v0 = false; v1 = false; v2 = j > 0; v3 = j < 255; n0 = m; n1 = m; n2 = m - 1; n3 = m + 1; }
        if (!v0) n0 = m; if (!v1) n1 = m; if (!v2) n2 = m; if (!v3) n3 = m;
        const float w0 = v0 ? wgt : 0.f, w1 = v1 ? wgt : 0.f, w2 = v2 ? wgt : 0.f, w3 = v3 ? wgt : 0.f;
        const bool plain = xnp != nullptr && m < MLAT;
        const bf16_t* sb = plain ? xnp : xnxs; const size_t ld = plain ? (size_t)D : (size_t)2048;
        u32x2 q0[4], q1[4], q2[4], q3[4], qs[4];
#pragma unroll
        for (int j = 0; j < 4; ++j) { const int c = 4 * lane + 256 * j;
            q0[j] = *(const u32x2*)(sb + (size_t)n0 * ld + c); q1[j] = *(const u32x2*)(sb + (size_t)n1 * ld + c);
            q2[j] = *(const u32x2*)(sb + (size_t)n2 * ld + c); q3[j] = *(const u32x2*)(sb + (size_t)n3 * ld + c); qs[j] = *(const u32x2*)(sb + (size_t)m * ld + c); }
#pragma unroll
        for (int j = 0; j < 4; ++j) { const int c = 4 * lane + 256 * j;
            const float a0 = w0 * bflo(q0[j].x) + w1 * bflo(q1[j].x) + w2 * bflo(q2[j].x) + w3 * bflo(q3[j].x);
            const float a1 = w0 * bfhi(q0[j].x) + w1 * bfhi(q1[j].x) + w2 * bfhi(q2[j].x) + w3 * bfhi(q3[j].x);
            const float a2 = w0 * bflo(q0[j].y) + w1 * bflo(q1[j].y) + w2 * bflo(q2[j].y) + w3 * bflo(q3[j].y);
            const float a3 = w0 * bfhi(q0[j].y) + w1 * bfhi(q1[j].y) + w2 * bfhi(q2[j].y) + w3 * bfhi(q3[j].y);
            u32x2 o; o.x = pk2(a0, a1); o.y = pk2(a2, a3);
            *(u32x2*)(xnxs + (size_t)m * 2048 + 1024 + c) = o;
            if (plain) *(u32x2*)(xnxs + (size_t)m * 2048 + c) = qs[j]; }
    }
}
__device__ __forceinline__ void xs_ctx_phase(const float* c1, const float* c2, const float* g, const float* mod, bf16_t* xnxs) {
    const int tid = tidx(), lane = tid & 63, gw = (int)gridDim.x * 8 - 1 - ((int)blockIdx.x * 8 + (tid >> 6)), ngw = gridDim.x * 8;
    const float* sh = mod + (size_t)4 * NMOD + 3 * D; const float* sc = mod + (size_t)4 * NMOD + 4 * D;
    for (int r = gw; r < MCTX; r += ngw) {
        const int j = r & 255; const bool vp = j > 0, vn = j < 255;
        const int rr[3] = {vp ? r - 1 : r, r, vn ? r + 1 : r};
        f32x4 x[3][4];
#pragma unroll
        for (int q = 0; q < 3; ++q)
#pragma unroll
            for (int i = 0; i < 4; ++i) { const size_t off = (size_t)rr[q] * D + 4 * lane + 256 * i; x[q][i] = *(const f32x4*)(c1 + off) + *(const f32x4*)(c2 + off); }
        float ss[3];
#pragma unroll
        for (int q = 0; q < 3; ++q) { float t = 0.f;
#pragma unroll
            for (int i = 0; i < 4; ++i) t += (x[q][i][0] * x[q][i][0] + x[q][i][1] * x[q][i][1]) + (x[q][i][2] * x[q][i][2] + x[q][i][3] * x[q][i][3]);
            ss[q] = t; }
#pragma unroll
        for (int o = 1; o < 64; o <<= 1) { ss[0] += __shfl_xor(ss[0], o); ss[1] += __shfl_xor(ss[1], o); ss[2] += __shfl_xor(ss[2], o); }
        const float r0 = rsqrtf(ss[0] * (1.0f / D) + 1e-6f) * (vp ? 0.5f : 0.f), r1 = rsqrtf(ss[1] * (1.0f / D) + 1e-6f), r2 = rsqrtf(ss[2] * (1.0f / D) + 1e-6f) * (vn ? 0.5f : 0.f);
        const float wsh = (vp ? 0.5f : 0.f) + (vn ? 0.5f : 0.f);
#pragma unroll
        for (int i = 0; i < 4; ++i) { const int c = 4 * lane + 256 * i;
            const f32x4 mul = *(const f32x4*)(g + c) * (1.0f + *(const f32x4*)(sc + c)), s0 = *(const f32x4*)(sh + c);
            const f32x4 xn = x[1][i] * r1 * mul + s0;
            const f32x4 xs = (x[0][i] * r0 + x[2][i] * r2) * mul + wsh * s0;
            u32x2 o; o.x = pk2(xn[0], xn[1]); o.y = pk2(xn[2], xn[3]); *(u32x2*)(xnxs + (size_t)(MLAT + r) * 2048 + c) = o;
            o.x = pk2(xs[0], xs[1]); o.y = pk2(xs[2], xs[3]); *(u32x2*)(xnxs + (size_t)(MLAT + r) * 2048 + 1024 + c) = o; }
    }
}
__device__ __forceinline__ void conv_phase(const bf16_t* plx, const bf16_t* plxc, bf16_t* xc, const float* cw, const float* cb) {
    const int tid = tidx(), lane = tid & 63, gw = blockIdx.x * 8 + (tid >> 6), ngw = gridDim.x * 8;
    for (int m = gw; m < MALL; m += ngw) {
        int t, len; if (m < MLAT) { t = m & 4095; len = 4096; } else { t = (m - MLAT) & 255; len = 256; }
        const bf16_t* pb = m < MLAT ? plx : plxc - (size_t)MLAT * D;
        int rq[4]; float wq[4];
#pragma unroll
        for (int q = 0; q < 4; ++q) { const int tt = t + q - 1; const bool ok = tt >= 0 && tt < len; rq[q] = ok ? m + q - 1 : m; wq[q] = ok ? 1.f : 0.f; }
        u32x2 x[4][4];
#pragma unroll
        for (int q = 0; q < 4; ++q)
#pragma unroll
            for (int j = 0; j < 4; ++j) x[q][j] = *(const u32x2*)(pb + (size_t)rq[q] * D + 4 * lane + 256 * j);
#pragma unroll
        for (int j = 0; j < 4; ++j) { const int c = 4 * lane + 256 * j; f32x4 a = *(const f32x4*)(cb + c);
#pragma unroll
            for (int q = 0; q < 4; ++q) { const f32x4 w = *(const f32x4*)(cw + q * D + c) * wq[q];
                a[0] += w[0] * bflo(x[q][j].x); a[1] += w[1] * bfhi(x[q][j].x); a[2] += w[2] * bflo(x[q][j].y); a[3] += w[3] * bfhi(x[q][j].y); }
            u32x2 o; o.x = pk2(a[0], a[1]); o.y = pk2(a[2], a[3]);
            *(u32x2*)(xc + (size_t)m * D + c) = o; }
    }
}
__device__ __forceinline__ void rncb_phase(const bf16_t* R, const bf16_t* Kk, const float* k_k, const float* r_k, float* rn, float* cbv) {
    const int tid = tidx(), g16 = (blockIdx.x * NTHREADS + tid) >> 4, ng = (gridDim.x * NTHREADS) >> 4, l = tid & 15;
    for (int it0 = g16; it0 < MALL * 16; it0 += 4 * ng) {
        u32x2 kv[4], rv[4];
#pragma unroll
        for (int u = 0; u < 4; ++u) { const int it = it0 + u * ng; kv[u] = (u32x2){0u, 0u}; rv[u] = (u32x2){0u, 0u};
            if (it < MALL * 16) { const size_t off = (size_t)(it >> 4) * D + (it & 15) * 64 + 4 * l; kv[u] = *(const u32x2*)(Kk + off); rv[u] = *(const u32x2*)(R + off); } }
#pragma unroll
        for (int u = 0; u < 4; ++u) { const int it = it0 + u * ng;
            if (it < MALL * 16) { const int c = (it & 15) * 64 + 4 * l;
                const f32x4 kk = *(const f32x4*)(k_k + c), rk = *(const f32x4*)(r_k + c);
                const float k0 = bflo(kv[u].x), k1 = bfhi(kv[u].x), k2 = bflo(kv[u].y), k3 = bfhi(kv[u].y);
                float s1 = k0 * kk[0] * k0 * kk[0] + k1 * kk[1] * k1 * kk[1] + k2 * kk[2] * k2 * kk[2] + k3 * kk[3] * k3 * kk[3];
                float s2 = bflo(rv[u].x) * k0 * rk[0] + bfhi(rv[u].x) * k1 * rk[1] + bflo(rv[u].y) * k2 * rk[2] + bfhi(rv[u].y) * k3 * rk[3];
                s1 = red16(s1); s2 = red16(s2);
                if (l == 0) { rn[it] = __builtin_amdgcn_rsqf(fmaxf(s1, 1e-24f)); cbv[it] = s2; } } }
    }
}
__device__ __forceinline__ void post_phase(bf16_t* YF, const bf16_t* YB, const bf16_t* V, const float* cbv, const float* lnw, const float* lnb) {
    const int tid = tidx(), g16 = (blockIdx.x * NTHREADS + tid) >> 4, ng = (gridDim.x * NTHREADS) >> 4, l = tid & 15;
    for (int it0 = g16; it0 < MLAT * 16; it0 += 4 * ng) {
        u32x2 av[4], bv[4], vv[4]; float cbs[4];
#pragma unroll
        for (int u = 0; u < 4; ++u) { const int it = it0 + u * ng; av[u] = (u32x2){0u, 0u}; bv[u] = av[u]; vv[u] = av[u]; cbs[u] = 0.f;
            if (it < MLAT * 16) { const size_t off = (size_t)(it >> 4) * D + (it & 15) * 64 + 4 * l; av[u] = *(const u32x2*)(YF + off); bv[u] = *(const u32x2*)(YB + off); vv[u] = *(const u32x2*)(V + off); cbs[u] = cbv[it]; } }
#pragma unroll
        for (int u = 0; u < 4; ++u) { const int it = it0 + u * ng;
            if (it < MLAT * 16) { const int c = (it & 15) * 64 + 4 * l; const size_t off = (size_t)(it >> 4) * D + c;
                float y[4] = {bflo(av[u].x) + bflo(bv[u].x), bfhi(av[u].x) + bfhi(bv[u].x), bflo(av[u].y) + bflo(bv[u].y), bfhi(av[u].y) + bfhi(bv[u].y)};
                const float mu = red16(y[0] + y[1] + y[2] + y[3]) * (1.0f / 64.0f);
                float q = 0.f;
#pragma unroll
                for (int j = 0; j < 4; ++j) { y[j] -= mu; q += y[j] * y[j]; }
                const float rs = rsqrtf(red16(q) * (1.0f / 64.0f) + 64e-5f);
                const f32x4 w = *(const f32x4*)(lnw + c), bb = *(const f32x4*)(lnb + c);
                const float v4[4] = {bflo(vv[u].x), bfhi(vv[u].x), bflo(vv[u].y), bfhi(vv[u].y)};
                float o[4];
#pragma unroll
                for (int j = 0; j < 4; ++j) o[j] = y[j] * rs * w[j] + bb[j] + cbs[u] * v4[j];
                u32x2 ov; ov.x = pk2(o[0], o[1]); ov.y = pk2(o[2], o[3]);
                *(u32x2*)(YF + off) = ov; } }
    }
}

constexpr int RS_STRIDE = 324;
constexpr int RS_BUF = 32 * RS_STRIDE + 1024 + 4096;
__device__ __forceinline__ int scan_row(int b, int dir, int s) {
    if (s < 256) return MLAT + b * 256 + (dir ? 255 - s : s);
    return b * 4096 + (dir ? 4095 - (s - 256) : (s - 256));
}
struct ScanIn { bf16x8 afr[2][2]; unsigned short xv[8]; float rnv[8]; unsigned vpair; };
__device__ __forceinline__ void rwkv_scan_phase(const Params& p, LAS float* lds) {
    unsigned char* ws = p.ws;
    const bf16_t* R = (const bf16_t*)(ws + O_R); const bf16_t* Kk = (const bf16_t*)(ws + O_K); const bf16_t* V = (const bf16_t*)(ws + O_V);
    const bf16_t* LIN = (const bf16_t*)(ws + O_LIN); const float* rn = (const float*)(ws + O_RN);
    const int tid = tidx(), lane = tid & 63, w = __builtin_amdgcn_readfirstlane(tid >> 6), fr = lane & 15, fq = lane >> 4;
    const int cgp = lane & 15, rw = lane >> 4;
    for (int unit = blockIdx.x; unit < 256; unit += gridDim.x) {
        const int xcd = unit & 7, slot = unit >> 3, half = slot & 1, chain = (slot >> 1) * 8 + xcd, dir = chain & 1, h = (chain >> 1) & 15, b = chain >> 5;
        bf16_t* Y = (bf16_t*)(ws + (dir ? O_YB : O_YF));
        const int lora = w >> 2, ct = w & 3, col = h * 64 + 16 * ct + fr;
        bf16x8 bfr[2];
        { const bf16_t* wt = (const bf16_t*)(ws + (lora ? O_LSCA : O_LSCW)) + (size_t)(dir * 1024 + col) * 64 + 8 * fq;
          bfr[0] = *(const bf16x8*)(wt); bfr[1] = *(const bf16x8*)(wt + 32); }
        const float c_bias = lora ? p.in[15][dir * D + col] : p.in[13][dir * D + col];
        const float c_kk = p.in[18][col], c_ka = p.in[19][col];
        const int lcol0 = (lora ? 128 : 0) + dir * 64;
        const int sgn = dir ? -1 : 1;
        f32x2 SA = (f32x2){0.f, 0.f}, SB = (f32x2){0.f, 0.f};
        ScanIn in;
#define SCAN_LOAD(c) do { const int m0 = scan_row(b, dir, 32 * (c)); \
            _Pragma("unroll") for (int tt = 0; tt < 2; ++tt) { const size_t mr = (size_t)(m0 + sgn * (16 * tt + fr)); \
                _Pragma("unroll") for (int ks = 0; ks < 2; ++ks) in.afr[tt][ks] = *(const bf16x8*)(LIN + mr * 256 + lcol0 + 32 * ks + 8 * fq); } \
            _Pragma("unroll") for (int tt = 0; tt < 2; ++tt) _Pragma("unroll") for (int j = 0; j < 4; ++j) { const size_t mr = (size_t)(m0 + sgn * (16 * tt + 4 * fq + j)); \
                in.xv[tt * 4 + j] = (lora ? Kk : R)[mr * D + col]; in.rnv[tt * 4 + j] = rn[mr * 16 + h]; } \
            { const size_t mr = (size_t)(m0 + sgn * (tid >> 4)); in.vpair = *(const unsigned*)(V + mr * D + h * 64 + half * 32 + 2 * (tid & 15)); } } while (0)
#define SCAN_PRODUCE(bufi) do { LAS float* sb = lds + (bufi) * RS_BUF; \
            _Pragma("unroll") for (int tt = 0; tt < 2; ++tt) { f32x4 acc = (f32x4){0.f, 0.f, 0.f, 0.f}; \
                acc = __builtin_amdgcn_mfma_f32_16x16x32_bf16(in.afr[tt][0], bfr[0], acc, 0, 0, 0); acc = __builtin_amdgcn_mfma_f32_16x16x32_bf16(in.afr[tt][1], bfr[1], acc, 0, 0, 0); \
                _Pragma("unroll") for (int j = 0; j < 4; ++j) { LAS float* rec = sb + (16 * tt + 4 * fq + j) * RS_STRIDE + 16 * ct + fr; const float x = bf2f(in.xv[tt * 4 + j]); \
                    if (lora == 0) { rec[0] = __expf(-0.60653066f * sigm(c_bias + acc[j])); rec[256] = x; } \
                    else { const float a = sigm(c_bias + acc[j]), kkv = x * c_kk * in.rnv[tt * 4 + j]; rec[64] = x * (1.0f + (a - 1.0f) * c_ka); rec[128] = -kkv; rec[192] = kkv * a; } } } \
            { LAS float* vb = sb + 32 * RS_STRIDE + (tid >> 4) * 32 + 2 * (tid & 15); vb[0] = bflo(in.vpair); vb[1] = bfhi(in.vpair); } } while (0)
#define SCAN_YOUT(c, bufi) do { if ((c) >= 8) { const LAS float* yb_ = lds + (bufi) * RS_BUF + 32 * RS_STRIDE + 1024 + ((tid >> 4) * 32 + 2 * (tid & 15)) * 4; \
            const f32x4 ya = *(const LAS f32x4*)(yb_), yc = *(const LAS f32x4*)(yb_ + 4); \
            const size_t mr = (size_t)(scan_row(b, dir, 32 * (c)) + sgn * (tid >> 4)); \
            *(unsigned*)(Y + mr * D + h * 64 + half * 32 + 2 * (tid & 15)) = pk2((ya[0] + ya[1]) + (ya[2] + ya[3]), (yc[0] + yc[1]) + (yc[2] + yc[3])); } } while (0)
        SCAN_LOAD(0);
        SCAN_PRODUCE(0);
        __syncthreads();
        for (int c = 0; c < 136; ++c) {
            const int cur = c & 1;
            if (c + 1 < 136 && w < 4) SCAN_LOAD(c + 1);
            if (c > 0 && w >= 4) SCAN_YOUT(c - 1, cur ^ 1);
            const LAS float* sp0 = lds + cur * RS_BUF + 4 * cgp;
            const LAS float* vb = lds + cur * RS_BUF + 32 * RS_STRIDE + w * 4 + rw;
            LAS float* yb = lds + cur * RS_BUF + 32 * RS_STRIDE + 1024 + (w * 4 + rw) * 4 + (cgp >> 2);
            f32x4 w4 = *(const LAS f32x4*)(sp0), kd4 = *(const LAS f32x4*)(sp0 + 64), ka4 = *(const LAS f32x4*)(sp0 + 192), r4 = *(const LAS f32x4*)(sp0 + 256);
            f32x4 nk1 = *(const LAS f32x4*)(sp0 + RS_STRIDE + 128);
            float vv = vb[0];
            float sa;
            { const f32x4 nk0 = *(const LAS f32x4*)(sp0 + 128); const f32x2 q = SA * (f32x2){nk0[0], nk0[1]} + SB * (f32x2){nk0[2], nk0[3]}; sa = red16(q[0] + q[1]); }
#define SCAN_STEPS(i0, cnt) _Pragma("unroll") for (int ii = 0; ii < (cnt); ++ii) { const int i = (i0) + ii; \
                f32x4 w4n = w4, kd4n = kd4, ka4n = ka4, r4n = r4, nk2 = nk1; float vvn = vv; \
                if (i + 1 < 32) { const LAS float* spn = sp0 + (i + 1) * RS_STRIDE; \
                    w4n = *(const LAS f32x4*)(spn); kd4n = *(const LAS f32x4*)(spn + 64); ka4n = *(const LAS f32x4*)(spn + 192); r4n = *(const LAS f32x4*)(spn + 256); vvn = vb[(i + 1) * 32]; } \
                if (i + 2 < 32) nk2 = *(const LAS f32x4*)(sp0 + (i + 2) * RS_STRIDE + 128); \
                { const f32x2 ta = sa * (f32x2){ka4[0], ka4[1]} + vv * (f32x2){kd4[0], kd4[1]}, tb = sa * (f32x2){ka4[2], ka4[3]} + vv * (f32x2){kd4[2], kd4[3]}; \
                  SA = SA * (f32x2){w4[0], w4[1]} + ta; SB = SB * (f32x2){w4[2], w4[3]} + tb; } \
                const f32x2 py = SA * (f32x2){r4[0], r4[1]} + SB * (f32x2){r4[2], r4[3]}; \
                float yp = py[0] + py[1]; \
                float sn = 0.f; \
                if (i + 1 < 32) { const f32x2 ps = SA * (f32x2){nk1[0], nk1[1]} + SB * (f32x2){nk1[2], nk1[3]}; sn = ps[0] + ps[1]; } \
                sn += dppf<0xB1>(sn); yp += dppf<0xB1>(yp); sn += dppf<0x4E>(sn); yp += dppf<0x4E>(yp); sn += dppf<0x141>(sn); sn += dppf<0x140>(sn); \
                if ((cgp & 3) == 0) yb[i * 128] = yp; \
                sa = sn; w4 = w4n; kd4 = kd4n; ka4 = ka4n; r4 = r4n; vv = vvn; nk1 = nk2; }
            __builtin_amdgcn_s_setprio(2);
            SCAN_STEPS(0, 8)
            if (c + 1 < 136 && w >= 4) SCAN_LOAD(c + 1);
            if (c + 1 < 136 && w < 4) { __builtin_amdgcn_s_setprio(0); SCAN_PRODUCE(cur ^ 1); __builtin_amdgcn_s_setprio(2); }
            SCAN_STEPS(8, 8)
            if (c > 0 && w < 4) SCAN_YOUT(c - 1, cur ^ 1);
            SCAN_STEPS(16, 8)
            if (c + 1 < 136 && w >= 4) { __builtin_amdgcn_s_setprio(0); SCAN_PRODUCE(cur ^ 1); __builtin_amdgcn_s_setprio(2); }
            SCAN_STEPS(24, 8)
            __builtin_amdgcn_s_setprio(0);
#undef SCAN_STEPS
            __syncthreads();
        }
        SCAN_YOUT(135, 1);
        __syncthreads();
#undef SCAN_LOAD
#undef SCAN_PRODUCE
#undef SCAN_YOUT
    }
}

__device__ __forceinline__ void lru_p1_phase(const Params& p) {
    unsigned char* ws = p.ws; const float* lam = (const float*)(ws + O_CL);
    float* PQ = (float*)(ws + O_PQ);
    const int tid = tidx(), lane = tid & 63, gw = blockIdx.x * 8 + (tid >> 6), ngw = gridDim.x * 8;
    for (int it = gw; it < 2 * 4 * 68 * 8; it += ngw) {
        const int cb8 = it & 7, j = (it >> 3) % 68, b = ((it >> 3) / 68) & 3, d = (it >> 3) / 272;
        const int c = cb8 * 128 + 2 * lane;
        const bf16_t* GR = (const bf16_t*)(ws + (d ? O_GRB : O_GRF)); const bf16_t* UU = (const bf16_t*)(ws + (d ? O_UB : O_UF));
        const float cl0 = lam[d * D + c], cl1 = lam[d * D + c + 1];
        float P0 = 1.f, P1 = 1.f, Q0 = 0.f, Q1 = 0.f;
        const int m0 = scan_row(b, d, 64 * j), sgn = d ? -1 : 1;
#pragma unroll 8
        for (int i = 0; i < 64; ++i) { const size_t off = (size_t)(m0 + sgn * i) * D + c;
            const unsigned g = *(const unsigned*)(GR + off), uv = *(const unsigned*)(UU + off);
            const float a0 = __expf(bflo(g) * cl0), a1 = __expf(bfhi(g) * cl1);
            P0 *= a0; P1 *= a1; Q0 = a0 * Q0 + bflo(uv); Q1 = a1 * Q1 + bfhi(uv); }
        const size_t o = ((size_t)((d * 4 + b) * 68 + j)) * D + c;
        *(f32x2*)(PQ + o) = (f32x2){P0, P1}; *(f32x2*)(PQ + (size_t)2 * 4 * 68 * D + o) = (f32x2){Q0, Q1};
    }
}
__device__ __forceinline__ void lru_p3_phase(const Params& p) {
    unsigned char* ws = p.ws; const float* lam = (const float*)(ws + O_CL);
    const float* PQ = (const float*)(ws + O_PQ); const float* QQ = PQ + (size_t)2 * 4 * 68 * D;
    bf16_t* HS = (bf16_t*)(ws + O_HSUM);
    const int tid = tidx(), lane = tid & 63, gw = blockIdx.x * 8 + (tid >> 6), ngw = gridDim.x * 8;
    for (int it = gw; it < 4 * 64 * 8; it += ngw) {
        const int cb8 = it & 7, T = (it >> 3) & 63, b = it >> 9, c = cb8 * 128 + 2 * lane;
        {
            const bf16_t* GR = (const bf16_t*)(ws + O_GRF); const bf16_t* UU = (const bf16_t*)(ws + O_UF);
            const float cl0 = lam[c], cl1 = lam[c + 1];
            float h0 = 0.f, h1 = 0.f;
#pragma unroll 4
            for (int jj = 0; jj < 4 + T; ++jj) { const size_t o = ((size_t)(b * 68 + jj)) * D + c; const f32x2 P = *(const f32x2*)(PQ + o), Q = *(const f32x2*)(QQ + o); h0 = P[0] * h0 + Q[0]; h1 = P[1] * h1 + Q[1]; }
            for (int i0 = 0; i0 < 64; i0 += 8) {
                unsigned g[8], uv[8];
#pragma unroll
                for (int i = 0; i < 8; ++i) { const size_t off = (size_t)(b * 4096 + 64 * T + i0 + i) * D + c; g[i] = *(const unsigned*)(GR + off); uv[i] = *(const unsigned*)(UU + off); }
#pragma unroll
                for (int i = 0; i < 8; ++i) { const size_t off = (size_t)(b * 4096 + 64 * T + i0 + i) * D + c;
                    h0 = __expf(bflo(g[i]) * cl0) * h0 + bflo(uv[i]); h1 = __expf(bfhi(g[i]) * cl1) * h1 + bfhi(uv[i]);
                    *(unsigned*)(HS + off) = pk2(h0, h1); }
            }
        }
        {
            const bf16_t* GR = (const bf16_t*)(ws + O_GRB); const bf16_t* UU = (const bf16_t*)(ws + O_UB);
            const float cl0 = lam[D + c], cl1 = lam[D + c + 1];
            float h0 = 0.f, h1 = 0.f;
#pragma unroll 4
            for (int jj = 0; jj < 67 - T; ++jj) { const size_t o = ((size_t)((4 + b) * 68 + jj)) * D + c; const f32x2 P = *(const f32x2*)(PQ + o), Q = *(const f32x2*)(QQ + o); h0 = P[0] * h0 + Q[0]; h1 = P[1] * h1 + Q[1]; }
            for (int i0 = 0; i0 < 64; i0 += 8) {
                unsigned g[8], uv[8], f[8];
#pragma unroll
                for (int i = 0; i < 8; ++i) { const size_t off = (size_t)(b * 4096 + 64 * T + 63 - i0 - i) * D + c; g[i] = *(const unsigned*)(GR + off); uv[i] = *(const unsigned*)(UU + off); f[i] = *(const unsigned*)(HS + off); }
#pragma unroll
                for (int i = 0; i < 8; ++i) { const size_t off = (size_t)(b * 4096 + 64 * T + 63 - i0 - i) * D + c;
                    h0 = __expf(bflo(g[i]) * cl0) * h0 + bflo(uv[i]); h1 = __expf(bfhi(g[i]) * cl1) * h1 + bfhi(uv[i]);
                    *(unsigned*)(HS + off) = pk2(bflo(f[i]) + h0, bfhi(f[i]) + h1); }
            }
        }
    }
}

#define XB_XCNT(j) (64 * (j))
#define XB_XSUB(j) (1024 + 64 * (j))
#define XB_XGEN(j) (2048 + 64 * (j))
#define XB_TOP 3072
#define XB_TOPGEN 3136
#define XB_WORDS 3200
__device__ __forceinline__ unsigned xb_ld(unsigned* p) { return __hip_atomic_load(p, __ATOMIC_RELAXED, __HIP_MEMORY_SCOPE_AGENT); }
__device__ __forceinline__ unsigned xb_add(unsigned* p, unsigned v) { return __hip_atomic_fetch_add(p, v, __ATOMIC_RELAXED, __HIP_MEMORY_SCOPE_AGENT); }
__device__ __forceinline__ void xb_st(unsigned* p, unsigned v) { __hip_atomic_store(p, v, __ATOMIC_RELAXED, __HIP_MEMORY_SCOPE_AGENT); }
struct XBar { unsigned* bar; unsigned x, nloc, nx, k; };
__device__ __forceinline__ void xbar_init(XBar& B, unsigned* bar) {
    B.bar = bar; B.x = (unsigned)__builtin_amdgcn_s_getreg((3 << 11) | 20) & 0xFu; B.nloc = 0u; B.nx = 0u; B.k = 0u;
    if (threadIdx.x == 0) (void)xb_add(&bar[XB_XCNT(B.x)], 1u);
}
__device__ __forceinline__ void gbar(XBar& B) {
    asm volatile("s_waitcnt vmcnt(0)" ::: "memory");
    __syncthreads();
    B.k += 1u;
    if (threadIdx.x == 0) {
        unsigned* bar = B.bar;
        if (B.nloc == 0u) {
            unsigned sum, cnt, mine;
            for (;;) { sum = 0u; cnt = 0u; mine = 0u;
#pragma unroll
                for (unsigned j = 0; j < 16; ++j) { const unsigned c = xb_ld(&bar[XB_XCNT(j)]); sum += c; cnt += (c > 0u) ? 1u : 0u; mine = (j == B.x) ? c : mine; }
                if (sum == gridDim.x) break;
                __builtin_amdgcn_s_sleep(1); }
            B.nloc = mine; B.nx = cnt;
        }
        const unsigned old = xb_add(&bar[XB_XSUB(B.x)], 1u);
        if (old + 1u == B.k * B.nloc) {
            __builtin_amdgcn_fence(__ATOMIC_RELEASE, "agent");
            asm volatile("s_waitcnt vmcnt(0)" ::: "memory");
            const unsigned t = xb_add(&bar[XB_TOP], 1u);
            if (t + 1u == B.k * B.nx) xb_st(&bar[XB_TOPGEN], B.k);
            else while (xb_ld(&bar[XB_TOPGEN]) < B.k) __builtin_amdgcn_s_sleep(1);
            xb_st(&bar[XB_XGEN(B.x)], B.k);
        } else {
            while (xb_ld(&bar[XB_XGEN(B.x)]) < B.k) __builtin_amdgcn_s_sleep(1);
        }
        __builtin_amdgcn_fence(__ATOMIC_ACQUIRE, "agent");
        asm volatile("s_waitcnt vmcnt(0)" ::: "memory");
    }
    __syncthreads();
}

__device__ __forceinline__ Gemm mk_gemm(const void* A, const void* Bt, int M, int N, int K, int lda, int ldb) { Gemm g; g.A = (const bf16_t*)A; g.Bt = (const bf16_t*)Bt; g.M = M; g.N = N; g.K = K; g.lda = lda; g.ldb = ldb; g.ksh = 0; g.kmask = 0; g.kmul = 0; return g; }

__global__ void __launch_bounds__(NTHREADS, 2) mega(Params p) {
    extern __shared__ __attribute__((aligned(16))) unsigned char shm[];
    LAS unsigned char* lds = (LAS unsigned char*)shm;
    LAS float* ldsf = (LAS float*)shm;
    cg::grid_group grid = cg::this_grid();
    unsigned char* ws = p.ws;
    float* mod = (float*)(ws + O_MOD);
    bf16_t* X1B = (bf16_t*)p.out;
    bf16_t* XNP = (bf16_t*)p.out + (size_t)MLAT * D;
    pg8::StaticOrder S;
    XBar XB; xbar_init(XB, (unsigned*)(ws + O_BAR));
#define BF(off) ((bf16_t*)(ws + (off)))
#define GSYNC() gbar(XB)
    if (p.ws == nullptr) grid.sync();
    cvt_run(p.in[7], DFF, D, DFF, BF(O_UP1), D, CV_UPI, 0, nullptr, ldsf);
    cvt_run(p.in[8], DFF, D, DFF, BF(O_UP1), D, CV_UPI, 1, nullptr, ldsf);
    cvt_run(p.in[9], D, DFF, D, BF(O_DN1), DFF, CV_PLAIN, 0, nullptr, ldsf);
    mod_phase(p, mod, ldsf);
    GSYNC();
    norm_phase(p.in[0], p.in[2], MALL, p.in[6], mod, 0, 1, BF(O_HN), D);
    GSYNC();
    { S.init(MALL, 2 * DFF, gridDim.x, blockIdx.x); EpiUp E{BF(O_U)}; pg8::gemm_phase(lds, mk_gemm(BF(O_HN), BF(O_UP1), MALL, 2 * DFF, D, D, D), S, E); }
    GSYNC();
    const bool fuse_ok = gridDim.x == 256;
    if (fuse_ok) { S.init(MLAT, D, gridDim.x, blockIdx.x); EpiDn1Norm E{p.in[0], X1B, BF(O_XNXS), XNP, mod, p.in[10], RowX{(unsigned*)(ws + O_XSLOT_C), (unsigned*)(ws + O_XCNT_C)}};
        pg8::gemm_phase(lds, mk_gemm(BF(O_U), BF(O_DN1), MLAT, D, DFF, DFF, DFF), S, E); }
    else { S.init(MLAT, D, gridDim.x, blockIdx.x); EpiRes<false, true> E{p.in[0], nullptr, nullptr, X1B, mod, 2, 0.5f}; pg8::gemm_phase(lds, mk_gemm(BF(O_U), BF(O_DN1), MLAT, D, DFF, DFF, DFF), S, E); }
    { const float* gate = mod + (size_t)4 * NMOD + 2 * D; const bf16_t* Uc = BF(O_U) + (size_t)MLAT * DFF;
      { S.init(MCTX, D, gridDim.x, blockIdx.x); EpiCtx E{p.in[2], (float*)(ws + O_CTXX1), gate, 0.5f}; pg8::gemm_phase(lds, mk_gemm(Uc, BF(O_DN1), MCTX, D, DFF / 2, DFF, DFF), S, E); }
      { S.init(MCTX, D, gridDim.x, ((int)blockIdx.x + (int)gridDim.x - 16) % (int)gridDim.x); EpiCtx E{nullptr, (float*)(ws + O_CTXP2), gate, 0.5f}; pg8::gemm_phase(lds, mk_gemm(Uc + DFF / 2, BF(O_DN1) + DFF / 2, MCTX, D, DFF / 2, DFF, DFF), S, E); } }
    { const int cnb = gridDim.x > 64 ? (int)gridDim.x - 32 : (int)gridDim.x, cbid = gridDim.x > 64 ? (int)blockIdx.x - 32 : (int)blockIdx.x;
      if (cbid >= 0) {
        cvt_run2(p.in[11], 7552, D, 3456, BF(O_RW), 2048, CV_RW, 0, p.in[12], ldsf, cbid, cnb);
        for (int d = 0; d < 2; ++d) { cvt_run2(p.in[14] + (size_t)d * 64 * D, D, 64, D, BF(O_LSCW) + (size_t)d * D * 64, 64, CV_PLAIN, 0, nullptr, ldsf, cbid, cnb);
                                      cvt_run2(p.in[16] + (size_t)d * 64 * D, D, 64, D, BF(O_LSCA) + (size_t)d * D * 64, 64, CV_PLAIN, 0, nullptr, ldsf, cbid, cnb); }
        cvt_run2(p.in[17], D, 128, D, BF(O_GUP), 256, CV_PLAIN, 0, nullptr, ldsf, cbid, cnb);
        cvt_run2(p.in[11] + 3456, 7552, D, D, BF(O_LX), D, CV_PLAIN, 0, nullptr, ldsf, cbid, cnb);
        for (int q = 0; q < 8; ++q) { cvt_run2(p.in[27] + (size_t)q * 65536, 256, 256, 256, BF(O_LRUW), 256, CV_LRU, q * 2 + 0, nullptr, ldsf, cbid, cnb);
                                      cvt_run2(p.in[29] + (size_t)q * 65536, 256, 256, 256, BF(O_LRUW), 256, CV_LRU, q * 2 + 1, nullptr, ldsf, cbid, cnb); }
      } }
    zero_fill(ws + O_RW + (size_t)3456 * 2048 * 2, 128 * 2048 * 2, 128 * 2048 * 2, 1);
    zero_fill(ws + O_GUP + 256, 256, 512, 1024);
    { const int t = tidx(); if (blockIdx.x == 20) for (int i = t; i < 2 * D; i += NTHREADS) ((float*)(ws + O_CL))[i] = -8.0f * log1pf(expf(-p.in[26][i])); }
    GSYNC();
    if (fuse_ok) {
        xs_phase(BF(O_XNXS), XNP, MLAT);
        xs_ctx_phase((const float*)(ws + O_CTXX1), (const float*)(ws + O_CTXP2), p.in[10], mod, BF(O_XNXS));
    } else {
        norm_phase<true>(p.in[0], (const float*)(ws + O_CTXX1), MALL, p.in[10], mod, 3, 4, BF(O_XNXS), 2048, (const float*)(ws + O_CTXP2), X1B, XNP, 0);
        GSYNC();
        xs_phase(BF(O_XNXS), nullptr, MALL);
    }
    GSYNC();
    { S.init(MALL, 3584, gridDim.x, blockIdx.x); EpiRw E{BF(O_R), BF(O_LIN), BF(O_GD)}; pg8::gemm_phase(lds, mk_gemm(BF(O_XNXS), BF(O_RW), MALL, 3584, 2048, 2048, 2048), S, E); }
    { const int sh = ((MALL / 256) * 14) % (int)gridDim.x; S.init(MCTX, D, gridDim.x, ((int)blockIdx.x + (int)gridDim.x - sh) % (int)gridDim.x); EpiBf E{BF(O_PLXC), D};
      pg8::gemm_phase(lds, mk_gemm(BF(O_XNXS) + (size_t)MLAT * 2048, BF(O_LX), MCTX, D, D, 2048, D), S, E); }
    GSYNC();
    rncb_phase(BF(O_R), BF(O_K), p.in[18], p.in[20], (float*)(ws + O_RN), (float*)(ws + O_CB));
    cvt_run(p.in[11] + 4480, 7552, D, 3072, BF(O_LATE), D, CV_PLAIN, 0, nullptr, ldsf);
    cvt_run(p.in[23], D, D, D, BF(O_PRW), D, CV_PLAIN, 0, nullptr, ldsf);
    cvt_run(p.in[31], D, D, D, BF(O_PLRU), D, CV_PLAIN, 0, nullptr, ldsf);
    cvt_run(p.in[32], D, D, D, BF(O_WOUT), D, CV_PLAIN, 0, nullptr, ldsf);
    cvt_run(p.in[36], D, DFF, D, BF(O_DN2), DFF, CV_PLAIN, 0, nullptr, ldsf);
    GSYNC();
    rwkv_scan_phase(p, ldsf);
    GSYNC();
    if (gridDim.x == 256) {
        S.init(MLAT, D, gridDim.x, blockIdx.x); EpiPostG E{BF(O_YF), BF(O_YB), BF(O_V), (const float*)(ws + O_CB), p.in[21], p.in[22]};
        pg8::gemm_phase(lds, mk_gemm(BF(O_GD), BF(O_GUP), MLAT, D, 256, 256, 256), S, E);
    } else {
        post_phase(BF(O_YF), BF(O_YB), BF(O_V), (const float*)(ws + O_CB), p.in[21], p.in[22]);
        GSYNC();
        { S.init(MLAT, D, gridDim.x, blockIdx.x); EpiMul E{BF(O_YF), nullptr, 0}; pg8::gemm_phase(lds, mk_gemm(BF(O_GD), BF(O_GUP), MLAT, D, 256, 256, 256), S, E); }
    }
    { S.init(MLAT, D, gridDim.x, blockIdx.x); EpiBf E{BF(O_PLX), D}; pg8::gemm_phase(lds, mk_gemm(XNP, BF(O_LX), MLAT, D, D, D, D), S, E); }
    GSYNC();
    conv_phase(BF(O_PLX), BF(O_PLXC), BF(O_XC), p.in[24], p.in[25]);
    GSYNC();
    { S.init(MALL, 4096, gridDim.x, blockIdx.x); EpiLru E{BF(O_XC), BF(O_GRF), BF(O_UF), BF(O_GRB), BF(O_UB), p.in[28], p.in[30], (const float*)(ws + O_CL)};
      Gemm g = mk_gemm(BF(O_XC), BF(O_LRUW), MALL, 4096, 256, D, 256); g.ksh = 1; g.kmask = 3; g.kmul = 256; pg8::gemm_phase(lds, g, S, E); }
    GSYNC();
    lru_p1_phase(p);
    cvt_run(p.in[34], DFF, D, DFF, BF(O_UP2), D, CV_UPI, 0, nullptr, ldsf);
    cvt_run(p.in[35], DFF, D, DFF, BF(O_UP2), D, CV_UPI, 1, nullptr, ldsf);
    GSYNC();
    lru_p3_phase(p);
    GSYNC();
    { S.init(MLAT, 3072, gridDim.x, blockIdx.x); EpiLate E{BF(O_HSUM), BF(O_SMRW), BF(O_SMLRU)}; pg8::gemm_phase(lds, mk_gemm(XNP, BF(O_LATE), MLAT, 3072, D, D, D), S, E); }
    GSYNC();
    { S.init(MLAT, D, gridDim.x, blockIdx.x); EpiMul E{BF(O_SMRW), nullptr, 0}; pg8::gemm_phase(lds, mk_gemm(BF(O_YF), BF(O_PRW), MLAT, D, D, D, D), S, E); }
    { S.init(MLAT, D, gridDim.x, blockIdx.x); EpiMul E{BF(O_SMRW), BF(O_SMLRU), 1}; pg8::gemm_phase(lds, mk_gemm(BF(O_HSUM), BF(O_PLRU), MLAT, D, D, D, D), S, E); }
    GSYNC();
    if (gridDim.x == 256) {
        S.init(MLAT, D, gridDim.x, blockIdx.x); EpiOutNorm E{X1B, BF(O_X2B), BF(O_HN2), mod, p.in[33], RowX{(unsigned*)(ws + O_XSLOT_B), (unsigned*)(ws + O_XCNT_B)}};
        pg8::gemm_phase(lds, mk_gemm(BF(O_SMRW), BF(O_WOUT), MLAT, D, D, D, D), S, E);
        GSYNC();
    } else {
        { S.init(MLAT, D, gridDim.x, blockIdx.x); EpiRes<true, true> E{nullptr, X1B, nullptr, BF(O_X2B), mod, 5, 1.0f}; pg8::gemm_phase(lds, mk_gemm(BF(O_SMRW), BF(O_WOUT), MLAT, D, D, D, D), S, E); }
        GSYNC();
        norm_phase<true>(p.in[0], (const float*)(ws + O_CTXX1), MLAT, p.in[33], mod, 6, 7, BF(O_HN2), D, nullptr, BF(O_X2B));
        GSYNC();
    }
    { S.init(MLAT, 2 * DFF, gridDim.x, blockIdx.x); EpiUp E{BF(O_U2)}; pg8::gemm_phase(lds, mk_gemm(BF(O_HN2), BF(O_UP2), MLAT, 2 * DFF, D, D, D), S, E); }
    GSYNC();
    if (gridDim.x == 256) {
        S.init(MLAT, D, gridDim.x, blockIdx.x); EpiFinalNorm E{BF(O_X2B), p.out, mod, p.in[37], RowX{(unsigned*)(ws + O_XSLOT_A), (unsigned*)(ws + O_XCNT_A)}};
        pg8::gemm_phase(lds, mk_gemm(BF(O_U2), BF(O_DN2), MLAT, D, DFF, DFF, DFF), S, E);
    } else {
        { S.init(MLAT, D, gridDim.x, blockIdx.x); EpiRes<true, false> E{nullptr, BF(O_X2B), p.out, nullptr, mod, 8, 0.5f}; pg8::gemm_phase(lds, mk_gemm(BF(O_U2), BF(O_DN2), MLAT, D, DFF, DFF, DFF), S, E); }
        GSYNC();
        final_norm_phase(p.out, p.in[37]);
    }
}

extern "C" void kernel_launch(void* const* d_in, const int* in_sizes, int n_in, void* d_out, int out_size, void* d_ws, size_t ws_size, hipStream_t stream) {
    static int grid = 0;
    if (grid == 0) {
        if (n_in != 38 || out_size != MLAT * D || ws_size < WS_NEED) { fprintf(stderr, "kernel_launch: unexpected shapes (n_in %d, out %d, ws %zu); nothing launched\n", n_in, out_size, ws_size); grid = -1; return; }
        int dev = 0, cus = 0, per_cu = 0;
        hipGetDevice(&dev);
        hipDeviceGetAttribute(&cus, hipDeviceAttributeMultiprocessorCount, dev);
        if (hipFuncSetAttribute((const void*)mega, hipFuncAttributeMaxDynamicSharedMemorySize, LDS_BYTES) != hipSuccess) { fprintf(stderr, "kernel_launch: hipFuncSetAttribute failed\n"); grid = -1; return; }
        if (hipOccupancyMaxActiveBlocksPerMultiprocessor(&per_cu, (const void*)mega, NTHREADS, LDS_BYTES) != hipSuccess || per_cu < 1) { fprintf(stderr, "kernel_launch: occupancy query failed (%d)\n", per_cu); per_cu = 1; }
        (void)hipGetLastError();
        grid = cus * (per_cu > 1 ? 1 : per_cu);
    }
    if (grid < 0) return;
    Params p{};
    for (int i = 0; i < 38; ++i) p.in[i] = (const float*)d_in[i];
    p.out = (float*)d_out; p.ws = (unsigned char*)d_ws;
    if (hipMemsetAsync((unsigned char*)d_ws + O_BAR, 0, 65536, stream) != hipSuccess) { fprintf(stderr, "kernel_launch: memset failed\n"); return; }
    void* args[] = {&p};
    hipError_t e = hipLaunchCooperativeKernel((const void*)mega, dim3(grid), dim3(NTHREADS), args, LDS_BYTES, stream);
    if (e != hipSuccess) fprintf(stderr, "kernel_launch: cooperative launch failed: %s (grid %d)\n", hipGetErrorString(e), grid);
}
```

```cpp
#include <hip/hip_runtime.h>
#include <hip/hip_cooperative_groups.h>
#include <cstdio>
#include <cstdint>
namespace cg = cooperative_groups;

#define LAS __attribute__((address_space(3)))
typedef unsigned short bf16_t;
typedef short bf16x8 __attribute__((ext_vector_type(8)));
typedef float f32x4 __attribute__((ext_vector_type(4)));
typedef float f32x2 __attribute__((ext_vector_type(2)));
typedef unsigned u32x4 __attribute__((ext_vector_type(4)));
typedef unsigned u32x2 __attribute__((ext_vector_type(2)));

constexpr int D = 1024, DFF = 2816, MLAT = 16384, MCTX = 1024, MALL = 17408, NMOD = 9216;
constexpr int NTHREADS = 512, LDS_BYTES = 131072;
constexpr size_t MiB = 1048576;
constexpr size_t W0 = 0, W1 = 18 * MiB, SP = 34 * MiB, ACT = 50 * MiB;
constexpr size_t O_UP1 = W0, O_RW = W0, O_LATE = W0, O_PRW = W0 + 6 * MiB, O_PLRU = W0 + 8 * MiB, O_WOUT = W0 + 10 * MiB, O_DN2 = W0 + 12 * MiB;
constexpr size_t O_DN1 = W1 + 10 * MiB, O_LSCW = W1, O_LSCA = W1 + 256 * 1024, O_GUP = W1 + 512 * 1024, O_LX = W1 + 1 * MiB, O_LRUW = W1 + 3 * MiB, O_UP2 = W1;
constexpr size_t O_MOD = SP, O_RN = SP + 256 * 1024, O_CB = O_RN + 1280 * 1024, O_PQ = SP + 3 * MiB, O_CTXX1 = SP + 8 * MiB, O_CL = SP + 12 * MiB, O_BAR = SP + 13 * MiB, O_PLXC = SP + 14 * MiB, O_XCNT_B = SP + 13 * MiB + 16384, O_XCNT_A = SP + 13 * MiB + 32768, O_XSLOT_B = SP + 15 * MiB, O_XSLOT_A = SP + 15 * MiB + 262144, O_XCNT_C = SP + 13 * MiB + 49152, O_XSLOT_C = SP + 15 * MiB + 524288, O_CTXP2 = ACT + 200 * MiB, O_X2B = ACT + 136 * MiB;
constexpr size_t O_HN = ACT, O_U = ACT + 34 * MiB;
constexpr size_t O_XNXS = ACT, O_R = ACT + 68 * MiB, O_K = ACT + 102 * MiB, O_V = ACT + 136 * MiB, O_LIN = ACT + 170 * MiB, O_GD = ACT + 178 * MiB + 512 * 1024;
constexpr size_t O_YF = ACT, O_YB = ACT + 32 * MiB, O_XN2 = ACT + 68 * MiB, O_PLX = ACT + 102 * MiB, O_XC = ACT + 136 * MiB;
constexpr size_t O_GRF = ACT + 32 * MiB, O_UF = ACT + 66 * MiB, O_GRB = ACT + 100 * MiB, O_UB = ACT + 170 * MiB;
constexpr size_t O_HSUM = ACT + 136 * MiB, O_XN3 = ACT + 32 * MiB, O_SMRW = ACT + 66 * MiB, O_SMLRU = ACT + 98 * MiB;
constexpr size_t O_HN2 = ACT, O_U2 = ACT + 34 * MiB;
constexpr size_t WS_NEED = 256 * MiB;

struct Params { const float* in[38]; float* out; unsigned char* ws; };

__device__ __forceinline__ float bf2f(unsigned short b) { return __uint_as_float(((unsigned)b) << 16); }
__device__ __forceinline__ float bflo(unsigned u) { return __uint_as_float(u << 16); }
__device__ __forceinline__ float bfhi(unsigned u) { return __uint_as_float(u & 0xffff0000u); }
typedef __bf16 bf16x2_t __attribute__((ext_vector_type(2)));
__device__ __forceinline__ unsigned pk2(float lo, float hi) { const f32x2 v = {lo, hi}; const bf16x2_t b = __builtin_convertvector(v, bf16x2_t); return __builtin_bit_cast(unsigned, b); }
__device__ __forceinline__ int tidx() { int t = threadIdx.x; asm volatile("" : "+v"(t)); return t; }
__device__ __forceinline__ float frcp(float x) { return __builtin_amdgcn_rcpf(x); }
__device__ __forceinline__ float sigm(float x) { return frcp(1.0f + __expf(-x)); }
__device__ __forceinline__ float tanh_f(float x) { return 1.0f - 2.0f * frcp(__expf(2.0f * x) + 1.0f); }
__device__ __forceinline__ float silu_f(float x) { return x * sigm(x); }
__device__ __forceinline__ float gelu_f(float x) { return x * sigm(1.5957691216f * (x + 0.044715f * x * x * x)); }
__device__ __forceinline__ float wave_sum(float v) {
#pragma unroll
    for (int o = 1; o < 64; o <<= 1) v += __shfl_xor(v, o);
    return v;
}
template <int CTRL> __device__ __forceinline__ float dppf(float v) {
    return __builtin_bit_cast(float, __builtin_amdgcn_update_dpp(0, __builtin_bit_cast(int, v), CTRL, 0xF, 0xF, true));
}
__device__ __forceinline__ float red16(float v) {
    v += dppf<0xB1>(v); v += dppf<0x4E>(v); v += dppf<0x141>(v); v += dppf<0x140>(v); return v;
}

namespace pg8 {
constexpr int BM = 256, BK = 64, HALF = 128, HTB = HALF * BK * 2, NXCD = 8, WGM = 8;
__device__ __forceinline__ int lds_byte(int r, int c) { const int st = (r >> 4) * 2 + (c >> 5), rr = r & 15, cc = c & 31, ob = rr * 64 + cc * 2; return st * 1024 + (ob ^ (((ob >> 9) & 1) << 5)); }
__device__ __forceinline__ void stage_rc(int b, int& R, int& C) { const int st = b / 1024, sb = b % 1024, swz = sb ^ (((sb >> 9) & 1) << 5); R = (st >> 1) * 16 + swz / 64; C = (st & 1) * 32 + (swz % 64) / 2; }
struct Unit { int pm, pn; };
struct Gemm { const bf16_t* A; const bf16_t* Bt; int M, N, K, lda, ldb, ksh, kmask, kmul; };
struct StaticOrder {
    int nM, nN, nwg, G, c;
    __device__ void init(int M, int N, int G_, int c_) { nM = M / BM; nN = N / BM; nwg = nM * nN; G = G_; c = c_; }
    __device__ bool next(int i, Unit& u) const {
        const long L = (long)i * G + c; if (L >= nwg) return false;
        int wgid = (int)L; { const int q = nwg / NXCD, r = nwg % NXCD, xcd = wgid % NXCD, off = wgid / NXCD; wgid = (xcd < r ? xcd * (q + 1) : r * (q + 1) + (xcd - r) * q) + off; }
        const int nig = WGM * nN, gid = wgid / nig, fm = gid * WGM, gsz = (nM - fm) < WGM ? (nM - fm) : WGM;
        u.pm = fm + ((wgid % nig) % gsz); u.pn = (wgid % nig) / gsz; return true;
    }
};

template <class E, class = void> struct is_ad { static constexpr bool value = false; };
template <class E> struct is_ad<E, decltype((void)E::AFTER_DRAIN)> { static constexpr bool value = true; };

template <class Epi>
__device__ __forceinline__ void gemm_phase(LAS unsigned char* lds, const Gemm g, const StaticOrder& S, const Epi& E) {
    const int tid = tidx(), wid = __builtin_amdgcn_readfirstlane(tid >> 6), lane = tid & 63, wr = wid >> 2, wc = wid & 3, fr = lane & 15, fq = lane >> 4;
    const int K = g.K, nt = K / BK;
    unsigned voffA[2], voffB[2];
#pragma unroll
    for (int i = 0; i < 2; ++i) { int R, C; stage_rc(tid * 16 + i * 8192, R, C);
        voffA[i] = (unsigned)(R * g.lda + C) * 2u; voffB[i] = (unsigned)(R * g.ldb + C) * 2u; }
    const size_t kstep = (size_t)(BK * 2);
    const size_t hstepA = (size_t)HALF * g.lda * 2, hstepB = (size_t)HALF * g.ldb * 2;
    const size_t tstepA = 2 * hstepA, tstepB = 2 * hstepB;
    const unsigned ldsw = (unsigned)wid * 1024u;
    const int aoff = lds_byte(wr * 64 + fr, fq * 8), boff = lds_byte(wc * 32 + fr, fq * 8);
#define PG8_SA(b, h) (((b) * 2 + (h)) * HTB)
#define PG8_SB(b, h) ((4 + (b) * 2 + (h)) * HTB)
#define PG8_STAGE(bufoff, gbase, voff) do { _Pragma("unroll") for (int _i = 0; _i < 2; ++_i) \
        __builtin_amdgcn_global_load_lds((const unsigned*)((const char*)(gbase) + (voff)[_i]), (LAS unsigned*)(lds + (bufoff) + ldsw + _i * 8192), 16, 0, 0); } while (0)
#define PG8_LDA(dst, b, h) do { _Pragma("unroll") for (int m = 0; m < 4; ++m) _Pragma("unroll") for (int k = 0; k < 2; ++k) dst[m][k] = *(const LAS bf16x8*)(lds + PG8_SA(b, h) + aoff + m * 2048 + k * 1024); } while (0)
#define PG8_LDB(dst, b, h) do { _Pragma("unroll") for (int n = 0; n < 2; ++n) _Pragma("unroll") for (int k = 0; k < 2; ++k) dst[n][k] = *(const LAS bf16x8*)(lds + PG8_SB(b, h) + boff + n * 2048 + k * 1024); } while (0)
#define PG8_MMA(ai, bj, At, Bt) do { __builtin_amdgcn_s_setprio(1); _Pragma("unroll") for (int m = 0; m < 4; ++m) _Pragma("unroll") for (int n = 0; n < 2; ++n) _Pragma("unroll") for (int k = 0; k < 2; ++k) \
        acc[ai][bj][m][n] = __builtin_amdgcn_mfma_f32_16x16x32_bf16(Bt[n][k], At[m][k], acc[ai][bj][m][n], 0, 0, 0); __builtin_amdgcn_s_setprio(0); } while (0)
#define PG8_WAIT_V(n) asm volatile("s_waitcnt vmcnt(" #n ")" ::: "memory")
#define PG8_WAIT_L(n) asm volatile("s_waitcnt lgkmcnt(" #n ")" ::: "memory")
#define PG8_BAR __builtin_amdgcn_s_barrier()
#define PG8_SCHED __builtin_amdgcn_sched_barrier(0)
#define PG8_KOFF(u) ((size_t)((((u).pn >> g.ksh) & g.kmask) * g.kmul) * 2)
    Unit cur, nxt; int ui = 0;
    if (!S.next(0, cur)) return;
    f32x4 acc[2][2][4][2];
#pragma unroll
    for (int a = 0; a < 2; ++a)
#pragma unroll
        for (int b = 0; b < 2; ++b)
#pragma unroll
            for (int m = 0; m < 4; ++m)
#pragma unroll
                for (int n = 0; n < 2; ++n) acc[a][b][m][n] = (f32x4){0.f, 0.f, 0.f, 0.f};
    bf16x8 At[4][2], B0[2][2], B1[2][2];
    const char* cA = (const char*)g.A + (size_t)cur.pm * tstepA + PG8_KOFF(cur); const char* cB = (const char*)g.Bt + (size_t)cur.pn * tstepB;
    PG8_STAGE(PG8_SB(0, 0), cB, voffB); PG8_STAGE(PG8_SA(0, 0), cA, voffA); PG8_STAGE(PG8_SB(0, 1), cB + hstepB, voffB); PG8_STAGE(PG8_SA(0, 1), cA + hstepA, voffA);
    if (wr == 1) PG8_BAR;
    PG8_WAIT_V(4); PG8_BAR;
    PG8_STAGE(PG8_SB(1, 0), cB + kstep, voffB); PG8_STAGE(PG8_SA(1, 0), cA + kstep, voffA); PG8_STAGE(PG8_SB(1, 1), cB + hstepB + kstep, voffB);
    PG8_WAIT_V(6); PG8_BAR;
    for (;;) {
        const bool has_next = S.next(ui + 1, nxt);
        const char* nA = has_next ? (const char*)g.A + (size_t)nxt.pm * tstepA + PG8_KOFF(nxt) : cA; const char* nB = has_next ? (const char*)g.Bt + (size_t)nxt.pn * tstepB : cB;
        for (int t = 0; t < nt; t += 2) {
            const bool last = (t == nt - 2);
            const char* a1 = cA + (size_t)(t + 1) * kstep;
            const char* a2 = last ? nA : cA + (size_t)(t + 2) * kstep; const char* b2 = last ? nB : cB + (size_t)(t + 2) * kstep;
            const char* a3 = a2 + kstep; const char* b3 = b2 + kstep;
            PG8_LDB(B0, 0, 0); PG8_SCHED; PG8_LDA(At, 0, 0); PG8_STAGE(PG8_SA(1, 1), a1 + hstepA, voffA);
            PG8_WAIT_L(8); PG8_BAR; PG8_WAIT_L(0); PG8_MMA(0, 0, At, B0); PG8_BAR; PG8_SCHED;
            PG8_LDB(B1, 0, 1); PG8_STAGE(PG8_SB(0, 0), b2, voffB);
            PG8_BAR; PG8_WAIT_L(0); PG8_MMA(0, 1, At, B1); PG8_BAR;
            PG8_LDA(At, 0, 1); PG8_STAGE(PG8_SA(0, 0), a2, voffA);
            PG8_BAR; PG8_WAIT_L(0); PG8_MMA(1, 0, At, B0); PG8_BAR; PG8_SCHED;
            PG8_STAGE(PG8_SB(0, 1), b2 + hstepB, voffB);
            PG8_WAIT_V(6); PG8_BAR; PG8_MMA(1, 1, At, B1); PG8_BAR;
            PG8_LDB(B0, 1, 0); PG8_SCHED; PG8_LDA(At, 1, 0); PG8_STAGE(PG8_SA(0, 1), a2 + hstepA, voffA);
            PG8_WAIT_L(8); PG8_BAR; PG8_WAIT_L(0); PG8_MMA(0, 0, At, B0); PG8_BAR; PG8_SCHED;
            PG8_LDB(B1, 1, 1); PG8_STAGE(PG8_SB(1, 0), b3, voffB);
            PG8_BAR; PG8_WAIT_L(0); PG8_MMA(0, 1, At, B1); PG8_BAR;
            PG8_LDA(At, 1, 1); PG8_STAGE(PG8_SA(1, 0), a3, voffA);
            PG8_BAR; PG8_WAIT_L(0); PG8_MMA(1, 0, At, B0); PG8_BAR; PG8_SCHED;
            PG8_STAGE(PG8_SB(1, 1), b3 + hstepB, voffB);
            PG8_WAIT_V(6); PG8_BAR; PG8_MMA(1, 1, At, B1); PG8_BAR;
        }
        if constexpr (!is_ad<Epi>::value) E(acc, cur, wr, wc, fr, fq);
        if (!has_next) break;
#pragma unroll
        for (int a = 0; a < 2; ++a)
#pragma unroll
            for (int b = 0; b < 2; ++b)
#pragma unroll
                for (int m = 0; m < 4; ++m)
#pragma unroll
                    for (int n = 0; n < 2; ++n) acc[a][b][m][n] = (f32x4){0.f, 0.f, 0.f, 0.f};
        cur = nxt; cA = nA; cB = nB; ++ui;
    }
    PG8_WAIT_V(0);
    if (wr == 0) PG8_BAR;
    PG8_BAR;
    if constexpr (is_ad<Epi>::value) E.fused(acc, cur, wr, wc, fr, fq, lds, wid, lane);
#undef PG8_SA
#undef PG8_SB
#undef PG8_STAGE
#undef PG8_LDA
#undef PG8_LDB
#undef PG8_MMA
#undef PG8_WAIT_V
#undef PG8_WAIT_L
#undef PG8_BAR
#undef PG8_SCHED
#undef PG8_KOFF
}
}
using pg8::Unit;
using pg8::Gemm;

#define EPI_ROWS(...) _Pragma("unroll") for (int ai = 0; ai < 2; ++ai) _Pragma("unroll") for (int m = 0; m < 4; ++m) { const int row = u.pm * 256 + ai * 128 + wr * 64 + m * 16 + fr; __VA_ARGS__ }
#define EPI_ALL(...) _Pragma("unroll") for (int ai = 0; ai < 2; ++ai) _Pragma("unroll") for (int m = 0; m < 4; ++m) _Pragma("unroll") for (int bj = 0; bj < 2; ++bj) _Pragma("unroll") for (int n = 0; n < 2; ++n) { \
        const int row = u.pm * 256 + ai * 128 + wr * 64 + m * 16 + fr; __VA_ARGS__ }
typedef const f32x4 (&AccRef)[2][2][4][2];

struct EpiUp {
    bf16_t* U;
    __device__ __forceinline__ void operator()(AccRef acc, const Unit& u, int wr, int wc, int fr, int fq) const {
        EPI_ROWS(
            _Pragma("unroll") for (int bj = 0; bj < 2; ++bj) {
                const f32x4 g = acc[ai][bj][m][0], v = acc[ai][bj][m][1];
                const int f0 = ((u.pn * 256 + bj * 128 + wc * 32) >> 1) + 4 * fq;
                u32x2 o; o.x = pk2(silu_f(g[0]) * v[0], silu_f(g[1]) * v[1]); o.y = pk2(silu_f(g[2]) * v[2], silu_f(g[3]) * v[3]);
                *(u32x2*)(U + (size_t)row * DFF + f0) = o; }
        )
    }
};
template <bool RB, bool OB> struct EpiRes {
    const float* res_f; const bf16_t* res_b; float* out_f; bf16_t* out_b; const float* mod; int gidx; float scale;
    __device__ __forceinline__ void operator()(AccRef acc, const Unit& u, int wr, int wc, int fr, int fq) const {
        u32x2 tv[2][4][2][2];
        if constexpr (RB) { EPI_ALL( const int col = u.pn * 256 + bj * 128 + wc * 32 + n * 16 + 4 * fq; tv[ai][m][bj][n] = *(const u32x2*)(res_b + (size_t)row * D + col); ) }
        EPI_ROWS(
            const float* gp = mod + (size_t)(row >> 12) * NMOD + gidx * D;
            _Pragma("unroll") for (int bj = 0; bj < 2; ++bj) _Pragma("unroll") for (int n = 0; n < 2; ++n) {
                const int col = u.pn * 256 + bj * 128 + wc * 32 + n * 16 + 4 * fq; const size_t off = (size_t)row * D + col;
                f32x4 r;
                if constexpr (RB) { const u32x2 t = tv[ai][m][bj][n]; r = (f32x4){bflo(t.x), bfhi(t.x), bflo(t.y), bfhi(t.y)}; } else r = *(const f32x4*)(res_f + off);
                const f32x4 gt = *(const f32x4*)(gp + col);
                const f32x4 o = r + scale * gt * acc[ai][bj][m][n];
                if constexpr (OB) { u32x2 w; w.x = pk2(o[0], o[1]); w.y = pk2(o[2], o[3]); *(u32x2*)(out_b + off) = w; } else *(f32x4*)(out_f + off) = o; }
        )
    }
};
struct EpiCtx {
    const float* res; float* out; const float* gate; float scale;
    __device__ __forceinline__ void operator()(AccRef acc, const Unit& u, int wr, int wc, int fr, int fq) const {
        EPI_ROWS(
            _Pragma("unroll") for (int bj = 0; bj < 2; ++bj) _Pragma("unroll") for (int n = 0; n < 2; ++n) {
                const int col = u.pn * 256 + bj * 128 + wc * 32 + n * 16 + 4 * fq; const size_t off = (size_t)row * D + col;
                const f32x4 gt = *(const f32x4*)(gate + col); f32x4 r = (f32x4){0.f, 0.f, 0.f, 0.f};
                if (res) r = *(const f32x4*)(res + off);
                *(f32x4*)(out + off) = r + scale * gt * acc[ai][bj][m][n]; }
        )
    }
};
struct EpiRw {
    bf16_t *RKV, *LIN, *GD;
    __device__ __forceinline__ void operator()(AccRef acc, const Unit& u, int wr, int wc, int fr, int fq) const {
        const int pn = u.pn;
        if (pn < 12) {
            bf16_t* base = RKV + (size_t)(pn >> 2) * ((size_t)MALL * D) + (pn & 3) * 256;
            EPI_ROWS(
                _Pragma("unroll") for (int bj = 0; bj < 2; ++bj) _Pragma("unroll") for (int n = 0; n < 2; ++n) {
                    const int cl = bj * 128 + wc * 32 + n * 16 + 4 * fq; const f32x4 a = acc[ai][bj][m][n];
                    u32x2 o; o.x = pk2(a[0], a[1]); o.y = pk2(a[2], a[3]);
                    *(u32x2*)(base + (size_t)row * D + cl) = o; }
            )
        } else if (pn == 12) {
            EPI_ROWS(
                _Pragma("unroll") for (int bj = 0; bj < 2; ++bj) _Pragma("unroll") for (int n = 0; n < 2; ++n) {
                    const int cl = bj * 128 + wc * 32 + n * 16 + 4 * fq; f32x4 a = acc[ai][bj][m][n];
                    if (bj == 0) { a[0] = tanh_f(a[0]); a[1] = tanh_f(a[1]); a[2] = tanh_f(a[2]); a[3] = tanh_f(a[3]); }
                    u32x2 o; o.x = pk2(a[0], a[1]); o.y = pk2(a[2], a[3]);
                    *(u32x2*)(LIN + (size_t)row * 256 + cl) = o; }
            )
        } else {
            EPI_ROWS(
                _Pragma("unroll") for (int bj = 0; bj < 2; ++bj) _Pragma("unroll") for (int n = 0; n < 2; ++n) {
                    const int cl = bj * 128 + wc * 32 + n * 16 + 4 * fq; const f32x4 a = acc[ai][bj][m][n];
                    u32x2 o; o.x = 0u; o.y = 0u;
                    if (bj == 0) { o.x = pk2(sigm(a[0]), sigm(a[1])); o.y = pk2(sigm(a[2]), sigm(a[3])); }
                    *(u32x2*)(GD + (size_t)row * 256 + cl) = o; }
            )
        }
    }
};
struct EpiBf {
    bf16_t* O; int ldo;
    __device__ __forceinline__ void operator()(AccRef acc, const Unit& u, int wr, int wc, int fr, int fq) const {
        EPI_ROWS(
            _Pragma("unroll") for (int bj = 0; bj < 2; ++bj) _Pragma("unroll") for (int n = 0; n < 2; ++n) {
                const int col = u.pn * 256 + bj * 128 + wc * 32 + n * 16 + 4 * fq; const f32x4 a = acc[ai][bj][m][n];
                u32x2 o; o.x = pk2(a[0], a[1]); o.y = pk2(a[2], a[3]);
                *(u32x2*)(O + (size_t)row * ldo + col) = o; }
        )
    }
};
struct EpiMul {
    bf16_t* T; const bf16_t* S2; int mode;
    __device__ __forceinline__ void operator()(AccRef acc, const Unit& u, int wr, int wc, int fr, int fq) const {
        u32x2 tv[2][4][2][2];
        EPI_ALL( const int col = u.pn * 256 + bj * 128 + wc * 32 + n * 16 + 4 * fq; tv[ai][m][bj][n] = *(const u32x2*)(T + (size_t)row * D + col); )
        if (mode == 0) {
            EPI_ALL( const int col = u.pn * 256 + bj * 128 + wc * 32 + n * 16 + 4 * fq; const f32x4 a = acc[ai][bj][m][n]; const u32x2 t = tv[ai][m][bj][n]; u32x2 o;
                o.x = pk2(bflo(t.x) * a[0], bfhi(t.x) * a[1]); o.y = pk2(bflo(t.y) * a[2], bfhi(t.y) * a[3]);
                *(u32x2*)(T + (size_t)row * D + col) = o; )
        } else {
            u32x2 sv[2][4][2][2];
            EPI_ALL( const int col = u.pn * 256 + bj * 128 + wc * 32 + n * 16 + 4 * fq; sv[ai][m][bj][n] = *(const u32x2*)(S2 + (size_t)row * D + col); )
            EPI_ALL( const int col = u.pn * 256 + bj * 128 + wc * 32 + n * 16 + 4 * fq; const f32x4 a = acc[ai][bj][m][n]; const u32x2 t = tv[ai][m][bj][n]; const u32x2 q = sv[ai][m][bj][n]; u32x2 o;
                o.x = pk2(bflo(t.x) + bflo(q.x) * a[0], bfhi(t.x) + bfhi(q.x) * a[1]); o.y = pk2(bflo(t.y) + bflo(q.y) * a[2], bfhi(t.y) + bfhi(q.y) * a[3]);
                *(u32x2*)(T + (size_t)row * D + col) = o; )
        }
    }
};
struct EpiLru {
    const bf16_t* XC; bf16_t *GR0, *U0, *GR1, *U1; const float *ba, *bx, *cl;
    __device__ __forceinline__ void operator()(AccRef acc, const Unit& u, int wr, int wc, int fr, int fq) const {
        const int d = u.pn >> 3, pn8 = u.pn & 7;
        bf16_t* GR = GR0 + (size_t)d * ((size_t)(O_GRB - O_GRF) / 2); bf16_t* UU = U0 + (size_t)d * ((size_t)(O_UB - O_UF) / 2);
#pragma unroll
        for (int bj = 0; bj < 2; ++bj) { const int c0 = 128 * pn8 + 16 * (4 * bj + wc) + 4 * fq;
            const f32x4 vba = *(const f32x4*)(ba + d * D + c0), vbx = *(const f32x4*)(bx + d * D + c0), vcl = *(const f32x4*)(cl + d * D + c0);
            u32x2 xv[2][4];
            EPI_ROWS( xv[ai][m] = *(const u32x2*)(XC + (size_t)row * D + c0); )
            EPI_ROWS(
                const size_t off = (size_t)row * D + c0;
                const u32x2 xcv = xv[ai][m];
                const float xc[4] = {bflo(xcv.x), bfhi(xcv.x), bflo(xcv.y), bfhi(xcv.y)};
                float gr[4]; float uu[4];
                _Pragma("unroll") for (int j = 0; j < 4; ++j) {
                    gr[j] = sigm(acc[ai][bj][m][0][j] + vba[j]);
                    const float gi = sigm(acc[ai][bj][m][1][j] + vbx[j]);
                    const float x = 2.0f * gr[j] * vcl[j];
                    const float om = -x * (1.0f + 0.5f * x * (1.0f + (1.0f / 3.0f) * x * (1.0f + 0.25f * x)));
                    uu[j] = __builtin_amdgcn_sqrtf(om) * gi * xc[j]; }
                u32x2 o1; u32x2 o2; o1.x = pk2(gr[0], gr[1]); o1.y = pk2(gr[2], gr[3]); o2.x = pk2(uu[0], uu[1]); o2.y = pk2(uu[2], uu[3]);
                *(u32x2*)(GR + off) = o1; *(u32x2*)(UU + off) = o2;
            )
        }
    }
};
struct EpiLate {
    bf16_t *HS, *S1, *S2;
    __device__ __forceinline__ void operator()(AccRef acc, const Unit& u, int wr, int wc, int fr, int fq) const {
        const int part = u.pn >> 2;
        if (part == 0) {
            u32x2 tv[2][4][2][2];
            EPI_ALL( const int col = (u.pn & 3) * 256 + bj * 128 + wc * 32 + n * 16 + 4 * fq; tv[ai][m][bj][n] = *(const u32x2*)(HS + (size_t)row * D + col); )
            EPI_ALL( const int col = (u.pn & 3) * 256 + bj * 128 + wc * 32 + n * 16 + 4 * fq; const f32x4 a = acc[ai][bj][m][n]; const u32x2 t = tv[ai][m][bj][n]; u32x2 o;
                o.x = pk2(bflo(t.x) * gelu_f(a[0]), bfhi(t.x) * gelu_f(a[1])); o.y = pk2(bflo(t.y) * gelu_f(a[2]), bfhi(t.y) * gelu_f(a[3]));
                *(u32x2*)(HS + (size_t)row * D + col) = o; )
        } else {
            bf16_t* O = part == 1 ? S1 : S2;
            EPI_ALL( const int col = (u.pn & 3) * 256 + bj * 128 + wc * 32 + n * 16 + 4 * fq; const f32x4 a = acc[ai][bj][m][n]; u32x2 o;
                o.x = pk2(sigm(a[0]), sigm(a[1])); o.y = pk2(sigm(a[2]), sigm(a[3])); *(u32x2*)(O + (size_t)row * D + col) = o; )
        }
    }
};

struct EpiPostG {
    static constexpr bool AFTER_DRAIN = true;
    bf16_t* YF; const bf16_t* YB; const bf16_t* V; const float* cb; const float* lnw; const float* lnb;
    __device__ __forceinline__ void fused(f32x4 (&acc)[2][2][4][2], const Unit& u, int wr, int wc, int fr, int fq, LAS unsigned char* lds, int wid, int lane) const {
        LAS f32x2* P = (LAS f32x2*)lds;
#pragma unroll
        for (int ai = 0; ai < 2; ++ai)
#pragma unroll
            for (int bj = 0; bj < 2; ++bj) { const int qd = ai * 2 + bj;
                u32x2 a[4][2], b[4][2], vv[4][2];
#pragma unroll
                for (int m = 0; m < 4; ++m)
#pragma unroll
                    for (int n = 0; n < 2; ++n) { const size_t off = (size_t)(u.pm * 256 + ai * 128 + wr * 64 + m * 16 + fr) * D + u.pn * 256 + bj * 128 + wc * 32 + n * 16 + 4 * fq;
                        a[m][n] = *(const u32x2*)(YF + off); b[m][n] = *(const u32x2*)(YB + off); vv[m][n] = *(const u32x2*)(V + off); }
                f32x4 y[4][2];
#pragma unroll
                for (int m = 0; m < 4; ++m) { float s1 = 0.f, s2 = 0.f;
#pragma unroll
                    for (int n = 0; n < 2; ++n) { const f32x4 t = (f32x4){bflo(a[m][n].x) + bflo(b[m][n].x), bfhi(a[m][n].x) + bfhi(b[m][n].x), bflo(a[m][n].y) + bflo(b[m][n].y), bfhi(a[m][n].y) + bfhi(b[m][n].y)};
                        y[m][n] = t; s1 += (t[0] + t[1]) + (t[2] + t[3]); s2 += (t[0] * t[0] + t[1] * t[1]) + (t[2] * t[2] + t[3] * t[3]); }
                    s1 += __shfl_xor(s1, 16); s1 += __shfl_xor(s1, 32); s2 += __shfl_xor(s2, 16); s2 += __shfl_xor(s2, 32);
                    if (fq == 0) P[(qd * 128 + wr * 64 + m * 16 + fr) * 4 + wc] = (f32x2){s1, s2}; }
                __syncthreads();
                const int head = 4 * u.pn + 2 * bj + (wc >> 1);
#pragma unroll
                for (int m = 0; m < 4; ++m) { const int rl = wr * 64 + m * 16 + fr, row = u.pm * 256 + ai * 128 + rl;
                    const f32x2 p0 = P[(qd * 128 + rl) * 4 + wc], p1 = P[(qd * 128 + rl) * 4 + (wc ^ 1)];
                    const float mean = (p0[0] + p1[0]) * (1.0f / 64.0f), var = fmaxf((p0[1] + p1[1]) * (1.0f / 64.0f) - mean * mean, 0.f), rs = rsqrtf(var + 64e-5f);
                    const float cbs = cb[(size_t)row * 16 + head];
#pragma unroll
                    for (int n = 0; n < 2; ++n) { const int col = u.pn * 256 + bj * 128 + wc * 32 + n * 16 + 4 * fq; const size_t off = (size_t)row * D + col;
                        const f32x4 w = *(const f32x4*)(lnw + col), bb = *(const f32x4*)(lnb + col), g = acc[ai][bj][m][n];
                        const f32x4 v4 = (f32x4){bflo(vv[m][n].x), bfhi(vv[m][n].x), bflo(vv[m][n].y), bfhi(vv[m][n].y)};
                        const f32x4 o = ((y[m][n] - mean) * rs * w + bb + cbs * v4) * g;
                        u32x2 q; q.x = pk2(o[0], o[1]); q.y = pk2(o[2], o[3]); *(u32x2*)(YF + off) = q; } }
            }
        __syncthreads();
    }
};
struct RowX { unsigned* slots; unsigned* cnt; };
__device__ __forceinline__ void row_rstd_exchange(f32x4 (&v)[2][2][4][2], const Unit& u, int wr, int wc, int fr, int fq, LAS unsigned char* lds, int wid, int lane, const RowX& X) {
    LAS float* P = (LAS float*)lds; LAS float* S = (LAS float*)(lds + 4096);
#pragma unroll
    for (int ai = 0; ai < 2; ++ai)
#pragma unroll
        for (int m = 0; m < 4; ++m) { float q = 0.f;
#pragma unroll
            for (int bj = 0; bj < 2; ++bj)
#pragma unroll
                for (int n = 0; n < 2; ++n) { const f32x4 x = v[ai][bj][m][n]; q += (x[0] * x[0] + x[1] * x[1]) + (x[2] * x[2] + x[3] * x[3]); }
            q += __shfl_xor(q, 16); q += __shfl_xor(q, 32);
            if (fq == 0) P[(ai * 128 + wr * 64 + m * 16 + fr) * 4 + wc] = q; }
    __syncthreads();
    const int row = wid * 32 + (lane & 31);
    if (lane < 32) { const float t = (P[row * 4] + P[row * 4 + 1]) + (P[row * 4 + 2] + P[row * 4 + 3]);
        __hip_atomic_store(X.slots + ((size_t)(u.pm * 256 + row) * 4 + u.pn), __float_as_uint(t), __ATOMIC_RELAXED, __HIP_MEMORY_SCOPE_AGENT); }
    asm volatile("s_waitcnt vmcnt(0)" ::: "memory");
    if (lane == 0) __hip_atomic_fetch_add(X.cnt + 64 * u.pm, 1u, __ATOMIC_RELAXED, __HIP_MEMORY_SCOPE_AGENT);
    if (wid == 0) { unsigned sp = 0u;
        while ((unsigned)__builtin_amdgcn_readfirstlane(__hip_atomic_load(X.cnt + 64 * u.pm, __ATOMIC_RELAXED, __HIP_MEMORY_SCOPE_AGENT)) < 32u) { __builtin_amdgcn_s_sleep(1); if (++sp > (1u << 22)) break; } }
    __syncthreads();
    if (lane < 32) { const unsigned* sl = X.slots + (size_t)(u.pm * 256 + row) * 4; float t = 0.f;
#pragma unroll
        for (int q = 0; q < 4; ++q) t += __uint_as_float(__hip_atomic_load(sl + q, __ATOMIC_RELAXED, __HIP_MEMORY_SCOPE_AGENT));
        S[row] = rsqrtf(t * (1.0f / D) + 1e-6f); }
    __syncthreads();
}
struct EpiOutNorm {
    static constexpr bool AFTER_DRAIN = true;
    const bf16_t* res_b; bf16_t* x2b; bf16_t* hn; const float* mod; const float* g2; RowX X;
    __device__ __forceinline__ void fused(f32x4 (&acc)[2][2][4][2], const Unit& u, int wr, int wc, int fr, int fq, LAS unsigned char* lds, int wid, int lane) const {
        const float* mb = mod + (size_t)((u.pm * 256) >> 12) * NMOD;
#pragma unroll
        for (int ai = 0; ai < 2; ++ai) { u32x2 tv[4][2][2];
#pragma unroll
            for (int m = 0; m < 4; ++m)
#pragma unroll
                for (int bj = 0; bj < 2; ++bj)
#pragma unroll
                    for (int n = 0; n < 2; ++n) { const int row = u.pm * 256 + ai * 128 + wr * 64 + m * 16 + fr, col = u.pn * 256 + bj * 128 + wc * 32 + n * 16 + 4 * fq; tv[m][bj][n] = *(const u32x2*)(res_b + (size_t)row * D + col); }
#pragma unroll
            for (int m = 0; m < 4; ++m)
#pragma unroll
                for (int bj = 0; bj < 2; ++bj)
#pragma unroll
                    for (int n = 0; n < 2; ++n) { const int row = u.pm * 256 + ai * 128 + wr * 64 + m * 16 + fr, col = u.pn * 256 + bj * 128 + wc * 32 + n * 16 + 4 * fq; const u32x2 t = tv[m][bj][n];
                        const f32x4 gt = *(const f32x4*)(mb + 5 * D + col);
                        const f32x4 o = (f32x4){bflo(t.x), bfhi(t.x), bflo(t.y), bfhi(t.y)} + gt * acc[ai][bj][m][n];
                        acc[ai][bj][m][n] = o;
                        u32x2 w; w.x = pk2(o[0], o[1]); w.y = pk2(o[2], o[3]); *(u32x2*)(x2b + (size_t)row * D + col) = w; }
        }
        row_rstd_exchange(acc, u, wr, wc, fr, fq, lds, wid, lane, X);
        const LAS float* S = (const LAS float*)(lds + 4096);
#pragma unroll
        for (int bj = 0; bj < 2; ++bj)
#pragma unroll
            for (int n = 0; n < 2; ++n) { const int col = u.pn * 256 + bj * 128 + wc * 32 + n * 16 + 4 * fq;
                const f32x4 mul = *(const f32x4*)(g2 + col) * (1.0f + *(const f32x4*)(mb + 7 * D + col)), sh = *(const f32x4*)(mb + 6 * D + col);
#pragma unroll
                for (int ai = 0; ai < 2; ++ai)
#pragma unroll
                    for (int m = 0; m < 4; ++m) { const int rl = ai * 128 + wr * 64 + m * 16 + fr; const float rs = S[rl];
                        const f32x4 y = acc[ai][bj][m][n] * rs * mul + sh;
                        u32x2 w; w.x = pk2(y[0], y[1]); w.y = pk2(y[2], y[3]); *(u32x2*)(hn + (size_t)(u.pm * 256 + rl) * D + col) = w; } }
    }
};
struct EpiDn1Norm {
    static constexpr bool AFTER_DRAIN = true;
    const float* res_f; bf16_t* x1b; bf16_t* xnxs; bf16_t* xnp; const float* mod; const float* gm; RowX X;
    __device__ __forceinline__ void fused(f32x4 (&acc)[2][2][4][2], const Unit& u, int wr, int wc, int fr, int fq, LAS unsigned char* lds, int wid, int lane) const {
        const float* mb = mod + (size_t)((u.pm * 256) >> 12) * NMOD;
        f32x4 gt[2][2];
#pragma unroll
        for (int bj = 0; bj < 2; ++bj)
#pragma unroll
            for (int n = 0; n < 2; ++n) gt[bj][n] = 0.5f * *(const f32x4*)(mb + 2 * D + u.pn * 256 + bj * 128 + wc * 32 + n * 16 + 4 * fq);
#pragma unroll
        for (int ai = 0; ai < 2; ++ai)
#pragma unroll
            for (int mh = 0; mh < 2; ++mh) { f32x4 rv[2][2][2];
#pragma unroll
                for (int mm = 0; mm < 2; ++mm)
#pragma unroll
                    for (int bj = 0; bj < 2; ++bj)
#pragma unroll
                        for (int n = 0; n < 2; ++n) { const int m = 2 * mh + mm, row = u.pm * 256 + ai * 128 + wr * 64 + m * 16 + fr, col = u.pn * 256 + bj * 128 + wc * 32 + n * 16 + 4 * fq; rv[mm][bj][n] = *(const f32x4*)(res_f + (size_t)row * D + col); }
#pragma unroll
                for (int mm = 0; mm < 2; ++mm)
#pragma unroll
                    for (int bj = 0; bj < 2; ++bj)
#pragma unroll
                        for (int n = 0; n < 2; ++n) { const int m = 2 * mh + mm, row = u.pm * 256 + ai * 128 + wr * 64 + m * 16 + fr, col = u.pn * 256 + bj * 128 + wc * 32 + n * 16 + 4 * fq;
                            const f32x4 o = rv[mm][bj][n] + gt[bj][n] * acc[ai][bj][m][n]; acc[ai][bj][m][n] = o;
                            u32x2 w; w.x = pk2(o[0], o[1]); w.y = pk2(o[2], o[3]); *(u32x2*)(x1b + (size_t)row * D + col) = w; }
            }
        row_rstd_exchange(acc, u, wr, wc, fr, fq, lds, wid, lane, X);
        const LAS float* S = (const LAS float*)(lds + 4096);
#pragma unroll
        for (int bj = 0; bj < 2; ++bj)
#pragma unroll
            for (int n = 0; n < 2; ++n) { const int col = u.pn * 256 + bj * 128 + wc * 32 + n * 16 + 4 * fq;
                const f32x4 mul = *(const f32x4*)(gm + col) * (1.0f + *(const f32x4*)(mb + 4 * D + col)), sh = *(const f32x4*)(mb + 3 * D + col);
#pragma unroll
                for (int ai = 0; ai < 2; ++ai)
#pragma unroll
                    for (int m = 0; m < 4; ++m) { const int rl = ai * 128 + wr * 64 + m * 16 + fr; const float rs = S[rl]; const size_t row = (size_t)(u.pm * 256 + rl);
                        const f32x4 y = acc[ai][bj][m][n] * rs * mul + sh;
                        u32x2 w; w.x = pk2(y[0], y[1]); w.y = pk2(y[2], y[3]); *(u32x2*)(xnp + row * D + col) = w; } }
        __syncthreads();
    }
};
struct EpiFinalNorm {
    static constexpr bool AFTER_DRAIN = true;
    const bf16_t* res_b; float* out; const float* mod; const float* gfin; RowX X;
    __device__ __forceinline__ void fused(f32x4 (&acc)[2][2][4][2], const Unit& u, int wr, int wc, int fr, int fq, LAS unsigned char* lds, int wid, int lane) const {
        const float* mb = mod + (size_t)((u.pm * 256) >> 12) * NMOD;
#pragma unroll
        for (int ai = 0; ai < 2; ++ai) { u32x2 tv[4][2][2];
#pragma unroll
            for (int m = 0; m < 4; ++m)
#pragma unroll
                for (int bj = 0; bj < 2; ++bj)
#pragma unroll
                    for (int n = 0; n < 2; ++n) { const int row = u.pm * 256 + ai * 128 + wr * 64 + m * 16 + fr, col = u.pn * 256 + bj * 128 + wc * 32 + n * 16 + 4 * fq; tv[m][bj][n] = *(const u32x2*)(res_b + (size_t)row * D + col); }
#pragma unroll
            for (int m = 0; m < 4; ++m)
#pragma unroll
                for (int bj = 0; bj < 2; ++bj)
#pragma unroll
                    for (int n = 0; n < 2; ++n) { const int col = u.pn * 256 + bj * 128 + wc * 32 + n * 16 + 4 * fq; const u32x2 t = tv[m][bj][n];
                        const f32x4 gt = 0.5f * *(const f32x4*)(mb + 8 * D + col);
                        acc[ai][bj][m][n] = (f32x4){bflo(t.x), bfhi(t.x), bflo(t.y), bfhi(t.y)} + gt * acc[ai][bj][m][n]; }
        }
        row_rstd_exchange(acc, u, wr, wc, fr, fq, lds, wid, lane, X);
        const LAS float* S = (const LAS float*)(lds + 4096);
#pragma unroll
        for (int bj = 0; bj < 2; ++bj)
#pragma unroll
            for (int n = 0; n < 2; ++n) { const int col = u.pn * 256 + bj * 128 + wc * 32 + n * 16 + 4 * fq;
                const f32x4 gg = *(const f32x4*)(gfin + col);
#pragma unroll
                for (int ai = 0; ai < 2; ++ai)
#pragma unroll
                    for (int m = 0; m < 4; ++m) { const int rl = ai * 128 + wr * 64 + m * 16 + fr; const float rs = S[rl];
                        *(f32x4*)(out + (size_t)(u.pm * 256 + rl) * D + col) = acc[ai][bj][m][n] * rs * gg; } }
    }
};

enum { CV_PLAIN = 0, CV_UPI = 1, CV_RW = 2, CV_LRU = 3 };
__device__ __forceinline__ void cvt_store(const LAS float* scr, int tid, int k0, int n0, bf16_t* dst, int ldd, int mode, int p0, const float* sc) {
    const int nl = tid >> 3, kc = (tid & 7) * 8, n = n0 + nl;
    float s[8];
#pragma unroll
    for (int j = 0; j < 8; ++j) s[j] = scr[(kc + j) * 65 + nl];
    int row = n;
    if (mode == CV_UPI) row = 32 * (n >> 4) + 16 * p0 + (n & 15);
    else if (mode == CV_LRU) { const int dd = p0 >> 3, nb = (p0 >> 1) & 3, which = p0 & 1, c = 256 * nb + n; row = dd * 2048 + (c >> 7) * 256 + ((c & 127) >> 4) * 32 + which * 16 + (c & 15); }
    bf16_t* dp = dst + (size_t)row * ldd + k0 + kc;
    if (mode == CV_RW) { const float mu = sc[n], om = 1.0f - mu;
        u32x4 o; o.x = pk2(s[0] * om, s[1] * om); o.y = pk2(s[2] * om, s[3] * om); o.z = pk2(s[4] * om, s[5] * om); o.w = pk2(s[6] * om, s[7] * om);
        *(u32x4*)dp = o;
        o.x = pk2(s[0] * mu, s[1] * mu); o.y = pk2(s[2] * mu, s[3] * mu); o.z = pk2(s[4] * mu, s[5] * mu); o.w = pk2(s[6] * mu, s[7] * mu);
        *(u32x4*)(dp + 1024) = o;
    } else { u32x4 o; o.x = pk2(s[0], s[1]); o.y = pk2(s[2], s[3]); o.z = pk2(s[4], s[5]); o.w = pk2(s[6], s[7]); *(u32x4*)dp = o; }
}
__device__ __forceinline__ void cvt_run2(const float* src, int lds_, int K, int N, bf16_t* dst, int ldd, int mode, int p0, const float* sc, LAS float* scr, int bid, int nb) {
    const int tid = tidx(), ntn = N >> 6, nt = (K >> 6) * ntn;
    for (int t = bid; t < nt; t += 2 * nb) {
        const int t2 = t + nb; const bool has2 = t2 < nt;
        const int k0 = (t / ntn) << 6, n0 = (t % ntn) << 6, k1 = has2 ? (t2 / ntn) << 6 : k0, n1 = has2 ? (t2 % ntn) << 6 : n0;
        float va[8], vb[8];
#pragma unroll
        for (int j = 0; j < 8; ++j) { const int kk = (tid >> 6) + 8 * j, nn = tid & 63; va[j] = src[(size_t)(k0 + kk) * lds_ + n0 + nn]; vb[j] = src[(size_t)(k1 + kk) * lds_ + n1 + nn]; }
#pragma unroll
        for (int j = 0; j < 8; ++j) { const int kk = (tid >> 6) + 8 * j, nn = tid & 63; scr[kk * 65 + nn] = va[j]; scr[4160 + kk * 65 + nn] = vb[j]; }
        __syncthreads();
        cvt_store(scr, tid, k0, n0, dst, ldd, mode, p0, sc);
        if (has2) cvt_store(scr + 4160, tid, k1, n1, dst, ldd, mode, p0, sc);
        __syncthreads();
    }
}
__device__ __forceinline__ void cvt_run(const float* src, int lds_, int K, int N, bf16_t* dst, int ldd, int mode, int p0, const float* sc, LAS float* scr) {
    cvt_run2(src, lds_, K, N, dst, ldd, mode, p0, sc, scr, blockIdx.x, gridDim.x);
}
__device__ __forceinline__ void zero_fill(unsigned char* p, size_t row_bytes, size_t pitch, int rows) {
    const size_t per = row_bytes / 16, tot = per * rows;
    const int ztid = tidx();
    for (size_t i = (size_t)blockIdx.x * NTHREADS + ztid; i < tot; i += (size_t)gridDim.x * NTHREADS) {
        const size_t r = i / per, c = i % per; *(u32x4*)(p + r * pitch + c * 16) = (u32x4){0u, 0u, 0u, 0u}; }
}

__device__ __forceinline__ void mod_phase(const Params& p, float* mod, LAS float* red) {
    const int tid = tidx(), kq = tid >> 4, cq = tid & 15;
    const float* c = p.in[1]; const float* cc = p.in[3]; const float* wm = p.in[4]; const float* bm = p.in[5];
    for (int it = blockIdx.x; it < NMOD / 64; it += gridDim.x) {
        const int j0 = it * 64 + 4 * cq;
        f32x4 acc[5];
#pragma unroll
        for (int b = 0; b < 5; ++b) acc[b] = (f32x4){0.f, 0.f, 0.f, 0.f};
#pragma unroll 4
        for (int i = 0; i < 32; ++i) { const int k = kq + 32 * i;
            const f32x4 w = *(const f32x4*)(wm + (size_t)k * NMOD + j0);
            acc[0] += silu_f(c[k]) * w; acc[1] += silu_f(c[D + k]) * w; acc[2] += silu_f(c[2 * D + k]) * w; acc[3] += silu_f(c[3 * D + k]) * w; acc[4] += silu_f(cc[k]) * w; }
#pragma unroll
        for (int b = 0; b < 5; ++b)
#pragma unroll
            for (int j = 0; j < 4; ++j) red[(kq * 5 + b) * 64 + 4 * cq + j] = acc[b][j];
        __syncthreads();
        if (tid < 320) { const int b = tid >> 6, cl = tid & 63; float s = 0.f;
            for (int q = 0; q < 32; ++q) s += red[(q * 5 + b) * 64 + cl];
            mod[(size_t)b * NMOD + it * 64 + cl] = s + bm[it * 64 + cl]; }
        __syncthreads();
    }
}

template <bool LATB = false> __device__ __forceinline__ void norm_phase(const float* lat, const float* ctx, int nrows, const float* g, const float* mod, int ish, int isc, bf16_t* dst, int ldd, const float* ctx2 = nullptr, const bf16_t* latb = nullptr, bf16_t* dst2 = nullptr, int mstart = 0) {
    const int tid = tidx(), lane = tid & 63, gw = blockIdx.x * 8 + (tid >> 6), ngw = gridDim.x * 8;
    for (int m0 = mstart + gw; m0 < nrows; m0 += 2 * ngw) {
        const int m1 = m0 + ngw; const bool has1 = m1 < nrows; const int mb = has1 ? m1 : m0;
        const float* srca = m0 < MLAT ? lat + (size_t)m0 * D : ctx + (size_t)(m0 - MLAT) * D;
        const float* srcb = mb < MLAT ? lat + (size_t)mb * D : ctx + (size_t)(mb - MLAT) * D;
        f32x4 va[4], vb[4]; float sa = 0.f, sb = 0.f;
#pragma unroll
        for (int j = 0; j < 4; ++j) {
            if (LATB && m0 < MLAT) { const u32x2 t = *(const u32x2*)(latb + (size_t)m0 * D + 4 * lane + 256 * j); va[j] = (f32x4){bflo(t.x), bfhi(t.x), bflo(t.y), bfhi(t.y)}; } else va[j] = *(const f32x4*)(srca + 4 * lane + 256 * j);
            if (LATB && mb < MLAT) { const u32x2 t = *(const u32x2*)(latb + (size_t)mb * D + 4 * lane + 256 * j); vb[j] = (f32x4){bflo(t.x), bfhi(t.x), bflo(t.y), bfhi(t.y)}; } else vb[j] = *(const f32x4*)(srcb + 4 * lane + 256 * j); }
        if (ctx2) {
            if (m0 >= MLAT) { _Pragma("unroll") for (int j = 0; j < 4; ++j) va[j] += *(const f32x4*)(ctx2 + (size_t)(m0 - MLAT) * D + 4 * lane + 256 * j); }
            if (mb >= MLAT) { _Pragma("unroll") for (int j = 0; j < 4; ++j) vb[j] += *(const f32x4*)(ctx2 + (size_t)(mb - MLAT) * D + 4 * lane + 256 * j); } }
#pragma unroll
        for (int j = 0; j < 4; ++j) { sa += va[j][0] * va[j][0] + va[j][1] * va[j][1] + va[j][2] * va[j][2] + va[j][3] * va[j][3]; sb += vb[j][0] * vb[j][0] + vb[j][1] * vb[j][1] + vb[j][2] * vb[j][2] + vb[j][3] * vb[j][3]; }
#pragma unroll
        for (int o = 1; o < 64; o <<= 1) { sa += __shfl_xor(sa, o); sb += __shfl_xor(sb, o); }
        const float ra = rsqrtf(sa * (1.0f / D) + 1e-6f), rb = rsqrtf(sb * (1.0f / D) + 1e-6f);
        const int ba = m0 < MLAT ? (m0 >> 12) : 4, bb = mb < MLAT ? (mb >> 12) : 4;
        const float* sha = mod + (size_t)ba * NMOD + ish * D; const float* sca = mod + (size_t)ba * NMOD + isc * D;
        const float* shb = mod + (size_t)bb * NMOD + ish * D; const float* scb = mod + (size_t)bb * NMOD + isc * D;
#pragma unroll
        for (int j = 0; j < 4; ++j) { const int c = 4 * lane + 256 * j;
            const f32x4 gg = *(const f32x4*)(g + c);
            { const f32x4 s1 = *(const f32x4*)(sha + c), s2 = *(const f32x4*)(sca + c); const f32x4 y = va[j] * ra * gg * (1.0f + s2) + s1;
              u32x2 o; o.x = pk2(y[0], y[1]); o.y = pk2(y[2], y[3]); *(u32x2*)(dst + (size_t)m0 * ldd + c) = o; if (dst2 && m0 < MLAT) *(u32x2*)(dst2 + (size_t)m0 * D + c) = o; }
            if (has1) { const f32x4 s1 = *(const f32x4*)(shb + c), s2 = *(const f32x4*)(scb + c); const f32x4 y = vb[j] * rb * gg * (1.0f + s2) + s1;
              u32x2 o; o.x = pk2(y[0], y[1]); o.y = pk2(y[2], y[3]); *(u32x2*)(dst + (size_t)m1 * ldd + c) = o; if (dst2 && m1 < MLAT) *(u32x2*)(dst2 + (size_t)m1 * D + c) = o; } }
    }
}
__device__ __forceinline__ void final_norm_phase(float* x, const float* g) {
    const int tid = tidx(), lane = tid & 63, gw = blockIdx.x * 8 + (tid >> 6), ngw = gridDim.x * 8;
    for (int m0 = gw; m0 < MLAT; m0 += 2 * ngw) {
        const int m1 = m0 + ngw; const bool has1 = m1 < MLAT;
        float* sa_ = x + (size_t)m0 * D; float* sb_ = x + (size_t)(has1 ? m1 : m0) * D;
        f32x4 va[4], vb[4]; float sa = 0.f, sb = 0.f;
#pragma unroll
        for (int j = 0; j < 4; ++j) { va[j] = *(const f32x4*)(sa_ + 4 * lane + 256 * j); vb[j] = *(const f32x4*)(sb_ + 4 * lane + 256 * j); }
#pragma unroll
        for (int j = 0; j < 4; ++j) { sa += va[j][0] * va[j][0] + va[j][1] * va[j][1] + va[j][2] * va[j][2] + va[j][3] * va[j][3]; sb += vb[j][0] * vb[j][0] + vb[j][1] * vb[j][1] + vb[j][2] * vb[j][2] + vb[j][3] * vb[j][3]; }
#pragma unroll
        for (int o = 1; o < 64; o <<= 1) { sa += __shfl_xor(sa, o); sb += __shfl_xor(sb, o); }
        const float ra = rsqrtf(sa * (1.0f / D) + 1e-6f), rb = rsqrtf(sb * (1.0f / D) + 1e-6f);
#pragma unroll
        for (int j = 0; j < 4; ++j) { const int c = 4 * lane + 256 * j; const f32x4 gg = *(const f32x4*)(g + c);
            *(f32x4*)(sa_ + c) = va[j] * ra * gg; if (has1) *(f32x4*)(sb_ + c) = vb[j] * rb * gg; }
    }
}
__device__ __forceinline__ void add4(f32x4& a, const bf16_t* p) { const u32x2 t = *(const u32x2*)p; a[0] += bflo(t.x); a[1] += bfhi(t.x); a[2] += bflo(t.y); a[3] += bfhi(t.y); }
__device__ __forceinline__ void xs_phase(bf16_t* xnxs, const bf16_t* xnp, int nrows) {
    const int tid = tidx(), lane = tid & 63, gw = blockIdx.x * 8 + (tid >> 6), ngw = gridDim.x * 8;
    for (int m = gw; m < nrows; m += ngw) {
        int n0, n1, n2, n3; bool v0, v1, v2, v3; float wgt;
        if (m < MLAT) { const int t = m & 4095, gr = t >> 6, gc = t & 63; wgt = 0.25f; v0 = gr > 0; v1 = gr < 63; v2 = gc > 0; v3 = gc < 63; n0 = m - 64; n1 = m + 64; n2 = m - 1; n3 = m + 1; }
        else { const int j = (m - MLAT) & 255; wgt = 0.5f; v0 = false; v1 = false; v2 = j > 0; v3 = j < 255; n0 = m; n1 = m; n2 = m - 1; n3 = m + 1; }
        if (!v0) n0 = m; if (!v1) n1 = m; if (!v2) n2 = m; if (!v3) n3 = m;
        const float w0 = v0 ? wgt : 0.f, w1 = v1 ? wgt : 0.f, w2 = v2 ? wgt : 0.f, w3 = v3 ? wgt : 0.f;
        const bool plain = xnp != nullptr && m < MLAT;
        const bf16_t* sb = plain ? xnp : xnxs; const size_t ld = plain ? (size_t)D : (size_t)2048;
        u32x2 q0[4], q1[4], q2[4], q3[4], qs[4];
#pragma unroll
        for (int j = 0; j < 4; ++j) { const int c = 4 * lane + 256 * j;
            q0[j] = *(const u32x2*)(sb + (size_t)n0 * ld + c); q1[j] = *(const u32x2*)(sb + (size_t)n1 * ld + c);
            q2[j] = *(const u32x2*)(sb + (size_t)n2 * ld + c); q3[j] = *(const u32x2*)(sb + (size_t)n3 * ld + c); qs[j] = *(const u32x2*)(sb + (size_t)m * ld + c); }
#pragma unroll
        for (int j = 0; j < 4; ++j) { const int c = 4 * lane + 256 * j;
            const float a0 = w0 * bflo(q0[j].x) + w1 * bflo(q1[j].x) + w2 * bflo(q2[j].x) + w3 * bflo(q3[j].x);
            const float a1 = w0 * bfhi(q0[j].x) + w1 * bfhi(q1[j].x) + w2 * bfhi(q2[j].x) + w3 * bfhi(q3[j].x);
            const float a2 = w0 * bflo(q0[j].y) + w1 * bflo(q1[j].y) + w2 * bflo(q2[j].y) + w3 * bflo(q3[j].y);
            const float a3 = w0 * bfhi(q0[j].y) + w1 * bfhi(q1[j].y) + w2 * bfhi(q2[j].y) + w3 * bfhi(q3[j].y);
            u32x2 o; o.x = pk2(a0, a1); o.y = pk2(a2, a3);
            *(u32x2*)(xnxs + (size_t)m * 2048 + 1024 + c) = o;
            if (plain) *(u32x2*)(xnxs + (size_t)m * 2048 + c) = qs[j]; }
    }
}
__device__ __forceinline__ void xs_ctx_phase(const float* c1, const float* c2, const float* g, const float* mod, bf16_t* xnxs) {
    const int tid = tidx(), lane = tid & 63, gw = (int)gridDim.x * 8 - 1 - ((int)blockIdx.x * 8 + (tid >> 6)), ngw = gridDim.x * 8;
    const float* sh = mod + (size_t)4 * NMOD + 3 * D; const float* sc = mod + (size_t)4 * NMOD + 4 * D;
    for (int r = gw; r < MCTX; r += ngw) {
        const int j = r & 255; const bool vp = j > 0, vn = j < 255;
        const int rr[3] = {vp ? r - 1 : r, r, vn ? r + 1 : r};
        f32x4 x[3][4];
#pragma unroll
        for (int q = 0; q < 3; ++q)
#pragma unroll
            for (int i = 0; i < 4; ++i) { const size_t off = (size_t)rr[q] * D + 4 * lane + 256 * i; x[q][i] = *(const f32x4*)(c1 + off) + *(const f32x4*)(c2 + off); }
        float ss[3];
#pragma unroll
        for (int q = 0; q < 3; ++q) { float t = 0.f;
#pragma unroll
            for (int i = 0; i < 4; ++i) t += (x[q][i][0] * x[q][i][0] + x[q][i][1] * x[q][i][1]) + (x[q][i][2] * x[q][i][2] + x[q][i][3] * x[q][i][3]);
            ss[q] = t; }
#pragma unroll
        for (int o = 1; o < 64; o <<= 1) { ss[0] += __shfl_xor(ss[0], o); ss[1] += __shfl_xor(ss[1], o); ss[2] += __shfl_xor(ss[2], o); }
        const float r0 = rsqrtf(ss[0] * (1.0f / D) + 1e-6f) * (vp ? 0.5f : 0.f), r1 = rsqrtf(ss[1] * (1.0f / D) + 1e-6f), r2 = rsqrtf(ss[2] * (1.0f / D) + 1e-6f) * (vn ? 0.5f : 0.f);
        const float wsh = (vp ? 0.5f : 0.f) + (vn ? 0.5f : 0.f);
#pragma unroll
        for (int i = 0; i < 4; ++i) { const int c = 4 * lane + 256 * i;
            const f32x4 mul = *(const f32x4*)(g + c) * (1.0f + *(const f32x4*)(sc + c)), s0 = *(const f32x4*)(sh + c);
            const f32x4 xn = x[1][i] * r1 * mul + s0;
            const f32x4 xs = (x[0][i] * r0 + x[2][i] * r2) * mul + wsh * s0;
            u32x2 o; o.x = pk2(xn[0], xn[1]); o.y = pk2(xn[2], xn[3]); *(u32x2*)(xnxs + (size_t)(MLAT + r) * 2048 + c) = o;
            o.x = pk2(xs[0], xs[1]); o.y = pk2(xs[2], xs[3]); *(u32x2*)(xnxs + (size_t)(MLAT + r) * 2048 + 1024 + c) = o; }
    }
}
__device__ __forceinline__ void conv_phase(const bf16_t* plx, const bf16_t* plxc, bf16_t* xc, const float* cw, const float* cb) {
    const int tid = tidx(), lane = tid & 63, gw = blockIdx.x * 8 + (tid >> 6), ngw = gridDim.x * 8;
    for (int m = gw; m < MALL; m += ngw) {
        int t, len; if (m < MLAT) { t = m & 4095; len = 4096; } else { t = (m - MLAT) & 255; len = 256; }
        const bf16_t* pb = m < MLAT ? plx : plxc - (size_t)MLAT * D;
        int rq[4]; float wq[4];
#pragma unroll
        for (int q = 0; q < 4; ++q) { const int tt = t + q - 1; const bool ok = tt >= 0 && tt < len; rq[q] = ok ? m + q - 1 : m; wq[q] = ok ? 1.f : 0.f; }
        u32x2 x[4][4];
#pragma unroll
        for (int q = 0; q < 4; ++q)
#pragma unroll
            for (int j = 0; j < 4; ++j) x[q][j] = *(const u32x2*)(pb + (size_t)rq[q] * D + 4 * lane + 256 * j);
#pragma unroll
        for (int j = 0; j < 4; ++j) { const int c = 4 * lane + 256 * j; f32x4 a = *(const f32x4*)(cb + c);
#pragma unroll
            for (int q = 0; q < 4; ++q) { const f32x4 w = *(const f32x4*)(cw + q * D + c) * wq[q];
                a[0] += w[0] * bflo(x[q][j].x); a[1] += w[1] * bfhi(x[q][j].x); a[2] += w[2] * bflo(x[q][j].y); a[3] += w[3] * bfhi(x[q][j].y); }
            u32x2 o; o.x = pk2(a[0], a[1]); o.y = pk2(a[2], a[3]);
            *(u32x2*)(xc + (size_t)m * D + c) = o; }
    }
}
__device__ __forceinline__ void rncb_phase(const bf16_t* R, const bf16_t* Kk, const float* k_k, const float* r_k, float* rn, float* cbv) {
    const int tid = tidx(), g16 = (blockIdx.x * NTHREADS + tid) >> 4, ng = (gridDim.x * NTHREADS) >> 4, l = tid & 15;
    for (int it0 = g16; it0 < MALL * 16; it0 += 4 * ng) {
        u32x2 kv[4], rv[4];
#pragma unroll
        for (int u = 0; u < 4; ++u) { const int it = it0 + u * ng; kv[u] = (u32x2){0u, 0u}; rv[u] = (u32x2){0u, 0u};
            if (it < MALL * 16) { const size_t off = (size_t)(it >> 4) * D + (it & 15) * 64 + 4 * l; kv[u] = *(const u32x2*)(Kk + off); rv[u] = *(const u32x2*)(R + off); } }
#pragma unroll
        for (int u = 0; u < 4; ++u) { const int it = it0 + u * ng;
            if (it < MALL * 16) { const int c = (it & 15) * 64 + 4 * l;
                const f32x4 kk = *(const f32x4*)(k_k + c), rk = *(const f32x4*)(r_k + c);
                const float k0 = bflo(kv[u].x), k1 = bfhi(kv[u].x), k2 = bflo(kv[u].y), k3 = bfhi(kv[u].y);
                float s1 = k0 * kk[0] * k0 * kk[0] + k1 * kk[1] * k1 * kk[1] + k2 * kk[2] * k2 * kk[2] + k3 * kk[3] * k3 * kk[3];
                float s2 = bflo(rv[u].x) * k0 * rk[0] + bfhi(rv[u].x) * k1 * rk[1] + bflo(rv[u].y) * k2 * rk[2] + bfhi(rv[u].y) * k3 * rk[3];
                s1 = red16(s1); s2 = red16(s2);
                if (l == 0) { rn[it] = __builtin_amdgcn_rsqf(fmaxf(s1, 1e-24f)); cbv[it] = s2; } } }
    }
}
__device__ __forceinline__ void post_phase(bf16_t* YF, const bf16_t* YB, const bf16_t* V, const float* cbv, const float* lnw, const float* lnb) {
    const int tid = tidx(), g16 = (blockIdx.x * NTHREADS + tid) >> 4, ng = (gridDim.x * NTHREADS) >> 4, l = tid & 15;
    for (int it0 = g16; it0 < MLAT * 16; it0 += 4 * ng) {
        u32x2 av[4], bv[4], vv[4]; float cbs[4];
#pragma unroll
        for (int u = 0; u < 4; ++u) { const int it = it0 + u * ng; av[u] = (u32x2){0u, 0u}; bv[u] = av[u]; vv[u] = av[u]; cbs[u] = 0.f;
            if (it < MLAT * 16) { const size_t off = (size_t)(it >> 4) * D + (it & 15) * 64 + 4 * l; av[u] = *(const u32x2*)(YF + off); bv[u] = *(const u32x2*)(YB + off); vv[u] = *(const u32x2*)(V + off); cbs[u] = cbv[it]; } }
#pragma unroll
        for (int u = 0; u < 4; ++u) { const int it = it0 + u * ng;
            if (it < MLAT * 16) { const int c = (it & 15) * 64 + 4 * l; const size_t off = (size_t)(it >> 4) * D + c;
                float y[4] = {bflo(av[u].x) + bflo(bv[u].x), bfhi(av[u].x) + bfhi(bv[u].x), bflo(av[u].y) + bflo(bv[u].y), bfhi(av[u].y) + bfhi(bv[u].y)};
                const float mu = red16(y[0] + y[1] + y[2] + y[3]) * (1.0f / 64.0f);
                float q = 0.f;
#pragma unroll
                for (int j = 0; j < 4; ++j) { y[j] -= mu; q += y[j] * y[j]; }
                const float rs = rsqrtf(red16(q) * (1.0f / 64.0f) + 64e-5f);
                const f32x4 w = *(const f32x4*)(lnw + c), bb = *(const f32x4*)(lnb + c);
                const float v4[4] = {bflo(vv[u].x), bfhi(vv[u].x), bflo(vv[u].y), bfhi(vv[u].y)};
                float o[4];
#pragma unroll
                for (int j = 0; j < 4; ++j) o[j] = y[j] * rs * w[j] + bb[j] + cbs[u] * v4[j];
                u32x2 ov; ov.x = pk2(o[0], o[1]); ov.y = pk2(o[2], o[3]);
                *(u32x2*)(YF + off) = ov; } }
    }
}

constexpr int RS_STRIDE = 324;
constexpr int RS_BUF = 32 * RS_STRIDE + 1024 + 4096;
__device__ __forceinline__ int scan_row(int b, int dir, int s) {
    if (s < 256) return MLAT + b * 256 + (dir ? 255 - s : s);
    return b * 4096 + (dir ? 4095 - (s - 256) : (s - 256));
}
struct ScanIn { bf16x8 afr[2][2]; unsigned short xv[8]; float rnv[8]; unsigned vpair; };
__device__ __forceinline__ void rwkv_scan_phase(const Params& p, LAS float* lds) {
    unsigned char* ws = p.ws;
    const bf16_t* R = (const bf16_t*)(ws + O_R); const bf16_t* Kk = (const bf16_t*)(ws + O_K); const bf16_t* V = (const bf16_t*)(ws + O_V);
    const bf16_t* LIN = (const bf16_t*)(ws + O_LIN); const float* rn = (const float*)(ws + O_RN);
    const int tid = tidx(), lane = tid & 63, w = __builtin_amdgcn_readfirstlane(tid >> 6), fr = lane & 15, fq = lane >> 4;
    const int cgp = lane & 15, rw = lane >> 4;
    for (int unit = blockIdx.x; unit < 256; unit += gridDim.x) {
        const int xcd = unit & 7, slot = unit >> 3, half = slot & 1, chain = (slot >> 1) * 8 + xcd, dir = chain & 1, h = (chain >> 1) & 15, b = chain >> 5;
        bf16_t* Y = (bf16_t*)(ws + (dir ? O_YB : O_YF));
        const int lora = w >> 2, ct = w & 3, col = h * 64 + 16 * ct + fr;
        bf16x8 bfr[2];
        { const bf16_t* wt = (const bf16_t*)(ws + (lora ? O_LSCA : O_LSCW)) + (size_t)(dir * 1024 + col) * 64 + 8 * fq;
          bfr[0] = *(const bf16x8*)(wt); bfr[1] = *(const bf16x8*)(wt + 32); }
        const float c_bias = lora ? p.in[15][dir * D + col] : p.in[13][dir * D + col];
        const float c_kk = p.in[18][col], c_ka = p.in[19][col];
        const int lcol0 = (lora ? 128 : 0) + dir * 64;
        const int sgn = dir ? -1 : 1;
        f32x2 SA = (f32x2){0.f, 0.f}, SB = (f32x2){0.f, 0.f};
        ScanIn in;
#define SCAN_LOAD(c) do { const int m0 = scan_row(b, dir, 32 * (c)); \
            _Pragma("unroll") for (int tt = 0; tt < 2; ++tt) { const size_t mr = (size_t)(m0 + sgn * (16 * tt + fr)); \
                _Pragma("unroll") for (int ks = 0; ks < 2; ++ks) in.afr[tt][ks] = *(const bf16x8*)(LIN + mr * 256 + lcol0 + 32 * ks + 8 * fq); } \
            _Pragma("unroll") for (int tt = 0; tt < 2; ++tt) _Pragma("unroll") for (int j = 0; j < 4; ++j) { const size_t mr = (size_t)(m0 + sgn * (16 * tt + 4 * fq + j)); \
                in.xv[tt * 4 + j] = (lora ? Kk : R)[mr * D + col]; in.rnv[tt * 4 + j] = rn[mr * 16 + h]; } \
            { const size_t mr = (size_t)(m0 + sgn * (tid >> 4)); in.vpair = *(const unsigned*)(V + mr * D + h * 64 + half * 32 + 2 * (tid & 15)); } } while (0)
#define SCAN_PRODUCE(bufi) do { LAS float* sb = lds + (bufi) * RS_BUF; \
            _Pragma("unroll") for (int tt = 0; tt < 2; ++tt) { f32x4 acc = (f32x4){0.f, 0.f, 0.f, 0.f}; \
                acc = __builtin_amdgcn_mfma_f32_16x16x32_bf16(in.afr[tt][0], bfr[0], acc, 0, 0, 0); acc = __builtin_amdgcn_mfma_f32_16x16x32_bf16(in.afr[tt][1], bfr[1], acc, 0, 0, 0); \
                _Pragma("unroll") for (int j = 0; j < 4; ++j) { LAS float* rec = sb + (16 * tt + 4 * fq + j) * RS_STRIDE + 16 * ct + fr; const float x = bf2f(in.xv[tt * 4 + j]); \
                    if (lora == 0) { rec[0] = __expf(-0.60653066f * sigm(c_bias + acc[j])); rec[256] = x; } \
                    else { const float a = sigm(c_bias + acc[j]), kkv = x * c_kk * in.rnv[tt * 4 + j]; rec[64] = x * (1.0f + (a - 1.0f) * c_ka); rec[128] = -kkv; rec[192] = kkv * a; } } } \
            { LAS float* vb = sb + 32 * RS_STRIDE + (tid >> 4) * 32 + 2 * (tid & 15); vb[0] = bflo(in.vpair); vb[1] = bfhi(in.vpair); } } while (0)
#define SCAN_YOUT(c, bufi) do { if ((c) >= 8) { const LAS float* yb_ = lds + (bufi) * RS_BUF + 32 * RS_STRIDE + 1024 + ((tid >> 4) * 32 + 2 * (tid & 15)) * 4; \
            const f32x4 ya = *(const LAS f32x4*)(yb_), yc = *(const LAS f32x4*)(yb_ + 4); \
            const size_t mr = (size_t)(scan_row(b, dir, 32 * (c)) + sgn * (tid >> 4)); \
            *(unsigned*)(Y + mr * D + h * 64 + half * 32 + 2 * (tid & 15)) = pk2((ya[0] + ya[1]) + (ya[2] + ya[3]), (yc[0] + yc[1]) + (yc[2] + yc[3])); } } while (0)
        SCAN_LOAD(0);
        SCAN_PRODUCE(0);
        __syncthreads();
        for (int c = 0; c < 136; ++c) {
            const int cur = c & 1;
            if (c + 1 < 136) SCAN_LOAD(c + 1);
            if (c > 0 && w >= 4) SCAN_YOUT(c - 1, cur ^ 1);
            const LAS float* sp0 = lds + cur * RS_BUF + 4 * cgp;
            const LAS float* vb = lds + cur * RS_BUF + 32 * RS_STRIDE + w * 4 + rw;
            LAS float* yb = lds + cur * RS_BUF + 32 * RS_STRIDE + 1024 + (w * 4 + rw) * 4 + (cgp >> 2);
            f32x4 w4 = *(const LAS f32x4*)(sp0), kd4 = *(const LAS f32x4*)(sp0 + 64), ka4 = *(const LAS f32x4*)(sp0 + 192), r4 = *(const LAS f32x4*)(sp0 + 256);
            f32x4 nk1 = *(const LAS f32x4*)(sp0 + RS_STRIDE + 128);
            float vv = vb[0];
            float sa;
            { const f32x4 nk0 = *(const LAS f32x4*)(sp0 + 128); const f32x2 q = SA * (f32x2){nk0[0], nk0[1]} + SB * (f32x2){nk0[2], nk0[3]}; sa = red16(q[0] + q[1]); }
#define SCAN_STEPS(i0, cnt) _Pragma("unroll") for (int ii = 0; ii < (cnt); ++ii) { const int i = (i0) + ii; \
                f32x4 w4n = w4, kd4n = kd4, ka4n = ka4, r4n = r4, nk2 = nk1; float vvn = vv; \
                if (i + 1 < 32) { const LAS float* spn = sp0 + (i + 1) * RS_STRIDE; \
                    w4n = *(const LAS f32x4*)(spn); kd4n = *(const LAS f32x4*)(spn + 64); ka4n = *(const LAS f32x4*)(spn + 192); r4n = *(const LAS f32x4*)(spn + 256); vvn = vb[(i + 1) * 32]; } \
                if (i + 2 < 32) nk2 = *(const LAS f32x4*)(sp0 + (i + 2) * RS_STRIDE + 128); \
                { const f32x2 ta = sa * (f32x2){ka4[0], ka4[1]} + vv * (f32x2){kd4[0], kd4[1]}, tb = sa * (f32x2){ka4[2], ka4[3]} + vv * (f32x2){kd4[2], kd4[3]}; \
                  SA = SA * (f32x2){w4[0], w4[1]} + ta; SB = SB * (f32x2){w4[2], w4[3]} + tb; } \
                const f32x2 py = SA * (f32x2){r4[0], r4[1]} + SB * (f32x2){r4[2], r4[3]}; \
                float yp = py[0] + py[1]; \
                float sn = 0.f; \
                if (i + 1 < 32) { const f32x2 ps = SA * (f32x2){nk1[0], nk1[1]} + SB * (f32x2){nk1[2], nk1[3]}; sn = ps[0] + ps[1]; } \
                sn += dppf<0xB1>(sn); yp += dppf<0xB1>(yp); sn += dppf<0x4E>(sn); yp += dppf<0x4E>(yp); sn += dppf<0x141>(sn); sn += dppf<0x140>(sn); \
                if ((cgp & 3) == 0) yb[i * 128] = yp; \
                sa = sn; w4 = w4n; kd4 = kd4n; ka4 = ka4n; r4 = r4n; vv = vvn; nk1 = nk2; }
            __builtin_amdgcn_s_setprio(2);
            SCAN_STEPS(0, 8)
            if (c + 1 < 136 && w < 4) { __builtin_amdgcn_s_setprio(0); SCAN_PRODUCE(cur ^ 1); __builtin_amdgcn_s_setprio(2); }
            SCAN_STEPS(8, 8)
            if (c > 0 && w < 4) SCAN_YOUT(c - 1, cur ^ 1);
            SCAN_STEPS(16, 8)
            if (c + 1 < 136 && w >= 4) { __builtin_amdgcn_s_setprio(0); SCAN_PRODUCE(cur ^ 1); __builtin_amdgcn_s_setprio(2); }
            SCAN_STEPS(24, 8)
            __builtin_amdgcn_s_setprio(0);
#undef SCAN_STEPS
            __syncthreads();
        }
        SCAN_YOUT(135, 1);
        __syncthreads();
#undef SCAN_LOAD
#undef SCAN_PRODUCE
#undef SCAN_YOUT
    }
}

__device__ __forceinline__ void lru_p1_phase(const Params& p) {
    unsigned char* ws = p.ws; const float* lam = (const float*)(ws + O_CL);
    float* PQ = (float*)(ws + O_PQ);
    const int tid = tidx(), lane = tid & 63, half = lane >> 5, l32 = lane & 31, gw = blockIdx.x * 8 + (tid >> 6), ngw = gridDim.x * 8;
    for (int it = gw; it < 2 * 4 * 68 * 16; it += ngw) {
        const int cb16 = it & 15, j = (it >> 4) % 68, b = ((it >> 4) / 68) & 3, d = (it >> 4) / 272;
        const int c = cb16 * 64 + 2 * l32;
        const bf16_t* GR = (const bf16_t*)(ws + (d ? O_GRB : O_GRF)); const bf16_t* UU = (const bf16_t*)(ws + (d ? O_UB : O_UF));
        const float cl0 = lam[d * D + c], cl1 = lam[d * D + c + 1];
        float P0 = 1.f, P1 = 1.f, Q0 = 0.f, Q1 = 0.f;
        const int sgn = d ? -1 : 1, m0 = scan_row(b, d, 64 * j) + sgn * 32 * half;
#pragma unroll 8
        for (int i = 0; i < 32; ++i) { const size_t off = (size_t)(m0 + sgn * i) * D + c;
            const unsigned g = *(const unsigned*)(GR + off), uv = *(const unsigned*)(UU + off);
            const float a0 = __expf(bflo(g) * cl0), a1 = __expf(bfhi(g) * cl1);
            P0 *= a0; P1 *= a1; Q0 = a0 * Q0 + bflo(uv); Q1 = a1 * Q1 + bfhi(uv); }
        const float oP0 = __shfl_xor(P0, 32), oP1 = __shfl_xor(P1, 32), oQ0 = __shfl_xor(Q0, 32), oQ1 = __shfl_xor(Q1, 32);
        if (half == 0) { const size_t o = ((size_t)((d * 4 + b) * 68 + j)) * D + c;
            *(f32x2*)(PQ + o) = (f32x2){P0 * oP0, P1 * oP1}; *(f32x2*)(PQ + (size_t)2 * 4 * 68 * D + o) = (f32x2){oP0 * Q0 + oQ0, oP1 * Q1 + oQ1}; }
    }
}
__device__ __forceinline__ void lru_p3_phase(const Params& p) {
    unsigned char* ws = p.ws; const float* lam = (const float*)(ws + O_CL);
    const float* PQ = (const float*)(ws + O_PQ); const float* QQ = PQ + (size_t)2 * 4 * 68 * D;
    bf16_t* HS = (bf16_t*)(ws + O_HSUM);
    const int tid = tidx(), lane = tid & 63, gw = blockIdx.x * 8 + (tid >> 6), ngw = gridDim.x * 8;
    for (int it = gw; it < 4 * 64 * 8; it += ngw) {
        const int cb8 = it & 7, T = (it >> 3) & 63, b = it >> 9, c = cb8 * 128 + 2 * lane;
        {
            const bf16_t* GR = (const bf16_t*)(ws + O_GRF); const bf16_t* UU = (const bf16_t*)(ws + O_UF);
            const float cl0 = lam[c], cl1 = lam[c + 1];
            float h0 = 0.f, h1 = 0.f;
#pragma unroll 8
            for (int jj = 0; jj < 4 + T; ++jj) { const size_t o = ((size_t)(b * 68 + jj)) * D + c; const f32x2 P = *(const f32x2*)(PQ + o), Q = *(const f32x2*)(QQ + o); h0 = P[0] * h0 + Q[0]; h1 = P[1] * h1 + Q[1]; }
            for (int i0 = 0; i0 < 64; i0 += 8) {
                unsigned g[8], uv[8];
#pragma unroll
                for (int i = 0; i < 8; ++i) { const size_t off = (size_t)(b * 4096 + 64 * T + i0 + i) * D + c; g[i] = *(const unsigned*)(GR + off); uv[i] = *(const unsigned*)(UU + off); }
#pragma unroll
                for (int i = 0; i < 8; ++i) { const size_t off = (size_t)(b * 4096 + 64 * T + i0 + i) * D + c;
                    h0 = __expf(bflo(g[i]) * cl0) * h0 + bflo(uv[i]); h1 = __expf(bfhi(g[i]) * cl1) * h1 + bfhi(uv[i]);
                    *(unsigned*)(HS + off) = pk2(h0, h1); }
            }
        }
        {
            const bf16_t* GR = (const bf16_t*)(ws + O_GRB); const bf16_t* UU = (const bf16_t*)(ws + O_UB);
            const float cl0 = lam[D + c], cl1 = lam[D + c + 1];
            float h0 = 0.f, h1 = 0.f;
#pragma unroll 8
            for (int jj = 0; jj < 67 - T; ++jj) { const size_t o = ((size_t)((4 + b) * 68 + jj)) * D + c; const f32x2 P = *(const f32x2*)(PQ + o), Q = *(const f32x2*)(QQ + o); h0 = P[0] * h0 + Q[0]; h1 = P[1] * h1 + Q[1]; }
            for (int i0 = 0; i0 < 64; i0 += 8) {
                unsigned g[8], uv[8], f[8];
#pragma unroll
                for (int i = 0; i < 8; ++i) { const size_t off = (size_t)(b * 4096 + 64 * T + 63 - i0 - i) * D + c; g[i] = *(const unsigned*)(GR + off); uv[i] = *(const unsigned*)(UU + off); f[i] = *(const unsigned*)(HS + off); }
#pragma unroll
                for (int i = 0; i < 8; ++i) { const size_t off = (size_t)(b * 4096 + 64 * T + 63 - i0 - i) * D + c;
                    h0 = __expf(bflo(g[i]) * cl0) * h0 + bflo(uv[i]); h1 = __expf(bfhi(g[i]) * cl1) * h1 + bfhi(uv[i]);
                    *(unsigned*)(HS + off) = pk2(bflo(f[i]) + h0, bfhi(f[i]) + h1); }
            }
        }
    }
}

#define XB_XCNT(j) (64 * (j))
#define XB_XSUB(j) (1024 + 64 * (j))
#define XB_XGEN(j) (2048 + 64 * (j))
#define XB_TOP 3072
#define XB_TOPGEN 3136
#define XB_WORDS 3200
__device__ __forceinline__ unsigned xb_ld(unsigned* p) { return __hip_atomic_load(p, __ATOMIC_RELAXED, __HIP_MEMORY_SCOPE_AGENT); }
__device__ __forceinline__ unsigned xb_add(unsigned* p, unsigned v) { return __hip_atomic_fetch_add(p, v, __ATOMIC_RELAXED, __HIP_MEMORY_SCOPE_AGENT); }
__device__ __forceinline__ void xb_st(unsigned* p, unsigned v) { __hip_atomic_store(p, v, __ATOMIC_RELAXED, __HIP_MEMORY_SCOPE_AGENT); }
struct XBar { unsigned* bar; unsigned x, nloc, nx, k; };
__device__ __forceinline__ void xbar_init(XBar& B, unsigned* bar) {
    B.bar = bar; B.x = (unsigned)__builtin_amdgcn_s_getreg((3 << 11) | 20) & 0xFu; B.nloc = 0u; B.nx = 0u; B.k = 0u;
    if (threadIdx.x == 0) (void)xb_add(&bar[XB_XCNT(B.x)], 1u);
}
__device__ __forceinline__ void gbar(XBar& B) {
    asm volatile("s_waitcnt vmcnt(0)" ::: "memory");
    __syncthreads();
    B.k += 1u;
    if (threadIdx.x == 0) {
        unsigned* bar = B.bar;
        if (B.nloc == 0u) {
            unsigned sum, cnt, mine;
            for (;;) { sum = 0u; cnt = 0u; mine = 0u;
#pragma unroll
                for (unsigned j = 0; j < 16; ++j) { const unsigned c = xb_ld(&bar[XB_XCNT(j)]); sum += c; cnt += (c > 0u) ? 1u : 0u; mine = (j == B.x) ? c : mine; }
                if (sum == gridDim.x) break;
                __builtin_amdgcn_s_sleep(1); }
            B.nloc = mine; B.nx = cnt;
        }
        const unsigned old = xb_add(&bar[XB_XSUB(B.x)], 1u);
        if (old + 1u == B.k * B.nloc) {
            __builtin_amdgcn_fence(__ATOMIC_RELEASE, "agent");
            asm volatile("s_waitcnt vmcnt(0)" ::: "memory");
            const unsigned t = xb_add(&bar[XB_TOP], 1u);
            if (t + 1u == B.k * B.nx) xb_st(&bar[XB_TOPGEN], B.k);
            else while (xb_ld(&bar[XB_TOPGEN]) < B.k) __builtin_amdgcn_s_sleep(1);
            xb_st(&bar[XB_XGEN(B.x)], B.k);
        } else {
            while (xb_ld(&bar[XB_XGEN(B.x)]) < B.k) __builtin_amdgcn_s_sleep(1);
        }
        __builtin_amdgcn_fence(__ATOMIC_ACQUIRE, "agent");
        asm volatile("s_waitcnt vmcnt(0)" ::: "memory");
    }
    __syncthreads();
}

__device__ __forceinline__ Gemm mk_gemm(const void* A, const void* Bt, int M, int N, int K, int lda, int ldb) { Gemm g; g.A = (const bf16_t*)A; g.Bt = (const bf16_t*)Bt; g.M = M; g.N = N; g.K = K; g.lda = lda; g.ldb = ldb; g.ksh = 0; g.kmask = 0; g.kmul = 0; return g; }

__global__ void __launch_bounds__(NTHREADS, 2) mega(Params p) {
    extern __shared__ __attribute__((aligned(16))) unsigned char shm[];
    LAS unsigned char* lds = (LAS unsigned char*)shm;
    LAS float* ldsf = (LAS float*)shm;
    cg::grid_group grid = cg::this_grid();
    unsigned char* ws = p.ws;
    float* mod = (float*)(ws + O_MOD);
    bf16_t* X1B = (bf16_t*)p.out;
    bf16_t* XNP = (bf16_t*)p.out + (size_t)MLAT * D;
    pg8::StaticOrder S;
    XBar XB; xbar_init(XB, (unsigned*)(ws + O_BAR));
#define BF(off) ((bf16_t*)(ws + (off)))
#define GSYNC() gbar(XB)
    if (p.ws == nullptr) grid.sync();
    cvt_run(p.in[7], DFF, D, DFF, BF(O_UP1), D, CV_UPI, 0, nullptr, ldsf);
    cvt_run(p.in[8], DFF, D, DFF, BF(O_UP1), D, CV_UPI, 1, nullptr, ldsf);
    cvt_run(p.in[9], D, DFF, D, BF(O_DN1), DFF, CV_PLAIN, 0, nullptr, ldsf);
    mod_phase(p, mod, ldsf);
    GSYNC();
    norm_phase(p.in[0], p.in[2], MALL, p.in[6], mod, 0, 1, BF(O_HN), D);
    GSYNC();
    { S.init(MALL, 2 * DFF, gridDim.x, blockIdx.x); EpiUp E{BF(O_U)}; pg8::gemm_phase(lds, mk_gemm(BF(O_HN), BF(O_UP1), MALL, 2 * DFF, D, D, D), S, E); }
    GSYNC();
    const bool fuse_ok = gridDim.x == 256;
    if (fuse_ok) { S.init(MLAT, D, gridDim.x, blockIdx.x); EpiDn1Norm E{p.in[0], X1B, BF(O_XNXS), XNP, mod, p.in[10], RowX{(unsigned*)(ws + O_XSLOT_C), (unsigned*)(ws + O_XCNT_C)}};
        pg8::gemm_phase(lds, mk_gemm(BF(O_U), BF(O_DN1), MLAT, D, DFF, DFF, DFF), S, E); }
    else { S.init(MLAT, D, gridDim.x, blockIdx.x); EpiRes<false, true> E{p.in[0], nullptr, nullptr, X1B, mod, 2, 0.5f}; pg8::gemm_phase(lds, mk_gemm(BF(O_U), BF(O_DN1), MLAT, D, DFF, DFF, DFF), S, E); }
    { const float* gate = mod + (size_t)4 * NMOD + 2 * D; const bf16_t* Uc = BF(O_U) + (size_t)MLAT * DFF;
      { S.init(MCTX, D, gridDim.x, blockIdx.x); EpiCtx E{p.in[2], (float*)(ws + O_CTXX1), gate, 0.5f}; pg8::gemm_phase(lds, mk_gemm(Uc, BF(O_DN1), MCTX, D, DFF / 2, DFF, DFF), S, E); }
      { S.init(MCTX, D, gridDim.x, ((int)blockIdx.x + (int)gridDim.x - 16) % (int)gridDim.x); EpiCtx E{nullptr, (float*)(ws + O_CTXP2), gate, 0.5f}; pg8::gemm_phase(lds, mk_gemm(Uc + DFF / 2, BF(O_DN1) + DFF / 2, MCTX, D, DFF / 2, DFF, DFF), S, E); } }
    { const int cnb = gridDim.x > 64 ? (int)gridDim.x - 32 : (int)gridDim.x, cbid = gridDim.x > 64 ? (int)blockIdx.x - 32 : (int)blockIdx.x;
      if (cbid >= 0) {
        cvt_run2(p.in[11], 7552, D, 3456, BF(O_RW), 2048, CV_RW, 0, p.in[12], ldsf, cbid, cnb);
        for (int d = 0; d < 2; ++d) { cvt_run2(p.in[14] + (size_t)d * 64 * D, D, 64, D, BF(O_LSCW) + (size_t)d * D * 64, 64, CV_PLAIN, 0, nullptr, ldsf, cbid, cnb);
                                      cvt_run2(p.in[16] + (size_t)d * 64 * D, D, 64, D, BF(O_LSCA) + (size_t)d * D * 64, 64, CV_PLAIN, 0, nullptr, ldsf, cbid, cnb); }
        cvt_run2(p.in[17], D, 128, D, BF(O_GUP), 256, CV_PLAIN, 0, nullptr, ldsf, cbid, cnb);
        cvt_run2(p.in[11] + 3456, 7552, D, D, BF(O_LX), D, CV_PLAIN, 0, nullptr, ldsf, cbid, cnb);
        for (int q = 0; q < 8; ++q) { cvt_run2(p.in[27] + (size_t)q * 65536, 256, 256, 256, BF(O_LRUW), 256, CV_LRU, q * 2 + 0, nullptr, ldsf, cbid, cnb);
                                      cvt_run2(p.in[29] + (size_t)q * 65536, 256, 256, 256, BF(O_LRUW), 256, CV_LRU, q * 2 + 1, nullptr, ldsf, cbid, cnb); }
      } }
    zero_fill(ws + O_RW + (size_t)3456 * 2048 * 2, 128 * 2048 * 2, 128 * 2048 * 2, 1);
    zero_fill(ws + O_GUP + 256, 256, 512, 1024);
    { const int t = tidx(); if (blockIdx.x == 20) for (int i = t; i < 2 * D; i += NTHREADS) ((float*)(ws + O_CL))[i] = -8.0f * log1pf(expf(-p.in[26][i])); }
    GSYNC();
    if (fuse_ok) {
        xs_phase(BF(O_XNXS), XNP, MLAT);
        xs_ctx_phase((const float*)(ws + O_CTXX1), (const float*)(ws + O_CTXP2), p.in[10], mod, BF(O_XNXS));
    } else {
        norm_phase<true>(p.in[0], (const float*)(ws + O_CTXX1), MALL, p.in[10], mod, 3, 4, BF(O_XNXS), 2048, (const float*)(ws + O_CTXP2), X1B, XNP, 0);
        GSYNC();
        xs_phase(BF(O_XNXS), nullptr, MALL);
    }
    GSYNC();
    { S.init(MALL, 3584, gridDim.x, blockIdx.x); EpiRw E{BF(O_R), BF(O_LIN), BF(O_GD)}; pg8::gemm_phase(lds, mk_gemm(BF(O_XNXS), BF(O_RW), MALL, 3584, 2048, 2048, 2048), S, E); }
    { const int sh = ((MALL / 256) * 14) % (int)gridDim.x; S.init(MCTX, D, gridDim.x, ((int)blockIdx.x + (int)gridDim.x - sh) % (int)gridDim.x); EpiBf E{BF(O_PLXC), D};
      pg8::gemm_phase(lds, mk_gemm(BF(O_XNXS) + (size_t)MLAT * 2048, BF(O_LX), MCTX, D, D, 2048, D), S, E); }
    GSYNC();
    rncb_phase(BF(O_R), BF(O_K), p.in[18], p.in[20], (float*)(ws + O_RN), (float*)(ws + O_CB));
    cvt_run(p.in[11] + 4480, 7552, D, 3072, BF(O_LATE), D, CV_PLAIN, 0, nullptr, ldsf);
    cvt_run(p.in[23], D, D, D, BF(O_PRW), D, CV_PLAIN, 0, nullptr, ldsf);
    cvt_run(p.in[31], D, D, D, BF(O_PLRU), D, CV_PLAIN, 0, nullptr, ldsf);
    cvt_run(p.in[32], D, D, D, BF(O_WOUT), D, CV_PLAIN, 0, nullptr, ldsf);
    cvt_run(p.in[36], D, DFF, D, BF(O_DN2), DFF, CV_PLAIN, 0, nullptr, ldsf);
    GSYNC();
    rwkv_scan_phase(p, ldsf);
    GSYNC();
    if (gridDim.x == 256) {
        S.init(MLAT, D, gridDim.x, blockIdx.x); EpiPostG E{BF(O_YF), BF(O_YB), BF(O_V), (const float*)(ws + O_CB), p.in[21], p.in[22]};
        pg8::gemm_phase(lds, mk_gemm(BF(O_GD), BF(O_GUP), MLAT, D, 256, 256, 256), S, E);
    } else {
        post_phase(BF(O_YF), BF(O_YB), BF(O_V), (const float*)(ws + O_CB), p.in[21], p.in[22]);
        GSYNC();
        { S.init(MLAT, D, gridDim.x, blockIdx.x); EpiMul E{BF(O_YF), nullptr, 0}; pg8::gemm_phase(lds, mk_gemm(BF(O_GD), BF(O_GUP), MLAT, D, 256, 256, 256), S, E); }
    }
    { S.init(MLAT, D, gridDim.x, blockIdx.x); EpiBf E{BF(O_PLX), D}; pg8::gemm_phase(lds, mk_gemm(XNP, BF(O_LX), MLAT, D, D, D, D), S, E); }
    GSYNC();
    conv_phase(BF(O_PLX), BF(O_PLXC), BF(O_XC), p.in[24], p.in[25]);
    GSYNC();
    { S.init(MALL, 4096, gridDim.x, blockIdx.x); EpiLru E{BF(O_XC), BF(O_GRF), BF(O_UF), BF(O_GRB), BF(O_UB), p.in[28], p.in[30], (const float*)(ws + O_CL)};
      Gemm g = mk_gemm(BF(O_XC), BF(O_LRUW), MALL, 4096, 256, D, 256); g.ksh = 1; g.kmask = 3; g.kmul = 256; pg8::gemm_phase(lds, g, S, E); }
    GSYNC();
    lru_p1_phase(p);
    cvt_run(p.in[34], DFF, D, DFF, BF(O_UP2), D, CV_UPI, 0, nullptr, ldsf);
    cvt_run(p.in[35], DFF, D, DFF, BF(O_UP2), D, CV_UPI, 1, nullptr, ldsf);
    GSYNC();
    lru_p3_phase(p);
    GSYNC();
    { S.init(MLAT, 3072, gridDim.x, blockIdx.x); EpiLate E{BF(O_HSUM), BF(O_SMRW), BF(O_SMLRU)}; pg8::gemm_phase(lds, mk_gemm(XNP, BF(O_LATE), MLAT, 3072, D, D, D), S, E); }
    GSYNC();
    { S.init(MLAT, D, gridDim.x, blockIdx.x); EpiMul E{BF(O_SMRW), nullptr, 0}; pg8::gemm_phase(lds, mk_gemm(BF(O_YF), BF(O_PRW), MLAT, D, D, D, D), S, E); }
    { S.init(MLAT, D, gridDim.x, blockIdx.x); EpiMul E{BF(O_SMRW), BF(O_SMLRU), 1}; pg8::gemm_phase(lds, mk_gemm(BF(O_HSUM), BF(O_PLRU), MLAT, D, D, D, D), S, E); }
    GSYNC();
    if (gridDim.x == 256) {
        S.init(MLAT, D, gridDim.x, blockIdx.x); EpiOutNorm E{X1B, BF(O_X2B), BF(O_HN2), mod, p.in[33], RowX{(unsigned*)(ws + O_XSLOT_B), (unsigned*)(ws + O_XCNT_B)}};
        pg8::gemm_phase(lds, mk_gemm(BF(O_SMRW), BF(O_WOUT), MLAT, D, D, D, D), S, E);
        GSYNC();
    } else {
        { S.init(MLAT, D, gridDim.x, blockIdx.x); EpiRes<true, true> E{nullptr, X1B, nullptr, BF(O_X2B), mod, 5, 1.0f}; pg8::gemm_phase(lds, mk_gemm(BF(O_SMRW), BF(O_WOUT), MLAT, D, D, D, D), S, E); }
        GSYNC();
        norm_phase<true>(p.in[0], (const float*)(ws + O_CTXX1), MLAT, p.in[33], mod, 6, 7, BF(O_HN2), D, nullptr, BF(O_X2B));
        GSYNC();
    }
    { S.init(MLAT, 2 * DFF, gridDim.x, blockIdx.x); EpiUp E{BF(O_U2)}; pg8::gemm_phase(lds, mk_gemm(BF(O_HN2), BF(O_UP2), MLAT, 2 * DFF, D, D, D), S, E); }
    GSYNC();
    if (gridDim.x == 256) {
        S.init(MLAT, D, gridDim.x, blockIdx.x); EpiFinalNorm E{BF(O_X2B), p.out, mod, p.in[37], RowX{(unsigned*)(ws + O_XSLOT_A), (unsigned*)(ws + O_XCNT_A)}};
        pg8::gemm_phase(lds, mk_gemm(BF(O_U2), BF(O_DN2), MLAT, D, DFF, DFF, DFF), S, E);
    } else {
        { S.init(MLAT, D, gridDim.x, blockIdx.x); EpiRes<true, false> E{nullptr, BF(O_X2B), p.out, nullptr, mod, 8, 0.5f}; pg8::gemm_phase(lds, mk_gemm(BF(O_U2), BF(O_DN2), MLAT, D, DFF, DFF, DFF), S, E); }
        GSYNC();
        final_norm_phase(p.out, p.in[37]);
    }
}

extern "C" void kernel_launch(void* const* d_in, const int* in_sizes, int n_in, void* d_out, int out_size, void* d_ws, size_t ws_size, hipStream_t stream) {
    static int grid = 0;
    if (grid == 0) {
        if (n_in != 38 || out_size != MLAT * D || ws_size < WS_NEED) { fprintf(stderr, "kernel_launch: unexpected shapes (n_in %d, out %d, ws %zu); nothing launched\n", n_in, out_size, ws_size); grid = -1; return; }
        int dev = 0, cus = 0, per_cu = 0;
        hipGetDevice(&dev);
        hipDeviceGetAttribute(&cus, hipDeviceAttributeMultiprocessorCount, dev);
        if (hipFuncSetAttribute((const void*)mega, hipFuncAttributeMaxDynamicSharedMemorySize, LDS_BYTES) != hipSuccess) { fprintf(stderr, "kernel_launch: hipFuncSetAttribute failed\n"); grid = -1; return; }
        if (hipOccupancyMaxActiveBlocksPerMultiprocessor(&per_cu, (const void*)mega, NTHREADS, LDS_BYTES) != hipSuccess || per_cu < 1) { fprintf(stderr, "kernel_launch: occupancy query failed (%d)\n", per_cu); per_cu = 1; }
        (void)hipGetLastError();
        grid = cus * (per_cu > 1 ? 1 : per_cu);
    }
    if (grid < 0) return;
    Params p{};
    for (int i = 0; i < 38; ++i) p.in[i] = (const float*)d_in[i];
    p.out = (float*)d_out; p.ws = (unsigned char*)d_ws;
    if (hipMemsetAsync((unsigned char*)d_ws + O_BAR, 0, 65536, stream) != hipSuccess) { fprintf(stderr, "kernel_launch: memset failed\n"); return; }
    void* args[] = {&p};
    hipError_t e = hipLaunchCooperativeKernel((const void*)mega, dim3(grid), dim3(NTHREADS), args, LDS_BYTES, stream);
    if (e != hipSuccess) fprintf(stderr, "kernel_launch: cooperative launch failed: %s (grid %d)\n", hipGetErrorString(e), grid);
}
```

```cpp
#include <hip/hip_runtime.h>
#include <hip/hip_cooperative_groups.h>
#include <cstdio>
#include <cstdint>
namespace cg = cooperative_groups;

#define LAS __attribute__((address_space(3)))
typedef unsigned short bf16_t;
typedef short bf16x8 __attribute__((ext_vector_type(8)));
typedef float f32x4 __attribute__((ext_vector_type(4)));
typedef float f32x2 __attribute__((ext_vector_type(2)));
typedef unsigned u32x4 __attribute__((ext_vector_type(4)));
typedef unsigned u32x2 __attribute__((ext_vector_type(2)));

constexpr int D = 1024, DFF = 2816, MLAT = 16384, MCTX = 1024, MALL = 17408, NMOD = 9216;
constexpr int NTHREADS = 512, LDS_BYTES = 131072;
constexpr size_t MiB = 1048576;
constexpr size_t W0 = 0, W1 = 18 * MiB, SP = 34 * MiB, ACT = 50 * MiB;
constexpr size_t O_UP1 = W0, O_RW = W0, O_LATE = W0, O_PRW = W0 + 6 * MiB, O_PLRU = W0 + 8 * MiB, O_WOUT = W0 + 10 * MiB, O_DN2 = W0 + 12 * MiB;
constexpr size_t O_DN1 = W1 + 10 * MiB, O_LSCW = W1, O_LSCA = W1 + 256 * 1024, O_GUP = W1 + 512 * 1024, O_LX = W1 + 1 * MiB, O_LRUW = W1 + 3 * MiB, O_UP2 = W1;
constexpr size_t O_MOD = SP, O_RN = SP + 256 * 1024, O_CB = O_RN + 1280 * 1024, O_PQ = SP + 3 * MiB, O_CTXX1 = SP + 8 * MiB, O_CL = SP + 12 * MiB, O_BAR = SP + 13 * MiB, O_PLXC = SP + 14 * MiB, O_XCNT_B = SP + 13 * MiB + 16384, O_XCNT_A = SP + 13 * MiB + 32768, O_XSLOT_B = SP + 15 * MiB, O_XSLOT_A = SP + 15 * MiB + 262144, O_XCNT_C = SP + 13 * MiB + 49152, O_XSLOT_C = SP + 15 * MiB + 524288, O_CTXP2 = ACT + 200 * MiB, O_X2B = ACT + 136 * MiB;
constexpr size_t O_HN = ACT, O_U = ACT + 34 * MiB;
constexpr size_t O_XNXS = ACT, O_R = ACT + 68 * MiB, O_K = ACT + 102 * MiB, O_V = ACT + 136 * MiB, O_LIN = ACT + 170 * MiB, O_GD = ACT + 178 * MiB + 512 * 1024;
constexpr size_t O_YF = ACT, O_YB = ACT + 32 * MiB, O_XN2 = ACT + 68 * MiB, O_PLX = ACT + 102 * MiB, O_XC = ACT + 136 * MiB;
constexpr size_t O_GRF = ACT + 32 * MiB, O_UF = ACT + 66 * MiB, O_GRB = ACT + 100 * MiB, O_UB = ACT + 170 * MiB;
constexpr size_t O_HSUM = ACT + 136 * MiB, O_XN3 = ACT + 32 * MiB, O_SMRW = ACT + 66 * MiB, O_SMLRU = ACT + 98 * MiB;
constexpr size_t O_HN2 = ACT, O_U2 = ACT + 34 * MiB;
constexpr size_t WS_NEED = 256 * MiB;

struct Params { const float* in[38]; float* out; unsigned char* ws; };

__device__ __forceinline__ float bf2f(unsigned short b) { return __uint_as_float(((unsigned)b) << 16); }
__device__ __forceinline__ float bflo(unsigned u) { return __uint_as_float(u << 16); }
__device__ __forceinline__ float bfhi(unsigned u) { return __uint_as_float(u & 0xffff0000u); }
typedef __bf16 bf16x2_t __attribute__((ext_vector_type(2)));
__device__ __forceinline__ unsigned pk2(float lo, float hi) { const f32x2 v = {lo, hi}; const bf16x2_t b = __builtin_convertvector(v, bf16x2_t); return __builtin_bit_cast(unsigned, b); }
__device__ __forceinline__ int tidx() { int t = threadIdx.x; asm volatile("" : "+v"(t)); return t; }
__device__ __forceinline__ float frcp(float x) { return __builtin_amdgcn_rcpf(x); }
__device__ __forceinline__ float sigm(float x) { return frcp(1.0f + __expf(-x)); }
__device__ __forceinline__ float tanh_f(float x) { return 1.0f - 2.0f * frcp(__expf(2.0f * x) + 1.0f); }
__device__ __forceinline__ float silu_f(float x) { return x * sigm(x); }
__device__ __forceinline__ float gelu_f(float x) { return x * sigm(1.5957691216f * (x + 0.044715f * x * x * x)); }
__device__ __forceinline__ float wave_sum(float v) {
#pragma unroll
    for (int o = 1; o < 64; o <<= 1) v += __shfl_xor(v, o);
    return v;
}
template <int CTRL> __device__ __forceinline__ float dppf(float v) {
    return __builtin_bit_cast(float, __builtin_amdgcn_update_dpp(0, __builtin_bit_cast(int, v), CTRL, 0xF, 0xF, true));
}
__device__ __forceinline__ float red16(float v) {
    v += dppf<0xB1>(v); v += dppf<0x4E>(v); v += dppf<0x141>(v); v += dppf<0x140>(v); return v;
}

namespace pg8 {
constexpr int BM = 256, BK = 64, HALF = 128, HTB = HALF * BK * 2, NXCD = 8, WGM = 8;
__device__ __forceinline__ int lds_byte(int r, int c) { const int st = (r >> 4) * 2 + (c >> 5), rr = r & 15, cc = c & 31, ob = rr * 64 + cc * 2; return st * 1024 + (ob ^ (((ob >> 9) & 1) << 5)); }
__device__ __forceinline__ void stage_rc(int b, int& R, int& C) { const int st = b / 1024, sb = b % 1024, swz = sb ^ (((sb >> 9) & 1) << 5); R = (st >> 1) * 16 + swz / 64; C = (st & 1) * 32 + (swz % 64) / 2; }
struct Unit { int pm, pn; };
struct Gemm { const bf16_t* A; const bf16_t* Bt; int M, N, K, lda, ldb, ksh, kmask, kmul; };
struct StaticOrder {
    int nM, nN, nwg, G, c;
    __device__ void init(int M, int N, int G_, int c_) { nM = M / BM; nN = N / BM; nwg = nM * nN; G = G_; c = c_; }
    __device__ bool next(int i, Unit& u) const {
        const long L = (long)i * G + c; if (L >= nwg) return false;
        int wgid = (int)L; { const int q = nwg / NXCD, r = nwg % NXCD, xcd = wgid % NXCD, off = wgid / NXCD; wgid = (xcd < r ? xcd * (q + 1) : r * (q + 1) + (xcd - r) * q) + off; }
        const int nig = WGM * nN, gid = wgid / nig, fm = gid * WGM, gsz = (nM - fm) < WGM ? (nM - fm) : WGM;
        u.pm = fm + ((wgid % nig) % gsz); u.pn = (wgid % nig) / gsz; return true;
    }
};

template <class E, class = void> struct is_ad { static constexpr bool value = false; };
template <class E> struct is_ad<E, decltype((void)E::AFTER_DRAIN)> { static constexpr bool value = true; };

template <class Epi>
__device__ __forceinline__ void gemm_phase(LAS unsigned char* lds, const Gemm g, const StaticOrder& S, const Epi& E) {
    const int tid = tidx(), wid = __builtin_amdgcn_readfirstlane(tid >> 6), lane = tid & 63, wr = wid >> 2, wc = wid & 3, fr = lane & 15, fq = lane >> 4;
    const int K = g.K, nt = K / BK;
    unsigned voffA[2], voffB[2];
#pragma unroll
    for (int i = 0; i < 2; ++i) { int R, C; stage_rc(tid * 16 + i * 8192, R, C);
        voffA[i] = (unsigned)(R * g.lda + C) * 2u; voffB[i] = (unsigned)(R * g.ldb + C) * 2u; }
    const size_t kstep = (size_t)(BK * 2);
    const size_t hstepA = (size_t)HALF * g.lda * 2, hstepB = (size_t)HALF * g.ldb * 2;
    const size_t tstepA = 2 * hstepA, tstepB = 2 * hstepB;
    const unsigned ldsw = (unsigned)wid * 1024u;
    const int aoff = lds_byte(wr * 64 + fr, fq * 8), boff = lds_byte(wc * 32 + fr, fq * 8);
#define PG8_SA(b, h) (((b) * 2 + (h)) * HTB)
#define PG8_SB(b, h) ((4 + (b) * 2 + (h)) * HTB)
#define PG8_STAGE(bufoff, gbase, voff) do { _Pragma("unroll") for (int _i = 0; _i < 2; ++_i) \
        __builtin_amdgcn_global_load_lds((const unsigned*)((const char*)(gbase) + (voff)[_i]), (LAS unsigned*)(lds + (bufoff) + ldsw + _i * 8192), 16, 0, 0); } while (0)
#define PG8_LDA(dst, b, h) do { _Pragma("unroll") for (int m = 0; m < 4; ++m) _Pragma("unroll") for (int k = 0; k < 2; ++k) dst[m][k] = *(const LAS bf16x8*)(lds + PG8_SA(b, h) + aoff + m * 2048 + k * 1024); } while (0)
#define PG8_LDB(dst, b, h) do { _Pragma("unroll") for (int n = 0; n < 2; ++n) _Pragma("unroll") for (int k = 0; k < 2; ++k) dst[n][k] = *(const LAS bf16x8*)(lds + PG8_SB(b, h) + boff + n * 2048 + k * 1024); } while (0)
#define PG8_MMA(ai, bj, At, Bt) do { __builtin_amdgcn_s_setprio(1); _Pragma("unroll") for (int m = 0; m < 4; ++m) _Pragma("unroll") for (int n = 0; n < 2; ++n) _Pragma("unroll") for (int k = 0; k < 2; ++k) \
        acc[ai][bj][m][n] = __builtin_amdgcn_mfma_f32_16x16x32_bf16(Bt[n][k], At[m][k], acc[ai][bj][m][n], 0, 0, 0); __builtin_amdgcn_s_setprio(0); } while (0)
#define PG8_WAIT_V(n) asm volatile("s_waitcnt vmcnt(" #n ")" ::: "memory")
#define PG8_WAIT_L(n) asm volatile("s_waitcnt lgkmcnt(" #n ")" ::: "memory")
#define PG8_BAR __builtin_amdgcn_s_barrier()
#define PG8_SCHED __builtin_amdgcn_sched_barrier(0)
#define PG8_KOFF(u) ((size_t)((((u).pn >> g.ksh) & g.kmask) * g.kmul) * 2)
    Unit cur, nxt; int ui = 0;
    if (!S.next(0, cur)) return;
    f32x4 acc[2][2][4][2];
#pragma unroll
    for (int a = 0; a < 2; ++a)
#pragma unroll
        for (int b = 0; b < 2; ++b)
#pragma unroll
            for (int m = 0; m < 4; ++m)
#pragma unroll
                for (int n = 0; n < 2; ++n) acc[a][b][m][n] = (f32x4){0.f, 0.f, 0.f, 0.f};
    bf16x8 At[4][2], B0[2][2], B1[2][2];
    const char* cA = (const char*)g.A + (size_t)cur.pm * tstepA + PG8_KOFF(cur); const char* cB = (const char*)g.Bt + (size_t)cur.pn * tstepB;
    PG8_STAGE(PG8_SB(0, 0), cB, voffB); PG8_STAGE(PG8_SA(0, 0), cA, voffA); PG8_STAGE(PG8_SB(0, 1), cB + hstepB, voffB); PG8_STAGE(PG8_SA(0, 1), cA + hstepA, voffA);
    if (wr == 1) PG8_BAR;
    PG8_WAIT_V(4); PG8_BAR;
    PG8_STAGE(PG8_SB(1, 0), cB + kstep, voffB); PG8_STAGE(PG8_SA(1, 0), cA + kstep, voffA); PG8_STAGE(PG8_SB(1, 1), cB + hstepB + kstep, voffB);
    PG8_WAIT_V(6); PG8_BAR;
    for (;;) {
        const bool has_next = S.next(ui + 1, nxt);
        const char* nA = has_next ? (const char*)g.A + (size_t)nxt.pm * tstepA + PG8_KOFF(nxt) : cA; const char* nB = has_next ? (const char*)g.Bt + (size_t)nxt.pn * tstepB : cB;
        for (int t = 0; t < nt; t += 2) {
            const bool last = (t == nt - 2);
            const char* a1 = cA + (size_t)(t + 1) * kstep;
            const char* a2 = last ? nA : cA + (size_t)(t + 2) * kstep; const char* b2 = last ? nB : cB + (size_t)(t + 2) * kstep;
            const char* a3 = a2 + kstep; const char* b3 = b2 + kstep;
            PG8_LDB(B0, 0, 0); PG8_SCHED; PG8_LDA(At, 0, 0); PG8_STAGE(PG8_SA(1, 1), a1 + hstepA, voffA);
            PG8_WAIT_L(8); PG8_BAR; PG8_WAIT_L(0); PG8_MMA(0, 0, At, B0); PG8_BAR; PG8_SCHED;
            PG8_LDB(B1, 0, 1); PG8_STAGE(PG8_SB(0, 0), b2, voffB);
            PG8_BAR; PG8_WAIT_L(0); PG8_MMA(0, 1, At, B1); PG8_BAR;
            PG8_LDA(At, 0, 1); PG8_STAGE(PG8_SA(0, 0), a2, voffA);
            PG8_BAR; PG8_WAIT_L(0); PG8_MMA(1, 0, At, B0); PG8_BAR; PG8_SCHED;
            PG8_STAGE(PG8_SB(0, 1), b2 + hstepB, voffB);
            PG8_WAIT_V(6); PG8_BAR; PG8_MMA(1, 1, At, B1); PG8_BAR;
            PG8_LDB(B0, 1, 0); PG8_SCHED; PG8_LDA(At, 1, 0); PG8_STAGE(PG8_SA(0, 1), a2 + hstepA, voffA);
            PG8_WAIT_L(8); PG8_BAR; PG8_WAIT_L(0); PG8_MMA(0, 0, At, B0); PG8_BAR; PG8_SCHED;
            PG8_LDB(B1, 1, 1); PG8_STAGE(PG8_SB(1, 0), b3, voffB);
            PG8_BAR; PG8_WAIT_L(0); PG8_MMA(0, 1, At, B1); PG8_BAR;
            PG8_LDA(At, 1, 1); PG8_STAGE(PG8_SA(1, 0), a3, voffA);
            PG8_BAR; PG8_WAIT_L(0); PG8_MMA(1, 0, At, B0); PG8_BAR; PG8_SCHED;
            PG8_STAGE(PG8_SB(1, 1), b3 + hstepB, voffB);
            PG8_WAIT_V(6); PG8_BAR; PG8_MMA(1, 1, At, B1); PG8_BAR;
        }
        if constexpr (!is_ad<Epi>::value) E(acc, cur, wr, wc, fr, fq);
        if (!has_next) break;
#pragma unroll
        for (int a = 0; a < 2; ++a)
#pragma unroll
            for (int b = 0; b < 2; ++b)
#pragma unroll
                for (int m = 0; m < 4; ++m)
#pragma unroll
                    for (int n = 0; n < 2; ++n) acc[a][b][m][n] = (f32x4){0.f, 0.f, 0.f, 0.f};
        cur = nxt; cA = nA; cB = nB; ++ui;
    }
    PG8_WAIT_V(0);
    if (wr == 0) PG8_BAR;
    PG8_BAR;
    if constexpr (is_ad<Epi>::value) E.fused(acc, cur, wr, wc, fr, fq, lds, wid, lane);
#undef PG8_SA
#undef PG8_SB
#undef PG8_STAGE
#undef PG8_LDA
#undef PG8_LDB
#undef PG8_MMA
#undef PG8_WAIT_V
#undef PG8_WAIT_L
#undef PG8_BAR
#undef PG8_SCHED
#undef PG8_KOFF
}
}
using pg8::Unit;
using pg8::Gemm;

#define EPI_ROWS(...) _Pragma("unroll") for (int ai = 0; ai < 2; ++ai) _Pragma("unroll") for (int m = 0; m < 4; ++m) { const int row = u.pm * 256 + ai * 128 + wr * 64 + m * 16 + fr; __VA_ARGS__ }
#define EPI_ALL(...) _Pragma("unroll") for (int ai = 0; ai < 2; ++ai) _Pragma("unroll") for (int m = 0; m < 4; ++m) _Pragma("unroll") for (int bj = 0; bj < 2; ++bj) _Pragma("unroll") for (int n = 0; n < 2; ++n) { \
        const int row = u.pm * 256 + ai * 128 + wr * 64 + m * 16 + fr; __VA_ARGS__ }
typedef const f32x4 (&AccRef)[2][2][4][2];

struct EpiUp {
    bf16_t* U;
    __device__ __forceinline__ void operator()(AccRef acc, const Unit& u, int wr, int wc, int fr, int fq) const {
        EPI_ROWS(
            _Pragma("unroll") for (int bj = 0; bj < 2; ++bj) {
                const f32x4 g = acc[ai][bj][m][0], v = acc[ai][bj][m][1];
                const int f0 = ((u.pn * 256 + bj * 128 + wc * 32) >> 1) + 4 * fq;
                u32x2 o; o.x = pk2(silu_f(g[0]) * v[0], silu_f(g[1]) * v[1]); o.y = pk2(silu_f(g[2]) * v[2], silu_f(g[3]) * v[3]);
                *(u32x2*)(U + (size_t)row * DFF + f0) = o; }
        )
    }
};
template <bool RB, bool OB> struct EpiRes {
    const float* res_f; const bf16_t* res_b; float* out_f; bf16_t* out_b; const float* mod; int gidx; float scale;
    __device__ __forceinline__ void operator()(AccRef acc, const Unit& u, int wr, int wc, int fr, int fq) const {
        u32x2 tv[2][4][2][2];
        if constexpr (RB) { EPI_ALL( const int col = u.pn * 256 + bj * 128 + wc * 32 + n * 16 + 4 * fq; tv[ai][m][bj][n] = *(const u32x2*)(res_b + (size_t)row * D + col); ) }
        EPI_ROWS(
            const float* gp = mod + (size_t)(row >> 12) * NMOD + gidx * D;
            _Pragma("unroll") for (int bj = 0; bj < 2; ++bj) _Pragma("unroll") for (int n = 0; n < 2; ++n) {
                const int col = u.pn * 256 + bj * 128 + wc * 32 + n * 16 + 4 * fq; const size_t off = (size_t)row * D + col;
                f32x4 r;
                if constexpr (RB) { const u32x2 t = tv[ai][m][bj][n]; r = (f32x4){bflo(t.x), bfhi(t.x), bflo(t.y), bfhi(t.y)}; } else r = *(const f32x4*)(res_f + off);
                const f32x4 gt = *(const f32x4*)(gp + col);
                const f32x4 o = r + scale * gt * acc[ai][bj][m][n];
                if constexpr (OB) { u32x2 w; w.x = pk2(o[0], o[1]); w.y = pk2(o[2], o[3]); *(u32x2*)(out_b + off) = w; } else *(f32x4*)(out_f + off) = o; }
        )
    }
};
struct EpiCtx {
    const float* res; float* out; const float* gate; float scale;
    __device__ __forceinline__ void operator()(AccRef acc, const Unit& u, int wr, int wc, int fr, int fq) const {
        EPI_ROWS(
            _Pragma("unroll") for (int bj = 0; bj < 2; ++bj) _Pragma("unroll") for (int n = 0; n < 2; ++n) {
                const int col = u.pn * 256 + bj * 128 + wc * 32 + n * 16 + 4 * fq; const size_t off = (size_t)row * D + col;
                const f32x4 gt = *(const f32x4*)(gate + col); f32x4 r = (f32x4){0.f, 0.f, 0.f, 0.f};
                if (res) r = *(const f32x4*)(res + off);
                *(f32x4*)(out + off) = r + scale * gt * acc[ai][bj][m][n]; }
        )
    }
};
struct EpiRw {
    bf16_t *RKV, *LIN, *GD;
    __device__ __forceinline__ void operator()(AccRef acc, const Unit& u, int wr, int wc, int fr, int fq) const {
        const int pn = u.pn;
        if (pn < 12) {
            bf16_t* base = RKV + (size_t)(pn >> 2) * ((size_t)MALL * D) + (pn & 3) * 256;
            EPI_ROWS(
                _Pragma("unroll") for (int bj = 0; bj < 2; ++bj) _Pragma("unroll") for (int n = 0; n < 2; ++n) {
                    const int cl = bj * 128 + wc * 32 + n * 16 + 4 * fq; const f32x4 a = acc[ai][bj][m][n];
                    u32x2 o; o.x = pk2(a[0], a[1]); o.y = pk2(a[2], a[3]);
                    *(u32x2*)(base + (size_t)row * D + cl) = o; }
            )
        } else if (pn == 12) {
            EPI_ROWS(
                _Pragma("unroll") for (int bj = 0; bj < 2; ++bj) _Pragma("unroll") for (int n = 0; n < 2; ++n) {
                    const int cl = bj * 128 + wc * 32 + n * 16 + 4 * fq; f32x4 a = acc[ai][bj][m][n];
                    if (bj == 0) { a[0] = tanh_f(a[0]); a[1] = tanh_f(a[1]); a[2] = tanh_f(a[2]); a[3] = tanh_f(a[3]); }
                    u32x2 o; o.x = pk2(a[0], a[1]); o.y = pk2(a[2], a[3]);
                    *(u32x2*)(LIN + (size_t)row * 256 + cl) = o; }
            )
        } else {
            EPI_ROWS(
                _Pragma("unroll") for (int bj = 0; bj < 2; ++bj) _Pragma("unroll") for (int n = 0; n < 2; ++n) {
                    const int cl = bj * 128 + wc * 32 + n * 16 + 4 * fq; const f32x4 a = acc[ai][bj][m][n];
                    u32x2 o; o.x = 0u; o.y = 0u;
                    if (bj == 0) { o.x = pk2(sigm(a[0]), sigm(a[1])); o.y = pk2(sigm(a[2]), sigm(a[3])); }
                    *(u32x2*)(GD + (size_t)row * 256 + cl) = o; }
            )
        }
    }
};
struct EpiBf {
    bf16_t* O; int ldo;
    __device__ __forceinline__ void operator()(AccRef acc, const Unit& u, int wr, int wc, int fr, int fq) const {
        EPI_ROWS(
            _Pragma("unroll") for (int bj = 0; bj < 2; ++bj) _Pragma("unroll") for (int n = 0; n < 2; ++n) {
                const int col = u.pn * 256 + bj * 128 + wc * 32 + n * 16 + 4 * fq; const f32x4 a = acc[ai][bj][m][n];
                u32x2 o; o.x = pk2(a[0], a[1]); o.y = pk2(a[2], a[3]);
                *(u32x2*)(O + (size_t)row * ldo + col) = o; }
        )
    }
};
struct EpiMul {
    bf16_t* T; const bf16_t* S2; int mode;
    __device__ __forceinline__ void operator()(AccRef acc, const Unit& u, int wr, int wc, int fr, int fq) const {
#pragma unroll
        for (int ai = 0; ai < 2; ++ai) {
            u32x2 tv[4][2][2], sv[4][2][2];
#pragma unroll
            for (int m = 0; m < 4; ++m)
#pragma unroll
                for (int bj = 0; bj < 2; ++bj)
#pragma unroll
                    for (int n = 0; n < 2; ++n) { const int row = u.pm * 256 + ai * 128 + wr * 64 + m * 16 + fr, col = u.pn * 256 + bj * 128 + wc * 32 + n * 16 + 4 * fq; const size_t off = (size_t)row * D + col;
                        tv[m][bj][n] = *(const u32x2*)(T + off); sv[m][bj][n] = (u32x2){0u, 0u}; if (mode != 0) sv[m][bj][n] = *(const u32x2*)(S2 + off); }
#pragma unroll
            for (int m = 0; m < 4; ++m)
#pragma unroll
                for (int bj = 0; bj < 2; ++bj)
#pragma unroll
                    for (int n = 0; n < 2; ++n) { const int row = u.pm * 256 + ai * 128 + wr * 64 + m * 16 + fr, col = u.pn * 256 + bj * 128 + wc * 32 + n * 16 + 4 * fq; const size_t off = (size_t)row * D + col;
                        const f32x4 a = acc[ai][bj][m][n]; const u32x2 t = tv[m][bj][n], q = sv[m][bj][n]; u32x2 o;
                        if (mode == 0) { o.x = pk2(bflo(t.x) * a[0], bfhi(t.x) * a[1]); o.y = pk2(bflo(t.y) * a[2], bfhi(t.y) * a[3]); }
                        else { o.x = pk2(bflo(t.x) + bflo(q.x) * a[0], bfhi(t.x) + bfhi(q.x) * a[1]); o.y = pk2(bflo(t.y) + bflo(q.y) * a[2], bfhi(t.y) + bfhi(q.y) * a[3]); }
                        *(u32x2*)(T + off) = o; }
        }
    }
};
struct EpiLru {
    const bf16_t* XC; bf16_t *GR0, *U0, *GR1, *U1; const float *ba, *bx, *cl;
    __device__ __forceinline__ void operator()(AccRef acc, const Unit& u, int wr, int wc, int fr, int fq) const {
        const int d = u.pn >> 3, pn8 = u.pn & 7;
        bf16_t* GR = GR0 + (size_t)d * ((size_t)(O_GRB - O_GRF) / 2); bf16_t* UU = U0 + (size_t)d * ((size_t)(O_UB - O_UF) / 2);
#pragma unroll
        for (int bj = 0; bj < 2; ++bj) { const int c0 = 128 * pn8 + 16 * (4 * bj + wc) + 4 * fq;
            const f32x4 vba = *(const f32x4*)(ba + d * D + c0), vbx = *(const f32x4*)(bx + d * D + c0), vcl = *(const f32x4*)(cl + d * D + c0);
            u32x2 xv[2][4];
            EPI_ROWS( xv[ai][m] = *(const u32x2*)(XC + (size_t)row * D + c0); )
            EPI_ROWS(
                const size_t off = (size_t)row * D + c0;
                const u32x2 xcv = xv[ai][m];
                const float xc[4] = {bflo(xcv.x), bfhi(xcv.x), bflo(xcv.y), bfhi(xcv.y)};
                float gr[4]; float uu[4];
                _Pragma("unroll") for (int j = 0; j < 4; ++j) {
                    gr[j] = sigm(acc[ai][bj][m][0][j] + vba[j]);
                    const float gi = sigm(acc[ai][bj][m][1][j] + vbx[j]);
                    const float x = 2.0f * gr[j] * vcl[j];
                    const float om = -x * (1.0f + 0.5f * x * (1.0f + (1.0f / 3.0f) * x * (1.0f + 0.25f * x)));
                    uu[j] = __builtin_amdgcn_sqrtf(om) * gi * xc[j]; }
                u32x2 o1; u32x2 o2; o1.x = pk2(gr[0], gr[1]); o1.y = pk2(gr[2], gr[3]); o2.x = pk2(uu[0], uu[1]); o2.y = pk2(uu[2], uu[3]);
                *(u32x2*)(GR + off) = o1; *(u32x2*)(UU + off) = o2;
            )
        }
    }
};
struct EpiLate {
    bf16_t *HS, *S1, *S2;
    __device__ __forceinline__ void operator()(AccRef acc, const Unit& u, int wr, int wc, int fr, int fq) const {
        const int part = u.pn >> 2;
        if (part == 0) {
            u32x2 tv[2][4][2][2];
            EPI_ALL( const int col = (u.pn & 3) * 256 + bj * 128 + wc * 32 + n * 16 + 4 * fq; tv[ai][m][bj][n] = *(const u32x2*)(HS + (size_t)row * D + col); )
            EPI_ALL( const int col = (u.pn & 3) * 256 + bj * 128 + wc * 32 + n * 16 + 4 * fq; const f32x4 a = acc[ai][bj][m][n]; const u32x2 t = tv[ai][m][bj][n]; u32x2 o;
                o.x = pk2(bflo(t.x) * gelu_f(a[0]), bfhi(t.x) * gelu_f(a[1])); o.y = pk2(bflo(t.y) * gelu_f(a[2]), bfhi(t.y) * gelu_f(a[3]));
                *(u32x2*)(HS + (size_t)row * D + col) = o; )
        } else {
            bf16_t* O = part == 1 ? S1 : S2;
            EPI_ALL( const int col = (u.pn & 3) * 256 + bj * 128 + wc * 32 + n * 16 + 4 * fq; const f32x4 a = acc[ai][bj][m][n]; u32x2 o;
                o.x = pk2(sigm(a[0]), sigm(a[1])); o.y = pk2(sigm(a[2]), sigm(a[3])); *(u32x2*)(O + (size_t)row * D + col) = o; )
        }
    }
};

struct EpiPostG {
    static constexpr bool AFTER_DRAIN = true;
    bf16_t* YF; const bf16_t* YB; const bf16_t* V; const float* cb; const float* lnw; const float* lnb;
    __device__ __forceinline__ void fused(f32x4 (&acc)[2][2][4][2], const Unit& u, int wr, int wc, int fr, int fq, LAS unsigned char* lds, int wid, int lane) const {
        LAS f32x2* P = (LAS f32x2*)lds;
#pragma unroll
        for (int ai = 0; ai < 2; ++ai)
#pragma unroll
            for (int bj = 0; bj < 2; ++bj) { const int qd = ai * 2 + bj;
                u32x2 a[4][2], b[4][2], vv[4][2];
#pragma unroll
                for (int m = 0; m < 4; ++m)
#pragma unroll
                    for (int n = 0; n < 2; ++n) { const size_t off = (size_t)(u.pm * 256 + ai * 128 + wr * 64 + m * 16 + fr) * D + u.pn * 256 + bj * 128 + wc * 32 + n * 16 + 4 * fq;
                        a[m][n] = *(const u32x2*)(YF + off); b[m][n] = *(const u32x2*)(YB + off); vv[m][n] = *(const u32x2*)(V + off); }
                f32x4 y[4][2];
#pragma unroll
                for (int m = 0; m < 4; ++m) { float s1 = 0.f, s2 = 0.f;
#pragma unroll
                    for (int n = 0; n < 2; ++n) { const f32x4 t = (f32x4){bflo(a[m][n].x) + bflo(b[m][n].x), bfhi(a[m][n].x) + bfhi(b[m][n].x), bflo(a[m][n].y) + bflo(b[m][n].y), bfhi(a[m][n].y) + bfhi(b[m][n].y)};
                        y[m][n] = t; s1 += (t[0] + t[1]) + (t[2] + t[3]); s2 += (t[0] * t[0] + t[1] * t[1]) + (t[2] * t[2] + t[3] * t[3]); }
                    s1 += __shfl_xor(s1, 16); s1 += __shfl_xor(s1, 32); s2 += __shfl_xor(s2, 16); s2 += __shfl_xor(s2, 32);
                    if (fq == 0) P[(qd * 128 + wr * 64 + m * 16 + fr) * 4 + wc] = (f32x2){s1, s2}; }
                __syncthreads();
                const int head = 4 * u.pn + 2 * bj + (wc >> 1);
#pragma unroll
                for (int m = 0; m < 4; ++m) { const int rl = wr * 64 + m * 16 + fr, row = u.pm * 256 + ai * 128 + rl;
                    const f32x2 p0 = P[(qd * 128 + rl) * 4 + wc], p1 = P[(qd * 128 + rl) * 4 + (wc ^ 1)];
                    const float mean = (p0[0] + p1[0]) * (1.0f / 64.0f), var = fmaxf((p0[1] + p1[1]) * (1.0f / 64.0f) - mean * mean, 0.f), rs = rsqrtf(var + 64e-5f);
                    const float cbs = cb[(size_t)row * 16 + head];
#pragma unroll
                    for (int n = 0; n < 2; ++n) { const int col = u.pn * 256 + bj * 128 + wc * 32 + n * 16 + 4 * fq; const size_t off = (size_t)row * D + col;
                        const f32x4 w = *(const f32x4*)(lnw + col), bb = *(const f32x4*)(lnb + col), g = acc[ai][bj][m][n];
                        const f32x4 v4 = (f32x4){bflo(vv[m][n].x), bfhi(vv[m][n].x), bflo(vv[m][n].y), bfhi(vv[m][n].y)};
                        const f32x4 o = ((y[m][n] - mean) * rs * w + bb + cbs * v4) * g;
                        u32x2 q; q.x = pk2(o[0], o[1]); q.y = pk2(o[2], o[3]); *(u32x2*)(YF + off) = q; } }
            }
        __syncthreads();
    }
};
struct RowX { unsigned* slots; unsigned* cnt; };
__device__ __forceinline__ void row_rstd_exchange(f32x4 (&v)[2][2][4][2], const Unit& u, int wr, int wc, int fr, int fq, LAS unsigned char* lds, int wid, int lane, const RowX& X) {
    LAS float* P = (LAS float*)lds; LAS float* S = (LAS float*)(lds + 4096);
#pragma unroll
    for (int ai = 0; ai < 2; ++ai)
#pragma unroll
        for (int m = 0; m < 4; ++m) { float q = 0.f;
#pragma unroll
            for (int bj = 0; bj < 2; ++bj)
#pragma unroll
                for (int n = 0; n < 2; ++n) { const f32x4 x = v[ai][bj][m][n]; q += (x[0] * x[0] + x[1] * x[1]) + (x[2] * x[2] + x[3] * x[3]); }
            q += __shfl_xor(q, 16); q += __shfl_xor(q, 32);
            if (fq == 0) P[(ai * 128 + wr * 64 + m * 16 + fr) * 4 + wc] = q; }
    __syncthreads();
    const int row = wid * 32 + (lane & 31);
    if (lane < 32) { const float t = (P[row * 4] + P[row * 4 + 1]) + (P[row * 4 + 2] + P[row * 4 + 3]);
        __hip_atomic_store(X.slots + ((size_t)(u.pm * 256 + row) * 4 + u.pn), __float_as_uint(t), __ATOMIC_RELAXED, __HIP_MEMORY_SCOPE_AGENT); }
    asm volatile("s_waitcnt vmcnt(0)" ::: "memory");
    if (lane == 0) __hip_atomic_fetch_add(X.cnt + 64 * u.pm, 1u, __ATOMIC_RELAXED, __HIP_MEMORY_SCOPE_AGENT);
    if (wid == 0) { unsigned sp = 0u;
        while ((unsigned)__builtin_amdgcn_readfirstlane(__hip_atomic_load(X.cnt + 64 * u.pm, __ATOMIC_RELAXED, __HIP_MEMORY_SCOPE_AGENT)) < 32u) { __builtin_amdgcn_s_sleep(1); if (++sp > (1u << 22)) break; } }
    __syncthreads();
    if (lane < 32) { const unsigned* sl = X.slots + (size_t)(u.pm * 256 + row) * 4; float t = 0.f;
#pragma unroll
        for (int q = 0; q < 4; ++q) t += __uint_as_float(__hip_atomic_load(sl + q, __ATOMIC_RELAXED, __HIP_MEMORY_SCOPE_AGENT));
        S[row] = rsqrtf(t * (1.0f / D) + 1e-6f); }
    __syncthreads();
}
struct EpiOutNorm {
    static constexpr bool AFTER_DRAIN = true;
    const bf16_t* res_b; bf16_t* x2b; bf16_t* hn; const float* mod; const float* g2; RowX X;
    __device__ __forceinline__ void fused(f32x4 (&acc)[2][2][4][2], const Unit& u, int wr, int wc, int fr, int fq, LAS unsigned char* lds, int wid, int lane) const {
        const float* mb = mod + (size_t)((u.pm * 256) >> 12) * NMOD;
#pragma unroll
        for (int ai = 0; ai < 2; ++ai) { u32x2 tv[4][2][2];
#pragma unroll
            for (int m = 0; m < 4; ++m)
#pragma unroll
                for (int bj = 0; bj < 2; ++bj)
#pragma unroll
                    for (int n = 0; n < 2; ++n) { const int row = u.pm * 256 + ai * 128 + wr * 64 + m * 16 + fr, col = u.pn * 256 + bj * 128 + wc * 32 + n * 16 + 4 * fq; tv[m][bj][n] = *(const u32x2*)(res_b + (size_t)row * D + col); }
#pragma unroll
            for (int m = 0; m < 4; ++m)
#pragma unroll
                for (int bj = 0; bj < 2; ++bj)
#pragma unroll
                    for (int n = 0; n < 2; ++n) { const int row = u.pm * 256 + ai * 128 + wr * 64 + m * 16 + fr, col = u.pn * 256 + bj * 128 + wc * 32 + n * 16 + 4 * fq; const u32x2 t = tv[m][bj][n];
                        const f32x4 gt = *(const f32x4*)(mb + 5 * D + col);
                        const f32x4 o = (f32x4){bflo(t.x), bfhi(t.x), bflo(t.y), bfhi(t.y)} + gt * acc[ai][bj][m][n];
                        acc[ai][bj][m][n] = o;
                        u32x2 w; w.x = pk2(o[0], o[1]); w.y = pk2(o[2], o[3]); *(u32x2*)(x2b + (size_t)row * D + col) = w; }
        }
        row_rstd_exchange(acc, u, wr, wc, fr, fq, lds, wid, lane, X);
        const LAS float* S = (const LAS float*)(lds + 4096);
#pragma unroll
        for (int bj = 0; bj < 2; ++bj)
#pragma unroll
            for (int n = 0; n < 2; ++n) { const int col = u.pn * 256 + bj * 128 + wc * 32 + n * 16 + 4 * fq;
                const f32x4 mul = *(const f32x4*)(g2 + col) * (1.0f + *(const f32x4*)(mb + 7 * D + col)), sh = *(const f32x4*)(mb + 6 * D + col);
#pragma unroll
                for (int ai = 0; ai < 2; ++ai)
#pragma unroll
                    for (int m = 0; m < 4; ++m) { const int rl = ai * 128 + wr * 64 + m * 16 + fr; const float rs = S[rl];
                        const f32x4 y = acc[ai][bj][m][n] * rs * mul + sh;
                        u32x2 w; w.x = pk2(y[0], y[1]); w.y = pk2(y[2], y[3]); *(u32x2*)(hn + (size_t)(u.pm * 256 + rl) * D + col) = w; } }
    }
};
struct EpiDn1Norm {
    static constexpr bool AFTER_DRAIN = true;
    const float* res_f; bf16_t* x1b; bf16_t* xnxs; bf16_t* xnp; const float* mod; const float* gm; RowX X;
    __device__ __forceinline__ void fused(f32x4 (&acc)[2][2][4][2], const Unit& u, int wr, int wc, int fr, int fq, LAS unsigned char* lds, int wid, int lane) const {
        const float* mb = mod + (size_t)((u.pm * 256) >> 12) * NMOD;
        f32x4 gt[2][2];
#pragma unroll
        for (int bj = 0; bj < 2; ++bj)
#pragma unroll
            for (int n = 0; n < 2; ++n) gt[bj][n] = 0.5f * *(const f32x4*)(mb + 2 * D + u.pn * 256 + bj * 128 + wc * 32 + n * 16 + 4 * fq);
#pragma unroll
        for (int ai = 0; ai < 2; ++ai)
#pragma unroll
            for (int mh = 0; mh < 2; ++mh) { f32x4 rv[2][2][2];
#pragma unroll
                for (int mm = 0; mm < 2; ++mm)
#pragma unroll
                    for (int bj = 0; bj < 2; ++bj)
#pragma unroll
                        for (int n = 0; n < 2; ++n) { const int m = 2 * mh + mm, row = u.pm * 256 + ai * 128 + wr * 64 + m * 16 + fr, col = u.pn * 256 + bj * 128 + wc * 32 + n * 16 + 4 * fq; rv[mm][bj][n] = *(const f32x4*)(res_f + (size_t)row * D + col); }
#pragma unroll
                for (int mm = 0; mm < 2; ++mm)
#pragma unroll
                    for (int bj = 0; bj < 2; ++bj)
#pragma unroll
                        for (int n = 0; n < 2; ++n) { const int m = 2 * mh + mm, row = u.pm * 256 + ai * 128 + wr * 64 + m * 16 + fr, col = u.pn * 256 + bj * 128 + wc * 32 + n * 16 + 4 * fq;
                            const f32x4 o = rv[mm][bj][n] + gt[bj][n] * acc[ai][bj][m][n]; acc[ai][bj][m][n] = o;
                            u32x2 w; w.x = pk2(o[0], o[1]); w.y = pk2(o[2], o[3]); *(u32x2*)(x1b + (size_t)row * D + col) = w; }
            }
        row_rstd_exchange(acc, u, wr, wc, fr, fq, lds, wid, lane, X);
        const LAS float* S = (const LAS float*)(lds + 4096);
#pragma unroll
        for (int bj = 0; bj < 2; ++bj)
#pragma unroll
            for (int n = 0; n < 2; ++n) { const int col = u.pn * 256 + bj * 128 + wc * 32 + n * 16 + 4 * fq;
                const f32x4 mul = *(const f32x4*)(gm + col) * (1.0f + *(const f32x4*)(mb + 4 * D + col)), sh = *(const f32x4*)(mb + 3 * D + col);
#pragma unroll
                for (int ai = 0; ai < 2; ++ai)
#pragma unroll
                    for (int m = 0; m < 4; ++m) { const int rl = ai * 128 + wr * 64 + m * 16 + fr; const float rs = S[rl]; const size_t row = (size_t)(u.pm * 256 + rl);
                        const f32x4 y = acc[ai][bj][m][n] * rs * mul + sh;
                        u32x2 w; w.x = pk2(y[0], y[1]); w.y = pk2(y[2], y[3]); *(u32x2*)(xnp + row * D + col) = w; } }
        __syncthreads();
    }
};
struct EpiFinalNorm {
    static constexpr bool AFTER_DRAIN = true;
    const bf16_t* res_b; float* out; const float* mod; const float* gfin; RowX X;
    __device__ __forceinline__ void fused(f32x4 (&acc)[2][2][4][2], const Unit& u, int wr, int wc, int fr, int fq, LAS unsigned char* lds, int wid, int lane) const {
        const float* mb = mod + (size_t)((u.pm * 256) >> 12) * NMOD;
#pragma unroll
        for (int ai = 0; ai < 2; ++ai) { u32x2 tv[4][2][2];
#pragma unroll
            for (int m = 0; m < 4; ++m)
#pragma unroll
                for (int bj = 0; bj < 2; ++bj)
#pragma unroll
                    for (int n = 0; n < 2; ++n) { const int row = u.pm * 256 + ai * 128 + wr * 64 + m * 16 + fr, col = u.pn * 256 + bj * 128 + wc * 32 + n * 16 + 4 * fq; tv[m][bj][n] = *(const u32x2*)(res_b + (size_t)row * D + col); }
#pragma unroll
            for (int m = 0; m < 4; ++m)
#pragma unroll
                for (int bj = 0; bj < 2; ++bj)
#pragma unroll
                    for (int n = 0; n < 2; ++n) { const int col = u.pn * 256 + bj * 128 + wc * 32 + n * 16 + 4 * fq; const u32x2 t = tv[m][bj][n];
                        const f32x4 gt = 0.5f * *(const f32x4*)(mb + 8 * D + col);
                        acc[ai][bj][m][n] = (f32x4){bflo(t.x), bfhi(t.x), bflo(t.y), bfhi(t.y)} + gt * acc[ai][bj][m][n]; }
        }
        row_rstd_exchange(acc, u, wr, wc, fr, fq, lds, wid, lane, X);
        const LAS float* S = (const LAS float*)(lds + 4096);
#pragma unroll
        for (int bj = 0; bj < 2; ++bj)
#pragma unroll
            for (int n = 0; n < 2; ++n) { const int col = u.pn * 256 + bj * 128 + wc * 32 + n * 16 + 4 * fq;
                const f32x4 gg = *(const f32x4*)(gfin + col);
#pragma unroll
                for (int ai = 0; ai < 2; ++ai)
#pragma unroll
                    for (int m = 0; m < 4; ++m) { const int rl = ai * 128 + wr * 64 + m * 16 + fr; const float rs = S[rl];
                        *(f32x4*)(out + (size_t)(u.pm * 256 + rl) * D + col) = acc[ai][bj][m][n] * rs * gg; } }
    }
};

enum { CV_PLAIN = 0, CV_UPI = 1, CV_RW = 2, CV_LRU = 3 };
__device__ __forceinline__ void cvt_store(const LAS float* scr, int tid, int k0, int n0, bf16_t* dst, int ldd, int mode, int p0, const float* sc) {
    const int nl = tid >> 3, kc = (tid & 7) * 8, n = n0 + nl;
    float s[8];
#pragma unroll
    for (int j = 0; j < 8; ++j) s[j] = scr[(kc + j) * 65 + nl];
    int row = n;
    if (mode == CV_UPI) row = 32 * (n >> 4) + 16 * p0 + (n & 15);
    else if (mode == CV_LRU) { const int dd = p0 >> 3, nb = (p0 >> 1) & 3, which = p0 & 1, c = 256 * nb + n; row = dd * 2048 + (c >> 7) * 256 + ((c & 127) >> 4) * 32 + which * 16 + (c & 15); }
    bf16_t* dp = dst + (size_t)row * ldd + k0 + kc;
    if (mode == CV_RW) { const float mu = sc[n], om = 1.0f - mu;
        u32x4 o; o.x = pk2(s[0] * om, s[1] * om); o.y = pk2(s[2] * om, s[3] * om); o.z = pk2(s[4] * om, s[5] * om); o.w = pk2(s[6] * om, s[7] * om);
        *(u32x4*)dp = o;
        o.x = pk2(s[0] * mu, s[1] * mu); o.y = pk2(s[2] * mu, s[3] * mu); o.z = pk2(s[4] * mu, s[5] * mu); o.w = pk2(s[6] * mu, s[7] * mu);
        *(u32x4*)(dp + 1024) = o;
    } else { u32x4 o; o.x = pk2(s[0], s[1]); o.y = pk2(s[2], s[3]); o.z = pk2(s[4], s[5]); o.w = pk2(s[6], s[7]); *(u32x4*)dp = o; }
}
__device__ __forceinline__ void cvt_run2(const float* src, int lds_, int K, int N, bf16_t* dst, int ldd, int mode, int p0, const float* sc, LAS float* scr, int bid, int nb) {
    const int tid = tidx(), ntn = N >> 6, nt = (K >> 6) * ntn;
    for (int t = bid; t < nt; t += 2 * nb) {
        const int t2 = t + nb; const bool has2 = t2 < nt;
        const int k0 = (t / ntn) << 6, n0 = (t % ntn) << 6, k1 = has2 ? (t2 / ntn) << 6 : k0, n1 = has2 ? (t2 % ntn) << 6 : n0;
        float va[8], vb[8];
#pragma unroll
        for (int j = 0; j < 8; ++j) { const int kk = (tid >> 6) + 8 * j, nn = tid & 63; va[j] = src[(size_t)(k0 + kk) * lds_ + n0 + nn]; vb[j] = src[(size_t)(k1 + kk) * lds_ + n1 + nn]; }
#pragma unroll
        for (int j = 0; j < 8; ++j) { const int kk = (tid >> 6) + 8 * j, nn = tid & 63; scr[kk * 65 + nn] = va[j]; scr[4160 + kk * 65 + nn] = vb[j]; }
        __syncthreads();
        cvt_store(scr, tid, k0, n0, dst, ldd, mode, p0, sc);
        if (has2) cvt_store(scr + 4160, tid, k1, n1, dst, ldd, mode, p0, sc);
        __syncthreads();
    }
}
__device__ __forceinline__ void cvt_run(const float* src, int lds_, int K, int N, bf16_t* dst, int ldd, int mode, int p0, const float* sc, LAS float* scr) {
    cvt_run2(src, lds_, K, N, dst, ldd, mode, p0, sc, scr, blockIdx.x, gridDim.x);
}
__device__ __forceinline__ void zero_fill(unsigned char* p, size_t row_bytes, size_t pitch, int rows) {
    const size_t per = row_bytes / 16, tot = per * rows;
    const int ztid = tidx();
    for (size_t i = (size_t)blockIdx.x * NTHREADS + ztid; i < tot; i += (size_t)gridDim.x * NTHREADS) {
        const size_t r = i / per, c = i % per; *(u32x4*)(p + r * pitch + c * 16) = (u32x4){0u, 0u, 0u, 0u}; }
}

__device__ __forceinline__ void mod_phase(const Params& p, float* mod, LAS float* red) {
    const int tid = tidx(), kq = tid >> 4, cq = tid & 15;
    const float* c = p.in[1]; const float* cc = p.in[3]; const float* wm = p.in[4]; const float* bm = p.in[5];
    for (int it = blockIdx.x; it < NMOD / 64; it += gridDim.x) {
        const int j0 = it * 64 + 4 * cq;
        f32x4 acc[5];
#pragma unroll
        for (int b = 0; b < 5; ++b) acc[b] = (f32x4){0.f, 0.f, 0.f, 0.f};
#pragma unroll 4
        for (int i = 0; i < 32; ++i) { const int k = kq + 32 * i;
            const f32x4 w = *(const f32x4*)(wm + (size_t)k * NMOD + j0);
            acc[0] += silu_f(c[k]) * w; acc[1] += silu_f(c[D + k]) * w; acc[2] += silu_f(c[2 * D + k]) * w; acc[3] += silu_f(c[3 * D + k]) * w; acc[4] += silu_f(cc[k]) * w; }
#pragma unroll
        for (int b = 0; b < 5; ++b)
#pragma unroll
            for (int j = 0; j < 4; ++j) red[(kq * 5 + b) * 64 + 4 * cq + j] = acc[b][j];
        __syncthreads();
        if (tid < 320) { const int b = tid >> 6, cl = tid & 63; float s = 0.f;
            for (int q = 0; q < 32; ++q) s += red[(q * 5 + b) * 64 + cl];
            mod[(size_t)b * NMOD + it * 64 + cl] = s + bm[it * 64 + cl]; }
        __syncthreads();
    }
}

template <bool LATB = false> __device__ __forceinline__ void norm_phase(const float* lat, const float* ctx, int nrows, const float* g, const float* mod, int ish, int isc, bf16_t* dst, int ldd, const float* ctx2 = nullptr, const bf16_t* latb = nullptr, bf16_t* dst2 = nullptr, int mstart = 0) {
    const int tid = tidx(), lane = tid & 63, gw = blockIdx.x * 8 + (tid >> 6), ngw = gridDim.x * 8;
    for (int m0 = mstart + gw; m0 < nrows; m0 += 2 * ngw) {
        const int m1 = m0 + ngw; const bool has1 = m1 < nrows; const int mb = has1 ? m1 : m0;
        const float* srca = m0 < MLAT ? lat + (size_t)m0 * D : ctx + (size_t)(m0 - MLAT) * D;
        const float* srcb = mb < MLAT ? lat + (size_t)mb * D : ctx + (size_t)(mb - MLAT) * D;
        f32x4 va[4], vb[4]; float sa = 0.f, sb = 0.f;
#pragma unroll
        for (int j = 0; j < 4; ++j) {
            if (LATB && m0 < MLAT) { const u32x2 t = *(const u32x2*)(latb + (size_t)m0 * D + 4 * lane + 256 * j); va[j] = (f32x4){bflo(t.x), bfhi(t.x), bflo(t.y), bfhi(t.y)}; } else va[j] = *(const f32x4*)(srca + 4 * lane + 256 * j);
            if (LATB && mb < MLAT) { const u32x2 t = *(const u32x2*)(latb + (size_t)mb * D + 4 * lane + 256 * j); vb[j] = (f32x4){bflo(t.x), bfhi(t.x), bflo(t.y), bfhi(t.y)}; } else vb[j] = *(const f32x4*)(srcb + 4 * lane + 256 * j); }
        if (ctx2) {
            if (m0 >= MLAT) { _Pragma("unroll") for (int j = 0; j < 4; ++j) va[j] += *(const f32x4*)(ctx2 + (size_t)(m0 - MLAT) * D + 4 * lane + 256 * j); }
            if (mb >= MLAT) { _Pragma("unroll") for (int j = 0; j < 4; ++j) vb[j] += *(const f32x4*)(ctx2 + (size_t)(mb - MLAT) * D + 4 * lane + 256 * j); } }
#pragma unroll
        for (int j = 0; j < 4; ++j) { sa += va[j][0] * va[j][0] + va[j][1] * va[j][1] + va[j][2] * va[j][2] + va[j][3] * va[j][3]; sb += vb[j][0] * vb[j][0] + vb[j][1] * vb[j][1] + vb[j][2] * vb[j][2] + vb[j][3] * vb[j][3]; }
#pragma unroll
        for (int o = 1; o < 64; o <<= 1) { sa += __shfl_xor(sa, o); sb += __shfl_xor(sb, o); }
        const float ra = rsqrtf(sa * (1.0f / D) + 1e-6f), rb = rsqrtf(sb * (1.0f / D) + 1e-6f);
        const int ba = m0 < MLAT ? (m0 >> 12) : 4, bb = mb < MLAT ? (mb >> 12) : 4;
        const float* sha = mod + (size_t)ba * NMOD + ish * D; const float* sca = mod + (size_t)ba * NMOD + isc * D;
        const float* shb = mod + (size_t)bb * NMOD + ish * D; const float* scb = mod + (size_t)bb * NMOD + isc * D;
#pragma unroll
        for (int j = 0; j < 4; ++j) { const int c = 4 * lane + 256 * j;
            const f32x4 gg = *(const f32x4*)(g + c);
            { const f32x4 s1 = *(const f32x4*)(sha + c), s2 = *(const f32x4*)(sca + c); const f32x4 y = va[j] * ra * gg * (1.0f + s2) + s1;
              u32x2 o; o.x = pk2(y[0], y[1]); o.y = pk2(y[2], y[3]); *(u32x2*)(dst + (size_t)m0 * ldd + c) = o; if (dst2 && m0 < MLAT) *(u32x2*)(dst2 + (size_t)m0 * D + c) = o; }
            if (has1) { const f32x4 s1 = *(const f32x4*)(shb + c), s2 = *(const f32x4*)(scb + c); const f32x4 y = vb[j] * rb * gg * (1.0f + s2) + s1;
              u32x2 o; o.x = pk2(y[0], y[1]); o.y = pk2(y[2], y[3]); *(u32x2*)(dst + (size_t)m1 * ldd + c) = o; if (dst2 && m1 < MLAT) *(u32x2*)(dst2 + (size_t)m1 * D + c) = o; } }
    }
}
__device__ __forceinline__ void final_norm_phase(float* x, const float* g) {
    const int tid = tidx(), lane = tid & 63, gw = blockIdx.x * 8 + (tid >> 6), ngw = gridDim.x * 8;
    for (int m0 = gw; m0 < MLAT; m0 += 2 * ngw) {
        const int m1 = m0 + ngw; const bool has1 = m1 < MLAT;
        float* sa_ = x + (size_t)m0 * D; float* sb_ = x + (size_t)(has1 ? m1 : m0) * D;
        f32x4 va[4], vb[4]; float sa = 0.f, sb = 0.f;
#pragma unroll
        for (int j = 0; j < 4; ++j) { va[j] = *(const f32x4*)(sa_ + 4 * lane + 256 * j); vb[j] = *(const f32x4*)(sb_ + 4 * lane + 256 * j); }
#pragma unroll
        for (int j = 0; j < 4; ++j) { sa += va[j][0] * va[j][0] + va[j][1] * va[j][1] + va[j][2] * va[j][2] + va[j][3] * va[j][3]; sb += vb[j][0] * vb[j][0] + vb[j][1] * vb[j][1] + vb[j][2] * vb[j][2] + vb[j][3] * vb[j][3]; }
#pragma unroll
        for (int o = 1; o < 64; o <<= 1) { sa += __shfl_xor(sa, o); sb += __shfl_xor(sb, o); }
        const float ra = rsqrtf(sa * (1.0f / D) + 1e-6f), rb = rsqrtf(sb * (1.0f / D) + 1e-6f);
#pragma unroll
        for (int j = 0; j < 4; ++j) { const int c = 4 * lane + 256 * j; const f32x4 gg = *(const f32x4*)(g + c);
            *(f32x4*)(sa_ + c) = va[j] * ra * gg; if (has1) *(f32x4*)(sb_ + c) = vb[j] * rb * gg; }
    }
}
__device__ __forceinline__ void add4(f32x4& a, const bf16_t* p) { const u32x2 t = *(const u32x2*)p; a[0] += bflo(t.x); a[1] += bfhi(t.x); a[2] += bflo(t.y); a[3] += bfhi(t.y); }
__device__ __forceinline__ void xs_phase(bf16_t* xnxs, const bf16_t* xnp, int nrows) {
    const int tid = tidx(), lane = tid & 63, gw = blockIdx.x * 8 + (tid >> 6), ngw = gridDim.x * 8;
    for (int m = gw; m < nrows; m += ngw) {
        int n0, n1, n2, n3; bool v0, v1, v2, v3; float wgt;
        if (m < MLAT) { const int t = m & 4095, gr = t >> 6, gc = t & 63; wgt = 0.25f; v0 = gr > 0; v1 = gr < 63; v2 = gc > 0; v3 = gc < 63; n0 = m - 64; n1 = m + 64; n2 = m - 1; n3 = m + 1; }
        else { const int j = (m - MLAT) & 255; wgt = 0.5f; v0 = false; v1 = false; v2 = j > 0; v3 = j < 255; n0 = m; n1 = m; n2 = m - 1; n3 = m + 1; }
        if (!v0) n0 = m; if (!v1) n1 = m; if (!v2) n2 = m; if (!v3) n3 = m;
        const float w0 = v0 ? wgt : 0.f, w1 = v1 ? wgt : 0.f, w2 = v2 ? wgt : 0.f, w3 = v3 ? wgt : 0.f;
        const bool plain = xnp != nullptr && m < MLAT;
        const bf16_t* sb = plain ? xnp : xnxs; const size_t ld = plain ? (size_t)D : (size_t)2048;
        u32x2 q0[4], q1[4], q2[4], q3[4], qs[4];
#pragma unroll
        for (int j = 0; j < 4; ++j) { const int c = 4 * lane + 256 * j;
            q0[j] = *(const u32x2*)(sb + (size_t)n0 * ld + c); q1[j] = *(const u32x2*)(sb + (size_t)n1 * ld + c);
            q2[j] = *(const u32x2*)(sb + (size_t)n2 * ld + c); q3[j] = *(const u32x2*)(sb + (size_t)n3 * ld + c); qs[j] = *(const u32x2*)(sb + (size_t)m * ld + c); }
#pragma unroll
        for (int j = 0; j < 4; ++j) { const int c = 4 * lane + 256 * j;
            const float a0 = w0 * bflo(q0[j].x) + w1 * bflo(q1[j].x) + w2 * bflo(q2[j].x) + w3 * bflo(q3[j].x);
            const float a1 = w0 * bfhi(q0[j].x) + w1 * bfhi(q1[j].x) + w2 * bfhi(q2[j].x) + w3 * bfhi(q3[j].x);
            const float a2 = w0 * bflo(q0[j].y) + w1 * bflo(q1[j].y) + w2 * bflo(q2[j].y) + w3 * bflo(q3[j].y);
            const float a3 = w0 * bfhi(q0[j].y) + w1 * bfhi(q1[j].y) + w2 * bfhi(q2[j].y) + w3 * bfhi(q3[j].y);
            u32x2 o; o.x = pk2(a0, a1); o.y = pk2(a2, a3);
            *(u32x2*)(xnxs + (size_t)m * 2048 + 1024 + c) = o;
            if (plain) *(u32x2*)(xnxs + (size_t)m * 2048 + c) = qs[j]; }
    }
}
__device__ __forceinline__ void xs_ctx_phase(const float* c1, const float* c2, const float* g, const float* mod, bf16_t* xnxs) {
    const int tid = tidx(), lane = tid & 63, gw = (int)gridDim.x * 8 - 1 - ((int)blockIdx.x * 8 + (tid >> 6)), ngw = gridDim.x * 8;
    const float* sh = mod + (size_t)4 * NMOD + 3 * D; const float* sc = mod + (size_t)4 * NMOD + 4 * D;
    for (int r = gw; r < MCTX; r += ngw) {
        const int j = r & 255; const bool vp = j > 0, vn = j < 255;
        const int rr[3] = {vp ? r - 1 : r, r, vn ? r + 1 : r};
        f32x4 x[3][4];
#pragma unroll
        for (int q = 0; q < 3; ++q)
#pragma unroll
            for (int i = 0; i < 4; ++i) { const size_t off = (size_t)rr[q] * D + 4 * lane + 256 * i; x[q][i] = *(const f32x4*)(c1 + off) + *(const f32x4*)(c2 + off); }
        float ss[3];
#pragma unroll
        for (int q = 0; q < 3; ++q) { float t = 0.f;
#pragma unroll
            for (int i = 0; i < 4; ++i) t += (x[q][i][0] * x[q][i][0] + x[q][i][1] * x[q][i][1]) + (x[q][i][2] * x[q][i][2] + x[q][i][3] * x[q][i][3]);
            ss[q] = t; }
#pragma unroll
        for (int o = 1; o < 64; o <<= 1) { ss[0] += __shfl_xor(ss[0], o); ss[1] += __shfl_xor(ss[1], o); ss[2] += __shfl_xor(ss[2], o); }
        const float r0 = rsqrtf(ss[0] * (1.0f / D) + 1e-6f) * (vp ? 0.5f : 0.f), r1 = rsqrtf(ss[1] * (1.0f / D) + 1e-6f), r2 = rsqrtf(ss[2] * (1.0f / D) + 1e-6f) * (vn ? 0.5f : 0.f);
        const float wsh = (vp ? 0.5f : 0.f) + (vn ? 0.5f : 0.f);
#pragma unroll
        for (int i = 0; i < 4; ++i) { const int c = 4 * lane + 256 * i;
            const f32x4 mul = *(const f32x4*)(g + c) * (1.0f + *(const f32x4*)(sc + c)), s0 = *(const f32x4*)(sh + c);
            const f32x4 xn = x[1][i] * r1 * mul + s0;
            const f32x4 xs = (x[0][i] * r0 + x[2][i] * r2) * mul + wsh * s0;
            u32x2 o; o.x = pk2(xn[0], xn[1]); o.y = pk2(xn[2], xn[3]); *(u32x2*)(xnxs + (size_t)(MLAT + r) * 2048 + c) = o;
            o.x = pk2(xs[0], xs[1]); o.y = pk2(xs[2], xs[3]); *(u32x2*)(xnxs + (size_t)(MLAT + r) * 2048 + 1024 + c) = o; }
    }
}
__device__ __forceinline__ void conv_phase(const bf16_t* plx, const bf16_t* plxc, bf16_t* xc, const float* cw, const float* cb) {
    const int tid = tidx(), lane = tid & 63, gw = blockIdx.x * 8 + (tid >> 6), ngw = gridDim.x * 8;
    for (int m = gw; m < MALL; m += ngw) {
        int t, len; if (m < MLAT) { t = m & 4095; len = 4096; } else { t = (m - MLAT) & 255; len = 256; }
        const bf16_t* pb = m < MLAT ? plx : plxc - (size_t)MLAT * D;
        int rq[4]; float wq[4];
#pragma unroll
        for (int q = 0; q < 4; ++q) { const int tt = t + q - 1; const bool ok = tt >= 0 && tt < len; rq[q] = ok ? m + q - 1 : m; wq[q] = ok ? 1.f : 0.f; }
        u32x2 x[4][4];
#pragma unroll
        for (int q = 0; q < 4; ++q)
#pragma unroll
            for (int j = 0; j < 4; ++j) x[q][j] = *(const u32x2*)(pb + (size_t)rq[q] * D + 4 * lane + 256 * j);
#pragma unroll
        for (int j = 0; j < 4; ++j) { const int c = 4 * lane + 256 * j; f32x4 a = *(const f32x4*)(cb + c);
#pragma unroll
            for (int q = 0; q < 4; ++q) { const f32x4 w = *(const f32x4*)(cw + q * D + c) * wq[q];
                a[0] += w[0] * bflo(x[q][j].x); a[1] += w[1] * bfhi(x[q][j].x); a[2] += w[2] * bflo(x[q][j].y); a[3] += w[3] * bfhi(x[q][j].y); }
            u32x2 o; o.x = pk2(a[0], a[1]); o.y = pk2(a[2], a[3]);
            *(u32x2*)(xc + (size_t)m * D + c) = o; }
    }
}
__device__ __forceinline__ void rncb_phase(const bf16_t* R, const bf16_t* Kk, const float* k_k, const float* r_k, float* rn, float* cbv) {
    const int tid = tidx(), g16 = (blockIdx.x * NTHREADS + tid) >> 4, ng = (gridDim.x * NTHREADS) >> 4, l = tid & 15;
    for (int it0 = g16; it0 < MALL * 16; it0 += 4 * ng) {
        u32x2 kv[4], rv[4];
#pragma unroll
        for (int u = 0; u < 4; ++u) { const int it = it0 + u * ng; kv[u] = (u32x2){0u, 0u}; rv[u] = (u32x2){0u, 0u};
            if (it < MALL * 16) { const size_t off = (size_t)(it >> 4) * D + (it & 15) * 64 + 4 * l; kv[u] = *(const u32x2*)(Kk + off); rv[u] = *(const u32x2*)(R + off); } }
#pragma unroll
        for (int u = 0; u < 4; ++u) { const int it = it0 + u * ng;
            if (it < MALL * 16) { const int c = (it & 15) * 64 + 4 * l;
                const f32x4 kk = *(const f32x4*)(k_k + c), rk = *(const f32x4*)(r_k + c);
                const float k0 = bflo(kv[u].x), k1 = bfhi(kv[u].x), k2 = bflo(kv[u].y), k3 = bfhi(kv[u].y);
                float s1 = k0 * kk[0] * k0 * kk[0] + k1 * kk[1] * k1 * kk[1] + k2 * kk[2] * k2 * kk[2] + k3 * kk[3] * k3 * kk[3];
                float s2 = bflo(rv[u].x) * k0 * rk[0] + bfhi(rv[u].x) * k1 * rk[1] + bflo(rv[u].y) * k2 * rk[2] + bfhi(rv[u].y) * k3 * rk[3];
                s1 = red16(s1); s2 = red16(s2);
                if (l == 0) { rn[it] = __builtin_amdgcn_rsqf(fmaxf(s1, 1e-24f)); cbv[it] = s2; } } }
    }
}
__device__ __forceinline__ void post_phase(bf16_t* YF, const bf16_t* YB, const bf16_t* V, const float* cbv, const float* lnw, const float* lnb) {
    const int tid = tidx(), g16 = (blockIdx.x * NTHREADS + tid) >> 4, ng = (gridDim.x * NTHREADS) >> 4, l = tid & 15;
    for (int it0 = g16; it0 < MLAT * 16; it0 += 4 * ng) {
        u32x2 av[4], bv[4], vv[4]; float cbs[4];
#pragma unroll
        for (int u = 0; u < 4; ++u) { const int it = it0 + u * ng; av[u] = (u32x2){0u, 0u}; bv[u] = av[u]; vv[u] = av[u]; cbs[u] = 0.f;
            if (it < MLAT * 16) { const size_t off = (size_t)(it >> 4) * D + (it & 15) * 64 + 4 * l; av[u] = *(const u32x2*)(YF + off); bv[u] = *(const u32x2*)(YB + off); vv[u] = *(const u32x2*)(V + off); cbs[u] = cbv[it]; } }
#pragma unroll
        for (int u = 0; u < 4; ++u) { const int it = it0 + u * ng;
            if (it < MLAT * 16) { const int c = (it & 15) * 64 + 4 * l; const size_t off = (size_t)(it >> 4) * D + c;
                float y[4] = {bflo(av[u].x) + bflo(bv[u].x), bfhi(av[u].x) + bfhi(bv[u].x), bflo(av[u].y) + bflo(bv[u].y), bfhi(av[u].y) + bfhi(bv[u].y)};
                const float mu = red16(y[0] + y[1] + y[2] + y[3]) * (1.0f / 64.0f);
                float q = 0.f;
#pragma unroll
                for (int j = 0; j < 4; ++j) { y[j] -= mu; q += y[j] * y[j]; }
                const float rs = rsqrtf(red16(q) * (1.0f / 64.0f) + 64e-5f);
                const f32x4 w = *(const f32x4*)(lnw + c), bb = *(const f32x4*)(lnb + c);
                const float v4[4] = {bflo(vv[u].x), bfhi(vv[u].x), bflo(vv[u].y), bfhi(vv[u].y)};
                float o[4];
#pragma unroll
                for (int j = 0; j < 4; ++j) o[j] = y[j] * rs * w[j] + bb[j] + cbs[u] * v4[j];
                u32x2 ov; ov.x = pk2(o[0], o[1]); ov.y = pk2(o[2], o[3]);
                *(u32x2*)(YF + off) = ov; } }
    }
}

constexpr int RS_STRIDE = 324;
constexpr int RS_BUF = 32 * RS_STRIDE + 1024 + 4096;
__device__ __forceinline__ int scan_row(int b, int dir, int s) {
    if (s < 256) return MLAT + b * 256 + (dir ? 255 - s : s);
    return b * 4096 + (dir ? 4095 - (s - 256) : (s - 256));
}
struct ScanIn { bf16x8 afr[2][2]; unsigned short xv[8]; float rnv[8]; unsigned vpair; };
__device__ __forceinline__ void rwkv_scan_phase(const Params& p, LAS float* lds) {
    unsigned char* ws = p.ws;
    const bf16_t* R = (const bf16_t*)(ws + O_R); const bf16_t* Kk = (const bf16_t*)(ws + O_K); const bf16_t* V = (const bf16_t*)(ws + O_V);
    const bf16_t* LIN = (const bf16_t*)(ws + O_LIN); const float* rn = (const float*)(ws + O_RN);
    const int tid = tidx(), lane = tid & 63, w = __builtin_amdgcn_readfirstlane(tid >> 6), fr = lane & 15, fq = lane >> 4;
    const int cgp = lane & 15, rw = lane >> 4;
    for (int unit = blockIdx.x; unit < 256; unit += gridDim.x) {
        const int xcd = unit & 7, slot = unit >> 3, half = slot & 1, chain = (slot >> 1) * 8 + xcd, dir = chain & 1, h = (chain >> 1) & 15, b = chain >> 5;
        bf16_t* Y = (bf16_t*)(ws + (dir ? O_YB : O_YF));
        const int lora = w >> 2, ct = w & 3, col = h * 64 + 16 * ct + fr;
        bf16x8 bfr[2];
        { const bf16_t* wt = (const bf16_t*)(ws + (lora ? O_LSCA : O_LSCW)) + (size_t)(dir * 1024 + col) * 64 + 8 * fq;
          bfr[0] = *(const bf16x8*)(wt); bfr[1] = *(const bf16x8*)(wt + 32); }
        const float c_bias = lora ? p.in[15][dir * D + col] : p.in[13][dir * D + col];
        const float c_kk = p.in[18][col], c_ka = p.in[19][col];
        const int lcol0 = (lora ? 128 : 0) + dir * 64;
        const int sgn = dir ? -1 : 1;
        f32x2 SA = (f32x2){0.f, 0.f}, SB = (f32x2){0.f, 0.f};
        ScanIn in;
#define SCAN_LOAD(c) do { const int m0 = scan_row(b, dir, 32 * (c)); \
            _Pragma("unroll") for (int tt = 0; tt < 2; ++tt) { const size_t mr = (size_t)(m0 + sgn * (16 * tt + fr)); \
                _Pragma("unroll") for (int ks = 0; ks < 2; ++ks) in.afr[tt][ks] = *(const bf16x8*)(LIN + mr * 256 + lcol0 + 32 * ks + 8 * fq); } \
            _Pragma("unroll") for (int tt = 0; tt < 2; ++tt) _Pragma("unroll") for (int j = 0; j < 4; ++j) { const size_t mr = (size_t)(m0 + sgn * (16 * tt + 4 * fq + j)); \
                in.xv[tt * 4 + j] = (lora ? Kk : R)[mr * D + col]; in.rnv[tt * 4 + j] = rn[mr * 16 + h]; } \
            { const size_t mr = (size_t)(m0 + sgn * (tid >> 4)); in.vpair = *(const unsigned*)(V + mr * D + h * 64 + half * 32 + 2 * (tid & 15)); } } while (0)
#define SCAN_PRODUCE(bufi) do { LAS float* sb = lds + (bufi) * RS_BUF; \
            _Pragma("unroll") for (int tt = 0; tt < 2; ++tt) { f32x4 acc = (f32x4){0.f, 0.f, 0.f, 0.f}; \
                acc = __builtin_amdgcn_mfma_f32_16x16x32_bf16(in.afr[tt][0], bfr[0], acc, 0, 0, 0); acc = __builtin_amdgcn_mfma_f32_16x16x32_bf16(in.afr[tt][1], bfr[1], acc, 0, 0, 0); \
                _Pragma("unroll") for (int j = 0; j < 4; ++j) { LAS float* rec = sb + (16 * tt + 4 * fq + j) * RS_STRIDE + 16 * ct + fr; const float x = bf2f(in.xv[tt * 4 + j]); \
                    if (lora == 0) { rec[0] = __expf(-0.60653066f * sigm(c_bias + acc[j])); rec[256] = x; } \
                    else { const float a = sigm(c_bias + acc[j]), kkv = x * c_kk * in.rnv[tt * 4 + j]; rec[64] = x * (1.0f + (a - 1.0f) * c_ka); rec[128] = -kkv; rec[192] = kkv * a; } } } \
            { LAS float* vb = sb + 32 * RS_STRIDE + (tid >> 4) * 32 + 2 * (tid & 15); vb[0] = bflo(in.vpair); vb[1] = bfhi(in.vpair); } } while (0)
#define SCAN_YOUT(c, bufi) do { if ((c) >= 8) { const LAS float* yb_ = lds + (bufi) * RS_BUF + 32 * RS_STRIDE + 1024 + ((tid >> 4) * 32 + 2 * (tid & 15)) * 4; \
            const f32x4 ya = *(const LAS f32x4*)(yb_), yc = *(const LAS f32x4*)(yb_ + 4); \
            const size_t mr = (size_t)(scan_row(b, dir, 32 * (c)) + sgn * (tid >> 4)); \
            *(unsigned*)(Y + mr * D + h * 64 + half * 32 + 2 * (tid & 15)) = pk2((ya[0] + ya[1]) + (ya[2] + ya[3]), (yc[0] + yc[1]) + (yc[2] + yc[3])); } } while (0)
        SCAN_LOAD(0);
        SCAN_PRODUCE(0);
        __syncthreads();
        for (int c = 0; c < 136; ++c) {
            const int cur = c & 1;
            if (c + 1 < 136) SCAN_LOAD(c + 1);
            if (c > 0 && w >= 4) SCAN_YOUT(c - 1, cur ^ 1);
            const LAS float* sp0 = lds + cur * RS_BUF + 4 * cgp;
            const LAS float* vb = lds + cur * RS_BUF + 32 * RS_STRIDE + w * 4 + rw;
            LAS float* yb = lds + cur * RS_BUF + 32 * RS_STRIDE + 1024 + (w * 4 + rw) * 4 + (cgp >> 2);
            f32x4 w4 = *(const LAS f32x4*)(sp0), kd4 = *(const LAS f32x4*)(sp0 + 64), ka4 = *(const LAS f32x4*)(sp0 + 192), r4 = *(const LAS f32x4*)(sp0 + 256);
            f32x4 nk1 = *(const LAS f32x4*)(sp0 + RS_STRIDE + 128);
            float vv = vb[0];
            float sa;
            { const f32x4 nk0 = *(const LAS f32x4*)(sp0 + 128); const f32x2 q = SA * (f32x2){nk0[0], nk0[1]} + SB * (f32x2){nk0[2], nk0[3]}; sa = red16(q[0] + q[1]); }
#define SCAN_STEPS(i0, cnt, YON) _Pragma("unroll") for (int ii = 0; ii < (cnt); ++ii) { const int i = (i0) + ii; \
                f32x4 w4n = w4, kd4n = kd4, ka4n = ka4, r4n = r4, nk2 = nk1; float vvn = vv; \
                if (i + 1 < 32) { const LAS float* spn = sp0 + (i + 1) * RS_STRIDE; \
                    w4n = *(const LAS f32x4*)(spn); kd4n = *(const LAS f32x4*)(spn + 64); ka4n = *(const LAS f32x4*)(spn + 192); r4n = *(const LAS f32x4*)(spn + 256); vvn = vb[(i + 1) * 32]; } \
                if (i + 2 < 32) nk2 = *(const LAS f32x4*)(sp0 + (i + 2) * RS_STRIDE + 128); \
                { const f32x2 ta = sa * (f32x2){ka4[0], ka4[1]} + vv * (f32x2){kd4[0], kd4[1]}, tb = sa * (f32x2){ka4[2], ka4[3]} + vv * (f32x2){kd4[2], kd4[3]}; \
                  SA = SA * (f32x2){w4[0], w4[1]} + ta; SB = SB * (f32x2){w4[2], w4[3]} + tb; } \
                float sn = 0.f; \
                if (i + 1 < 32) { const f32x2 ps = SA * (f32x2){nk1[0], nk1[1]} + SB * (f32x2){nk1[2], nk1[3]}; sn = ps[0] + ps[1]; } \
                if (YON) { const f32x2 py = SA * (f32x2){r4[0], r4[1]} + SB * (f32x2){r4[2], r4[3]}; float yp = py[0] + py[1]; \
                    sn += dppf<0xB1>(sn); yp += dppf<0xB1>(yp); sn += dppf<0x4E>(sn); yp += dppf<0x4E>(yp); sn += dppf<0x141>(sn); sn += dppf<0x140>(sn); \
                    if ((cgp & 3) == 0) yb[i * 128] = yp; } \
                else { sn += dppf<0xB1>(sn); sn += dppf<0x4E>(sn); sn += dppf<0x141>(sn); sn += dppf<0x140>(sn); }     \
                sa = sn; w4 = w4n; kd4 = kd4n; ka4 = ka4n; r4 = r4n; vv = vvn; nk1 = nk2; }
            __builtin_amdgcn_s_setprio(2);
#define SCAN_CHUNK(YON) \
            SCAN_STEPS(0, 8, YON) \
            if (c + 1 < 136 && w < 4) { __builtin_amdgcn_s_setprio(0); SCAN_PRODUCE(cur ^ 1); __builtin_amdgcn_s_setprio(2); }     \
            SCAN_STEPS(8, 8, YON) \
            if (c > 0 && w < 4) SCAN_YOUT(c - 1, cur ^ 1); \
            SCAN_STEPS(16, 8, YON) \
            if (c + 1 < 136 && w >= 4) { __builtin_amdgcn_s_setprio(0); SCAN_PRODUCE(cur ^ 1); __builtin_amdgcn_s_setprio(2); } \
            SCAN_STEPS(24, 8, YON)
            if (c < 8) { SCAN_CHUNK(false) } else { SCAN_CHUNK(true) }
#undef SCAN_CHUNK
            __builtin_amdgcn_s_setprio(0);
#undef SCAN_STEPS
            __syncthreads();
        }
        SCAN_YOUT(135, 1);
        __syncthreads();
#undef SCAN_LOAD
#undef SCAN_PRODUCE
#undef SCAN_YOUT
    }
}

__device__ __forceinline__ void lru_p1_phase(const Params& p) {
    unsigned char* ws = p.ws; const float* lam = (const float*)(ws + O_CL);
    float* PQ = (float*)(ws + O_PQ);
    const int tid = tidx(), lane = tid & 63, half = lane >> 5, l32 = lane & 31, gw = blockIdx.x * 8 + (tid >> 6), ngw = gridDim.x * 8;
    for (int it = gw; it < 2 * 4 * 68 * 16; it += ngw) {
        const int cb16 = it & 15, j = (it >> 4) % 68, b = ((it >> 4) / 68) & 3, d = (it >> 4) / 272;
        const int c = cb16 * 64 + 2 * l32;
        const bf16_t* GR = (const bf16_t*)(ws + (d ? O_GRB : O_GRF)); const bf16_t* UU = (const bf16_t*)(ws + (d ? O_UB : O_UF));
        const float cl0 = lam[d * D + c], cl1 = lam[d * D + c + 1];
        float P0 = 1.f, P1 = 1.f, Q0 = 0.f, Q1 = 0.f;
        const int sgn = d ? -1 : 1, m0 = scan_row(b, d, 64 * j) + sgn * 32 * half;
#pragma unroll 8
        for (int i = 0; i < 32; ++i) { const size_t off = (size_t)(m0 + sgn * i) * D + c;
            const unsigned g = *(const unsigned*)(GR + off), uv = *(const unsigned*)(UU + off);
            const float a0 = __expf(bflo(g) * cl0), a1 = __expf(bfhi(g) * cl1);
            P0 *= a0; P1 *= a1; Q0 = a0 * Q0 + bflo(uv); Q1 = a1 * Q1 + bfhi(uv); }
        const float oP0 = __shfl_xor(P0, 32), oP1 = __shfl_xor(P1, 32), oQ0 = __shfl_xor(Q0, 32), oQ1 = __shfl_xor(Q1, 32);
        if (half == 0) { const size_t o = ((size_t)((d * 4 + b) * 68 + j)) * D + c;
            *(f32x2*)(PQ + o) = (f32x2){P0 * oP0, P1 * oP1}; *(f32x2*)(PQ + (size_t)2 * 4 * 68 * D + o) = (f32x2){oP0 * Q0 + oQ0, oP1 * Q1 + oQ1}; }
    }
}
__device__ __forceinline__ void lru_p3_phase(const Params& p) {
    unsigned char* ws = p.ws; const float* lam = (const float*)(ws + O_CL);
    const float* PQ = (const float*)(ws + O_PQ); const float* QQ = PQ + (size_t)2 * 4 * 68 * D;
    bf16_t* HS = (bf16_t*)(ws + O_HSUM);
    const int tid = tidx(), lane = tid & 63, gw = blockIdx.x * 8 + (tid >> 6), ngw = gridDim.x * 8;
    for (int it = gw; it < 4 * 64 * 8; it += ngw) {
        const int cb8 = it & 7, T = (it >> 3) & 63, b = it >> 9, c = cb8 * 128 + 2 * lane;
        {
            const bf16_t* GR = (const bf16_t*)(ws + O_GRF); const bf16_t* UU = (const bf16_t*)(ws + O_UF);
            const float cl0 = lam[c], cl1 = lam[c + 1];
            float h0 = 0.f, h1 = 0.f;
#pragma unroll 8
            for (int jj = 0; jj < 4 + T; ++jj) { const size_t o = ((size_t)(b * 68 + jj)) * D + c; const f32x2 P = *(const f32x2*)(PQ + o), Q = *(const f32x2*)(QQ + o); h0 = P[0] * h0 + Q[0]; h1 = P[1] * h1 + Q[1]; }
            for (int i0 = 0; i0 < 64; i0 += 8) {
                unsigned g[8], uv[8];
#pragma unroll
                for (int i = 0; i < 8; ++i) { const size_t off = (size_t)(b * 4096 + 64 * T + i0 + i) * D + c; g[i] = *(const unsigned*)(GR + off); uv[i] = *(const unsigned*)(UU + off); }
#pragma unroll
                for (int i = 0; i < 8; ++i) { const size_t off = (size_t)(b * 4096 + 64 * T + i0 + i) * D + c;
                    h0 = __expf(bflo(g[i]) * cl0) * h0 + bflo(uv[i]); h1 = __expf(bfhi(g[i]) * cl1) * h1 + bfhi(uv[i]);
                    *(unsigned*)(HS + off) = pk2(h0, h1); }
            }
        }
        {
            const bf16_t* GR = (const bf16_t*)(ws + O_GRB); const bf16_t* UU = (const bf16_t*)(ws + O_UB);
            const float cl0 = lam[D + c], cl1 = lam[D + c + 1];
            float h0 = 0.f, h1 = 0.f;
#pragma unroll 8
            for (int jj = 0; jj < 67 - T; ++jj) { const size_t o = ((size_t)((4 + b) * 68 + jj)) * D + c; const f32x2 P = *(const f32x2*)(PQ + o), Q = *(const f32x2*)(QQ + o); h0 = P[0] * h0 + Q[0]; h1 = P[1] * h1 + Q[1]; }
            for (int i0 = 0; i0 < 64; i0 += 8) {
                unsigned g[8], uv[8], f[8];
#pragma unroll
                for (int i = 0; i < 8; ++i) { const size_t off = (size_t)(b * 4096 + 64 * T + 63 - i0 - i) * D + c; g[i] = *(const unsigned*)(GR + off); uv[i] = *(const unsigned*)(UU + off); f[i] = *(const unsigned*)(HS + off); }
#pragma unroll
                for (int i = 0; i < 8; ++i) { const size_t off = (size_t)(b * 4096 + 64 * T + 63 - i0 - i) * D + c;
                    h0 = __expf(bflo(g[i]) * cl0) * h0 + bflo(uv[i]); h1 = __expf(bfhi(g[i]) * cl1) * h1 + bfhi(uv[i]);
                    *(unsigned*)(HS + off) = pk2(bflo(f[i]) + h0, bfhi(f[i]) + h1); }
            }
        }
    }
}

#define XB_XCNT(j) (64 * (j))
#define XB_XSUB(j) (1024 + 64 * (j))
#define XB_XGEN(j) (2048 + 64 * (j))
#define XB_TOP 3072
#define XB_TOPGEN 3136
#define XB_WORDS 3200
__device__ __forceinline__ unsigned xb_ld(unsigned* p) { return __hip_atomic_load(p, __ATOMIC_RELAXED, __HIP_MEMORY_SCOPE_AGENT); }
__device__ __forceinline__ unsigned xb_add(unsigned* p, unsigned v) { return __hip_atomic_fetch_add(p, v, __ATOMIC_RELAXED, __HIP_MEMORY_SCOPE_AGENT); }
__device__ __forceinline__ void xb_st(unsigned* p, unsigned v) { __hip_atomic_store(p, v, __ATOMIC_RELAXED, __HIP_MEMORY_SCOPE_AGENT); }
struct XBar { unsigned* bar; unsigned x, nloc, nx, k; };
__device__ __forceinline__ void xbar_init(XBar& B, unsigned* bar) {
    B.bar = bar; B.x = (unsigned)__builtin_amdgcn_s_getreg((3 << 11) | 20) & 0xFu; B.nloc = 0u; B.nx = 0u; B.k = 0u;
    if (threadIdx.x == 0) (void)xb_add(&bar[XB_XCNT(B.x)], 1u);
}
__device__ __forceinline__ void gbar(XBar& B) {
    asm volatile("s_waitcnt vmcnt(0)" ::: "memory");
    __syncthreads();
    B.k += 1u;
    if (threadIdx.x == 0) {
        unsigned* bar = B.bar;
        if (B.nloc == 0u) {
            unsigned sum, cnt, mine;
            for (;;) { sum = 0u; cnt = 0u; mine = 0u;
#pragma unroll
                for (unsigned j = 0; j < 16; ++j) { const unsigned c = xb_ld(&bar[XB_XCNT(j)]); sum += c; cnt += (c > 0u) ? 1u : 0u; mine = (j == B.x) ? c : mine; }
                if (sum == gridDim.x) break;
                __builtin_amdgcn_s_sleep(1); }
            B.nloc = mine; B.nx = cnt;
        }
        const unsigned old = xb_add(&bar[XB_XSUB(B.x)], 1u);
        if (old + 1u == B.k * B.nloc) {
            __builtin_amdgcn_fence(__ATOMIC_RELEASE, "agent");
            asm volatile("s_waitcnt vmcnt(0)" ::: "memory");
            const unsigned t = xb_add(&bar[XB_TOP], 1u);
            if (t + 1u == B.k * B.nx) xb_st(&bar[XB_TOPGEN], B.k);
            else while (xb_ld(&bar[XB_TOPGEN]) < B.k) __builtin_amdgcn_s_sleep(1);
            xb_st(&bar[XB_XGEN(B.x)], B.k);
        } else {
            while (xb_ld(&bar[XB_XGEN(B.x)]) < B.k) __builtin_amdgcn_s_sleep(1);
        }
        __builtin_amdgcn_fence(__ATOMIC_ACQUIRE, "agent");
        asm volatile("s_waitcnt vmcnt(0)" ::: "memory");
    }
    __syncthreads();
}

__device__ __forceinline__ Gemm mk_gemm(const void* A, const void* Bt, int M, int N, int K, int lda, int ldb) { Gemm g; g.A = (const bf16_t*)A; g.Bt = (const bf16_t*)Bt; g.M = M; g.N = N; g.K = K; g.lda = lda; g.ldb = ldb; g.ksh = 0; g.kmask = 0; g.kmul = 0; return g; }

__global__ void __launch_bounds__(NTHREADS, 2) mega(Params p) {
    extern __shared__ __attribute__((aligned(16))) unsigned char shm[];
    LAS unsigned char* lds = (LAS unsigned char*)shm;
    LAS float* ldsf = (LAS float*)shm;
    cg::grid_group grid = cg::this_grid();
    unsigned char* ws = p.ws;
    float* mod = (float*)(ws + O_MOD);
    bf16_t* X1B = (bf16_t*)p.out;
    bf16_t* XNP = (bf16_t*)p.out + (size_t)MLAT * D;
    pg8::StaticOrder S;
    XBar XB; xbar_init(XB, (unsigned*)(ws + O_BAR));
#define BF(off) ((bf16_t*)(ws + (off)))
#define GSYNC() gbar(XB)
    if (p.ws == nullptr) grid.sync();
    cvt_run(p.in[7], DFF, D, DFF, BF(O_UP1), D, CV_UPI, 0, nullptr, ldsf);
    cvt_run(p.in[8], DFF, D, DFF, BF(O_UP1), D, CV_UPI, 1, nullptr, ldsf);
    cvt_run(p.in[9], D, DFF, D, BF(O_DN1), DFF, CV_PLAIN, 0, nullptr, ldsf);
    mod_phase(p, mod, ldsf);
    GSYNC();
    norm_phase(p.in[0], p.in[2], MALL, p.in[6], mod, 0, 1, BF(O_HN), D);
    GSYNC();
    { S.init(MALL, 2 * DFF, gridDim.x, blockIdx.x); EpiUp E{BF(O_U)}; pg8::gemm_phase(lds, mk_gemm(BF(O_HN), BF(O_UP1), MALL, 2 * DFF, D, D, D), S, E); }
    GSYNC();
    const bool fuse_ok = gridDim.x == 256;
    if (fuse_ok) { S.init(MLAT, D, gridDim.x, blockIdx.x); EpiDn1Norm E{p.in[0], X1B, BF(O_XNXS), XNP, mod, p.in[10], RowX{(unsigned*)(ws + O_XSLOT_C), (unsigned*)(ws + O_XCNT_C)}};
        pg8::gemm_phase(lds, mk_gemm(BF(O_U), BF(O_DN1), MLAT, D, DFF, DFF, DFF), S, E); }
    else { S.init(MLAT, D, gridDim.x, blockIdx.x); EpiRes<false, true> E{p.in[0], nullptr, nullptr, X1B, mod, 2, 0.5f}; pg8::gemm_phase(lds, mk_gemm(BF(O_U), BF(O_DN1), MLAT, D, DFF, DFF, DFF), S, E); }
    { const float* gate = mod + (size_t)4 * NMOD + 2 * D; const bf16_t* Uc = BF(O_U) + (size_t)MLAT * DFF;
      { S.init(MCTX, D, gridDim.x, blockIdx.x); EpiCtx E{p.in[2], (float*)(ws + O_CTXX1), gate, 0.5f}; pg8::gemm_phase(lds, mk_gemm(Uc, BF(O_DN1), MCTX, D, DFF / 2, DFF, DFF), S, E); }
      { S.init(MCTX, D, gridDim.x, ((int)blockIdx.x + (int)gridDim.x - 16) % (int)gridDim.x); EpiCtx E{nullptr, (float*)(ws + O_CTXP2), gate, 0.5f}; pg8::gemm_phase(lds, mk_gemm(Uc + DFF / 2, BF(O_DN1) + DFF / 2, MCTX, D, DFF / 2, DFF, DFF), S, E); } }
    { const int cnb = gridDim.x > 64 ? (int)gridDim.x - 32 : (int)gridDim.x, cbid = gridDim.x > 64 ? (int)blockIdx.x - 32 : (int)blockIdx.x;
      if (cbid >= 0) {
        cvt_run2(p.in[11], 7552, D, 3456, BF(O_RW), 2048, CV_RW, 0, p.in[12], ldsf, cbid, cnb);
        for (int d = 0; d < 2; ++d) { cvt_run2(p.in[14] + (size_t)d * 64 * D, D, 64, D, BF(O_LSCW) + (size_t)d * D * 64, 64, CV_PLAIN, 0, nullptr, ldsf, cbid, cnb);
                                      cvt_run2(p.in[16] + (size_t)d * 64 * D, D, 64, D, BF(O_LSCA) + (size_t)d * D * 64, 64, CV_PLAIN, 0, nullptr, ldsf, cbid, cnb); }
        cvt_run2(p.in[17], D, 128, D, BF(O_GUP), 256, CV_PLAIN, 0, nullptr, ldsf, cbid, cnb);
        cvt_run2(p.in[11] + 3456, 7552, D, D, BF(O_LX), D, CV_PLAIN, 0, nullptr, ldsf, cbid, cnb);
        for (int q = 0; q < 8; ++q) { cvt_run2(p.in[27] + (size_t)q * 65536, 256, 256, 256, BF(O_LRUW), 256, CV_LRU, q * 2 + 0, nullptr, ldsf, cbid, cnb);
                                      cvt_run2(p.in[29] + (size_t)q * 65536, 256, 256, 256, BF(O_LRUW), 256, CV_LRU, q * 2 + 1, nullptr, ldsf, cbid, cnb); }
      } }
    zero_fill(ws + O_RW + (size_t)3456 * 2048 * 2, 128 * 2048 * 2, 128 * 2048 * 2, 1);
    zero_fill(ws + O_GUP + 256, 256, 512, 1024);
    { const int t = tidx(); if (blockIdx.x == 20) for (int i = t; i < 2 * D; i += NTHREADS) ((float*)(ws + O_CL))[i] = -8.0f * log1pf(expf(-p.in[26][i])); }
    GSYNC();
    if (fuse_ok) {
        xs_phase(BF(O_XNXS), XNP, MLAT);
        xs_ctx_phase((const float*)(ws + O_CTXX1), (const float*)(ws + O_CTXP2), p.in[10], mod, BF(O_XNXS));
    } else {
        norm_phase<true>(p.in[0], (const float*)(ws + O_CTXX1), MALL, p.in[10], mod, 3, 4, BF(O_XNXS), 2048, (const float*)(ws + O_CTXP2), X1B, XNP, 0);
        GSYNC();
        xs_phase(BF(O_XNXS), nullptr, MALL);
    }
    GSYNC();
    { S.init(MALL, 3584, gridDim.x, blockIdx.x); EpiRw E{BF(O_R), BF(O_LIN), BF(O_GD)}; pg8::gemm_phase(lds, mk_gemm(BF(O_XNXS), BF(O_RW), MALL, 3584, 2048, 2048, 2048), S, E); }
    { const int sh = ((MALL / 256) * 14) % (int)gridDim.x; S.init(MCTX, D, gridDim.x, ((int)blockIdx.x + (int)gridDim.x - sh) % (int)gridDim.x); EpiBf E{BF(O_PLXC), D};
      pg8::gemm_phase(lds, mk_gemm(BF(O_XNXS) + (size_t)MLAT * 2048, BF(O_LX), MCTX, D, D, 2048, D), S, E); }
    GSYNC();
    rncb_phase(BF(O_R), BF(O_K), p.in[18], p.in[20], (float*)(ws + O_RN), (float*)(ws + O_CB));
    cvt_run(p.in[11] + 4480, 7552, D, 3072, BF(O_LATE), D, CV_PLAIN, 0, nullptr, ldsf);
    cvt_run(p.in[23], D, D, D, BF(O_PRW), D, CV_PLAIN, 0, nullptr, ldsf);
    cvt_run(p.in[31], D, D, D, BF(O_PLRU), D, CV_PLAIN, 0, nullptr, ldsf);
    cvt_run(p.in[32], D, D, D, BF(O_WOUT), D, CV_PLAIN, 0, nullptr, ldsf);
    cvt_run(p.in[36], D, DFF, D, BF(O_DN2), DFF, CV_PLAIN, 0, nullptr, ldsf);
    GSYNC();
    rwkv_scan_phase(p, ldsf);
    GSYNC();
    if (gridDim.x == 256) {
        S.init(MLAT, D, gridDim.x, blockIdx.x); EpiPostG E{BF(O_YF), BF(O_YB), BF(O_V), (const float*)(ws + O_CB), p.in[21], p.in[22]};
        pg8::gemm_phase(lds, mk_gemm(BF(O_GD), BF(O_GUP), MLAT, D, 256, 256, 256), S, E);
    } else {
        post_phase(BF(O_YF), BF(O_YB), BF(O_V), (const float*)(ws + O_CB), p.in[21], p.in[22]);
        GSYNC();
        { S.init(MLAT, D, gridDim.x, blockIdx.x); EpiMul E{BF(O_YF), nullptr, 0}; pg8::gemm_phase(lds, mk_gemm(BF(O_GD), BF(O_GUP), MLAT, D, 256, 256, 256), S, E); }
    }
    { S.init(MLAT, D, gridDim.x, blockIdx.x); EpiBf E{BF(O_PLX), D}; pg8::gemm_phase(lds, mk_gemm(XNP, BF(O_LX), MLAT, D, D, D, D), S, E); }
    GSYNC();
    conv_phase(BF(O_PLX), BF(O_PLXC), BF(O_XC), p.in[24], p.in[25]);
    GSYNC();
    { S.init(MALL, 4096, gridDim.x, blockIdx.x); EpiLru E{BF(O_XC), BF(O_GRF), BF(O_UF), BF(O_GRB), BF(O_UB), p.in[28], p.in[30], (const float*)(ws + O_CL)};
      Gemm g = mk_gemm(BF(O_XC), BF(O_LRUW), MALL, 4096, 256, D, 256); g.ksh = 1; g.kmask = 3; g.kmul = 256; pg8::gemm_phase(lds, g, S, E); }
    GSYNC();
    lru_p1_phase(p);
    cvt_run(p.in[34], DFF, D, DFF, BF(O_UP2), D, CV_UPI, 0, nullptr, ldsf);
    cvt_run(p.in[35], DFF, D, DFF, BF(O_UP2), D, CV_UPI, 1, nullptr, ldsf);
    GSYNC();
    lru_p3_phase(p);
    GSYNC();
    { S.init(MLAT, 3072, gridDim.x, blockIdx.x); EpiLate E{BF(O_HSUM), BF(O_SMRW), BF(O_SMLRU)}; pg8::gemm_phase(lds, mk_gemm(XNP, BF(O_LATE), MLAT, 3072, D, D, D), S, E); }
    GSYNC();
    { S.init(MLAT, D, gridDim.x, blockIdx.x); EpiMul E{BF(O_SMRW), nullptr, 0}; pg8::gemm_phase(lds, mk_gemm(BF(O_YF), BF(O_PRW), MLAT, D, D, D, D), S, E); }
    { S.init(MLAT, D, gridDim.x, blockIdx.x); EpiMul E{BF(O_SMRW), BF(O_SMLRU), 1}; pg8::gemm_phase(lds, mk_gemm(BF(O_HSUM), BF(O_PLRU), MLAT, D, D, D, D), S, E); }
    GSYNC();
    if (gridDim.x == 256) {
        S.init(MLAT, D, gridDim.x, blockIdx.x); EpiOutNorm E{X1B, BF(O_X2B), BF(O_HN2), mod, p.in[33], RowX{(unsigned*)(ws + O_XSLOT_B), (unsigned*)(ws + O_XCNT_B)}};
        pg8::gemm_phase(lds, mk_gemm(BF(O_SMRW), BF(O_WOUT), MLAT, D, D, D, D), S, E);
        GSYNC();
    } else {
        { S.init(MLAT, D, gridDim.x, blockIdx.x); EpiRes<true, true> E{nullptr, X1B, nullptr, BF(O_X2B), mod, 5, 1.0f}; pg8::gemm_phase(lds, mk_gemm(BF(O_SMRW), BF(O_WOUT), MLAT, D, D, D, D), S, E); }
        GSYNC();
        norm_phase<true>(p.in[0], (const float*)(ws + O_CTXX1), MLAT, p.in[33], mod, 6, 7, BF(O_HN2), D, nullptr, BF(O_X2B));
        GSYNC();
    }
    { S.init(MLAT, 2 * DFF, gridDim.x, blockIdx.x); EpiUp E{BF(O_U2)}; pg8::gemm_phase(lds, mk_gemm(BF(O_HN2), BF(O_UP2), MLAT, 2 * DFF, D, D, D), S, E); }
    GSYNC();
    if (gridDim.x == 256) {
        S.init(MLAT, D, gridDim.x, blockIdx.x); EpiFinalNorm E{BF(O_X2B), p.out, mod, p.in[37], RowX{(unsigned*)(ws + O_XSLOT_A), (unsigned*)(ws + O_XCNT_A)}};
        pg8::gemm_phase(lds, mk_gemm(BF(O_U2), BF(O_DN2), MLAT, D, DFF, DFF, DFF), S, E);
    } else {
        { S.init(MLAT, D, gridDim.x, blockIdx.x); EpiRes<true, false> E{nullptr, BF(O_X2B), p.out, nullptr, mod, 8, 0.5f}; pg8::gemm_phase(lds, mk_gemm(BF(O_U2), BF(O_DN2), MLAT, D, DFF, DFF, DFF), S, E); }
        GSYNC();
        final_norm_phase(p.out, p.in[37]);
    }
}

extern "C" void kernel_launch(void* const* d_in, const int* in_sizes, int n_in, void* d_out, int out_size, void* d_ws, size_t ws_size, hipStream_t stream) {
    static int grid = 0;
    if (grid == 0) {
        if (n_in != 38 || out_size != MLAT * D || ws_size < WS_NEED) { fprintf(stderr, "kernel_launch: unexpected shapes (n_in %d, out %d, ws %zu); nothing launched\n", n_in, out_size, ws_size); grid = -1; return; }
        int dev = 0, cus = 0, per_cu = 0;
        hipGetDevice(&dev);
        hipDeviceGetAttribute(&cus, hipDeviceAttributeMultiprocessorCount, dev);
        if (hipFuncSetAttribute((const void*)mega, hipFuncAttributeMaxDynamicSharedMemorySize, LDS_BYTES) != hipSuccess) { fprintf(stderr, "kernel_launch: hipFuncSetAttribute failed\n"); grid = -1; return; }
        if (hipOccupancyMaxActiveBlocksPerMultiprocessor(&per_cu, (const void*)mega, NTHREADS, LDS_BYTES) != hipSuccess || per_cu < 1) { fprintf(stderr, "kernel_launch: occupancy query failed (%d)\n", per_cu); per_cu = 1; }
        (void)hipGetLastError();
        grid = cus * (per_cu > 1 ? 1 : per_cu);
    }
    if (grid < 0) return;
    Params p{};
    for (int i = 0; i < 38; ++i) p.in[i] = (const float*)d_in[i];
    p.out = (float*)d_out; p.ws = (unsigned char*)d_ws;
    if (hipMemsetAsync((unsigned char*)d_ws + O_BAR, 0, 65536, stream) != hipSuccess) { fprintf(stderr, "kernel_launch: memset failed\n"); return; }
    void* args[] = {&p};
    hipError_t e = hipLaunchCooperativeKernel((const void*)mega, dim3(grid), dim3(NTHREADS), args, LDS_BYTES, stream);
    if (e != hipSuccess) fprintf(stderr, "kernel_launch: cooperative launch failed: %s (grid %d)\n", hipGetErrorString(e), grid);
}
```

```cpp
#include <hip/hip_runtime.h>
#include <hip/hip_cooperative_groups.h>
#include <cstdio>
#include <cstdint>
namespace cg = cooperative_groups;

#define LAS __attribute__((address_space(3)))
typedef unsigned short bf16_t;
typedef short bf16x8 __attribute__((ext_vector_type(8)));
typedef float f32x4 __attribute__((ext_vector_type(4)));
typedef float f32x2 __attribute__((ext_vector_type(2)));
typedef unsigned u32x4 __attribute__((ext_vector_type(4)));
typedef unsigned u32x2 __attribute__((ext_vector_type(2)));

constexpr int D = 1024, DFF = 2816, MLAT = 16384, MCTX = 1024, MALL = 17408, NMOD = 9216;
constexpr int NTHREADS = 512, LDS_BYTES = 131072;
constexpr size_t MiB = 1048576;
constexpr size_t W0 = 0, W1 = 18 * MiB, SP = 34 * MiB, ACT = 50 * MiB;
constexpr size_t O_UP1 = W0, O_RW = W0, O_LATE = W0, O_PRW = W0 + 6 * MiB, O_PLRU = W0 + 8 * MiB, O_WOUT = W0 + 10 * MiB, O_DN2 = W0 + 12 * MiB;
constexpr size_t O_DN1 = W1 + 10 * MiB, O_LSCW = W1, O_LSCA = W1 + 256 * 1024, O_GUP = W1 + 512 * 1024, O_LX = W1 + 1 * MiB, O_LRUW = W1 + 3 * MiB, O_UP2 = W1;
constexpr size_t O_MOD = SP, O_RN = SP + 256 * 1024, O_CB = O_RN + 1280 * 1024, O_PQ = SP + 3 * MiB, O_CTXX1 = SP + 8 * MiB, O_CL = SP + 12 * MiB, O_BAR = SP + 13 * MiB, O_PLXC = SP + 14 * MiB, O_XCNT_B = SP + 13 * MiB + 16384, O_XCNT_A = SP + 13 * MiB + 32768, O_XSLOT_B = SP + 15 * MiB, O_XSLOT_A = SP + 15 * MiB + 262144, O_XCNT_C = SP + 13 * MiB + 49152, O_XSLOT_C = SP + 15 * MiB + 524288, O_CTXP2 = ACT + 200 * MiB, O_X2B = ACT + 136 * MiB;
constexpr size_t O_HN = ACT, O_U = ACT + 34 * MiB;
constexpr size_t O_XNXS = ACT, O_R = ACT + 68 * MiB, O_K = ACT + 102 * MiB, O_V = ACT + 136 * MiB, O_LIN = ACT + 170 * MiB, O_GD = ACT + 178 * MiB + 512 * 1024;
constexpr size_t O_YF = ACT, O_YB = ACT + 32 * MiB, O_XN2 = ACT + 68 * MiB, O_PLX = ACT + 102 * MiB, O_XC = ACT + 136 * MiB;
constexpr size_t O_GRF = ACT + 32 * MiB, O_UF = ACT + 66 * MiB, O_GRB = ACT + 100 * MiB, O_UB = ACT + 170 * MiB;
constexpr size_t O_HSUM = ACT + 136 * MiB, O_XN3 = ACT + 32 * MiB, O_SMRW = ACT + 66 * MiB, O_SMLRU = ACT + 98 * MiB;
constexpr size_t O_HN2 = ACT, O_U2 = ACT + 34 * MiB;
constexpr size_t WS_NEED = 256 * MiB;

struct Params { const float* in[38]; float* out; unsigned char* ws; };

__device__ __forceinline__ float bf2f(unsigned short b) { return __uint_as_float(((unsigned)b) << 16); }
__device__ __forceinline__ float bflo(unsigned u) { return __uint_as_float(u << 16); }
__device__ __forceinline__ float bfhi(unsigned u) { return __uint_as_float(u & 0xffff0000u); }
typedef __bf16 bf16x2_t __attribute__((ext_vector_type(2)));
__device__ __forceinline__ unsigned pk2(float lo, float hi) { const f32x2 v = {lo, hi}; const bf16x2_t b = __builtin_convertvector(v, bf16x2_t); return __builtin_bit_cast(unsigned, b); }
__device__ __forceinline__ int tidx() { int t = threadIdx.x; asm volatile("" : "+v"(t)); return t; }
__device__ __forceinline__ float frcp(float x) { return __builtin_amdgcn_rcpf(x); }
__device__ __forceinline__ float sigm(float x) { return frcp(1.0f + __expf(-x)); }
__device__ __forceinline__ float tanh_f(float x) { return 1.0f - 2.0f * frcp(__expf(2.0f * x) + 1.0f); }
__device__ __forceinline__ float silu_f(float x) { return x * sigm(x); }
__device__ __forceinline__ float gelu_f(float x) { return x * sigm(1.5957691216f * (x + 0.044715f * x * x * x)); }
__device__ __forceinline__ float wave_sum(float v) {
#pragma unroll
    for (int o = 1; o < 64; o <<= 1) v += __shfl_xor(v, o);
    return v;
}
template <int CTRL> __device__ __forceinline__ float dppf(float v) {
    return __builtin_bit_cast(float, __builtin_amdgcn_update_dpp(0, __builtin_bit_cast(int, v), CTRL, 0xF, 0xF, true));
}
__device__ __forceinline__ float red16(float v) {
    v += dppf<0xB1>(v); v += dppf<0x4E>(v); v += dppf<0x141>(v); v += dppf<0x140>(v); return v;
}

namespace pg8 {
constexpr int BM = 256, BK = 64, HALF = 128, HTB = HALF * BK * 2, NXCD = 8, WGM = 8;
__device__ __forceinline__ int lds_byte(int r, int c) { const int st = (r >> 4) * 2 + (c >> 5), rr = r & 15, cc = c & 31, ob = rr * 64 + cc * 2; return st * 1024 + (ob ^ (((ob >> 9) & 1) << 5)); }
__device__ __forceinline__ void stage_rc(int b, int& R, int& C) { const int st = b / 1024, sb = b % 1024, swz = sb ^ (((sb >> 9) & 1) << 5); R = (st >> 1) * 16 + swz / 64; C = (st & 1) * 32 + (swz % 64) / 2; }
struct Unit { int pm, pn; };
struct Gemm { const bf16_t* A; const bf16_t* Bt; int M, N, K, lda, ldb, ksh, kmask, kmul; };
struct StaticOrder {
    int nM, nN, nwg, G, c;
    __device__ void init(int M, int N, int G_, int c_) { nM = M / BM; nN = N / BM; nwg = nM * nN; G = G_; c = c_; }
    __device__ bool next(int i, Unit& u) const {
        const long L = (long)i * G + c; if (L >= nwg) return false;
        int wgid = (int)L; { const int q = nwg / NXCD, r = nwg % NXCD, xcd = wgid % NXCD, off = wgid / NXCD; wgid = (xcd < r ? xcd * (q + 1) : r * (q + 1) + (xcd - r) * q) + off; }
        const int nig = WGM * nN, gid = wgid / nig, fm = gid * WGM, gsz = (nM - fm) < WGM ? (nM - fm) : WGM;
        u.pm = fm + ((wgid % nig) % gsz); u.pn = (wgid % nig) / gsz; return true;
    }
};

template <class E, class = void> struct is_ad { static constexpr bool value = false; };
template <class E> struct is_ad<E, decltype((void)E::AFTER_DRAIN)> { static constexpr bool value = true; };

template <class Epi>
__device__ __forceinline__ void gemm_phase(LAS unsigned char* lds, const Gemm g, const StaticOrder& S, const Epi& E) {
    const int tid = tidx(), wid = __builtin_amdgcn_readfirstlane(tid >> 6), lane = tid & 63, wr = wid >> 2, wc = wid & 3, fr = lane & 15, fq = lane >> 4;
    const int K = g.K, nt = K / BK;
    unsigned voffA[2], voffB[2];
#pragma unroll
    for (int i = 0; i < 2; ++i) { int R, C; stage_rc(tid * 16 + i * 8192, R, C);
        voffA[i] = (unsigned)(R * g.lda + C) * 2u; voffB[i] = (unsigned)(R * g.ldb + C) * 2u; }
    const size_t kstep = (size_t)(BK * 2);
    const size_t hstepA = (size_t)HALF * g.lda * 2, hstepB = (size_t)HALF * g.ldb * 2;
    const size_t tstepA = 2 * hstepA, tstepB = 2 * hstepB;
    const unsigned ldsw = (unsigned)wid * 1024u;
    const int aoff = lds_byte(wr * 64 + fr, fq * 8), boff = lds_byte(wc * 32 + fr, fq * 8);
#define PG8_SA(b, h) (((b) * 2 + (h)) * HTB)
#define PG8_SB(b, h) ((4 + (b) * 2 + (h)) * HTB)
#define PG8_STAGE(bufoff, gbase, voff) do { _Pragma("unroll") for (int _i = 0; _i < 2; ++_i) \
        __builtin_amdgcn_global_load_lds((const unsigned*)((const char*)(gbase) + (voff)[_i]), (LAS unsigned*)(lds + (bufoff) + ldsw + _i * 8192), 16, 0, 0); } while (0)
#define PG8_LDA(dst, b, h) do { _Pragma("unroll") for (int m = 0; m < 4; ++m) _Pragma("unroll") for (int k = 0; k < 2; ++k) dst[m][k] = *(const LAS bf16x8*)(lds + PG8_SA(b, h) + aoff + m * 2048 + k * 1024); } while (0)
#define PG8_LDB(dst, b, h) do { _Pragma("unroll") for (int n = 0; n < 2; ++n) _Pragma("unroll") for (int k = 0; k < 2; ++k) dst[n][k] = *(const LAS bf16x8*)(lds + PG8_SB(b, h) + boff + n * 2048 + k * 1024); } while (0)
#define PG8_MMA(ai, bj, At, Bt) do { __builtin_amdgcn_s_setprio(1); _Pragma("unroll") for (int m = 0; m < 4; ++m) _Pragma("unroll") for (int n = 0; n < 2; ++n) _Pragma("unroll") for (int k = 0; k < 2; ++k) \
        acc[ai][bj][m][n] = __builtin_amdgcn_mfma_f32_16x16x32_bf16(Bt[n][k], At[m][k], acc[ai][bj][m][n], 0, 0, 0); __builtin_amdgcn_s_setprio(0); } while (0)
#define PG8_WAIT_V(n) asm volatile("s_waitcnt vmcnt(" #n ")" ::: "memory")
#define PG8_WAIT_L(n) asm volatile("s_waitcnt lgkmcnt(" #n ")" ::: "memory")
#define PG8_BAR __builtin_amdgcn_s_barrier()
#define PG8_SCHED __builtin_amdgcn_sched_barrier(0)
#define PG8_KOFF(u) ((size_t)((((u).pn >> g.ksh) & g.kmask) * g.kmul) * 2)
    Unit cur, nxt; int ui = 0;
    if (!S.next(0, cur)) return;
    f32x4 acc[2][2][4][2];
#pragma unroll
    for (int a = 0; a < 2; ++a)
#pragma unroll
        for (int b = 0; b < 2; ++b)
#pragma unroll
            for (int m = 0; m < 4; ++m)
#pragma unroll
                for (int n = 0; n < 2; ++n) acc[a][b][m][n] = (f32x4){0.f, 0.f, 0.f, 0.f};
    bf16x8 At[4][2], B0[2][2], B1[2][2];
    const char* cA = (const char*)g.A + (size_t)cur.pm * tstepA + PG8_KOFF(cur); const char* cB = (const char*)g.Bt + (size_t)cur.pn * tstepB;
    PG8_STAGE(PG8_SB(0, 0), cB, voffB); PG8_STAGE(PG8_SA(0, 0), cA, voffA); PG8_STAGE(PG8_SB(0, 1), cB + hstepB, voffB); PG8_STAGE(PG8_SA(0, 1), cA + hstepA, voffA);
    if (wr == 1) PG8_BAR;
    PG8_WAIT_V(4); PG8_BAR;
    PG8_STAGE(PG8_SB(1, 0), cB + kstep, voffB); PG8_STAGE(PG8_SA(1, 0), cA + kstep, voffA); PG8_STAGE(PG8_SB(1, 1), cB + hstepB + kstep, voffB);
    PG8_WAIT_V(6); PG8_BAR;
    for (;;) {
        const bool has_next = S.next(ui + 1, nxt);
        const char* nA = has_next ? (const char*)g.A + (size_t)nxt.pm * tstepA + PG8_KOFF(nxt) : cA; const char* nB = has_next ? (const char*)g.Bt + (size_t)nxt.pn * tstepB : cB;
        for (int t = 0; t < nt; t += 2) {
            const bool last = (t == nt - 2);
            const char* a1 = cA + (size_t)(t + 1) * kstep;
            const char* a2 = last ? nA : cA + (size_t)(t + 2) * kstep; const char* b2 = last ? nB : cB + (size_t)(t + 2) * kstep;
            const char* a3 = a2 + kstep; const char* b3 = b2 + kstep;
            PG8_LDB(B0, 0, 0); PG8_SCHED; PG8_LDA(At, 0, 0); PG8_STAGE(PG8_SA(1, 1), a1 + hstepA, voffA);
            PG8_WAIT_L(8); PG8_BAR; PG8_WAIT_L(0); PG8_MMA(0, 0, At, B0); PG8_BAR; PG8_SCHED;
            PG8_LDB(B1, 0, 1); PG8_STAGE(PG8_SB(0, 0), b2, voffB);
            PG8_BAR; PG8_WAIT_L(0); PG8_MMA(0, 1, At, B1); PG8_BAR;
            PG8_LDA(At, 0, 1); PG8_STAGE(PG8_SA(0, 0), a2, voffA);
            PG8_BAR; PG8_WAIT_L(0); PG8_MMA(1, 0, At, B0); PG8_BAR; PG8_SCHED;
            PG8_STAGE(PG8_SB(0, 1), b2 + hstepB, voffB);
            PG8_WAIT_V(6); PG8_BAR; PG8_MMA(1, 1, At, B1); PG8_BAR;
            PG8_LDB(B0, 1, 0); PG8_SCHED; PG8_LDA(At, 1, 0); PG8_STAGE(PG8_SA(0, 1), a2 + hstepA, voffA);
            PG8_WAIT_L(8); PG8_BAR; PG8_WAIT_L(0); PG8_MMA(0, 0, At, B0); PG8_BAR; PG8_SCHED;
            PG8_LDB(B1, 1, 1); PG8_STAGE(PG8_SB(1, 0), b3, voffB);
            PG8_BAR; PG8_WAIT_L(0); PG8_MMA(0, 1, At, B1); PG8_BAR;
            PG8_LDA(At, 1, 1); PG8_STAGE(PG8_SA(1, 0), a3, voffA);
            PG8_BAR; PG8_WAIT_L(0); PG8_MMA(1, 0, At, B0); PG8_BAR; PG8_SCHED;
            PG8_STAGE(PG8_SB(1, 1), b3 + hstepB, voffB);
            PG8_WAIT_V(6); PG8_BAR; PG8_MMA(1, 1, At, B1); PG8_BAR;
        }
        if constexpr (!is_ad<Epi>::value) E(acc, cur, wr, wc, fr, fq);
        if (!has_next) break;
#pragma unroll
        for (int a = 0; a < 2; ++a)
#pragma unroll
            for (int b = 0; b < 2; ++b)
#pragma unroll
                for (int m = 0; m < 4; ++m)
#pragma unroll
                    for (int n = 0; n < 2; ++n) acc[a][b][m][n] = (f32x4){0.f, 0.f, 0.f, 0.f};
        cur = nxt; cA = nA; cB = nB; ++ui;
    }
    PG8_WAIT_V(0);
    if (wr == 0) PG8_BAR;
    PG8_BAR;
    if constexpr (is_ad<Epi>::value) E.fused(acc, cur, wr, wc, fr, fq, lds, wid, lane);
#undef PG8_SA
#undef PG8_SB
#undef PG8_STAGE
#undef PG8_LDA
#undef PG8_LDB
#undef PG8_MMA
#undef PG8_WAIT_V
#undef PG8_WAIT_L
#undef PG8_BAR
#undef PG8_SCHED
#undef PG8_KOFF
}
}
using pg8::Unit;
using pg8::Gemm;

#define EPI_ROWS(...) _Pragma("unroll") for (int ai = 0; ai < 2; ++ai) _Pragma("unroll") for (int m = 0; m < 4; ++m) { const int row = u.pm * 256 + ai * 128 + wr * 64 + m * 16 + fr; __VA_ARGS__ }
#define EPI_ALL(...) _Pragma("unroll") for (int ai = 0; ai < 2; ++ai) _Pragma("unroll") for (int m = 0; m < 4; ++m) _Pragma("unroll") for (int bj = 0; bj < 2; ++bj) _Pragma("unroll") for (int n = 0; n < 2; ++n) { \
        const int row = u.pm * 256 + ai * 128 + wr * 64 + m * 16 + fr; __VA_ARGS__ }
typedef const f32x4 (&AccRef)[2][2][4][2];

struct EpiUp {
    bf16_t* U;
    __device__ __forceinline__ void operator()(AccRef acc, const Unit& u, int wr, int wc, int fr, int fq) const {
        EPI_ROWS(
            _Pragma("unroll") for (int bj = 0; bj < 2; ++bj) {
                const f32x4 g = acc[ai][bj][m][0], v = acc[ai][bj][m][1];
                const int f0 = ((u.pn * 256 + bj * 128 + wc * 32) >> 1) + 4 * fq;
                u32x2 o; o.x = pk2(silu_f(g[0]) * v[0], silu_f(g[1]) * v[1]); o.y = pk2(silu_f(g[2]) * v[2], silu_f(g[3]) * v[3]);
                *(u32x2*)(U + (size_t)row * DFF + f0) = o; }
        )
    }
};
template <bool RB, bool OB> struct EpiRes {
    const float* res_f; const bf16_t* res_b; float* out_f; bf16_t* out_b; const float* mod; int gidx; float scale;
    __device__ __forceinline__ void operator()(AccRef acc, const Unit& u, int wr, int wc, int fr, int fq) const {
        u32x2 tv[2][4][2][2];
        if constexpr (RB) { EPI_ALL( const int col = u.pn * 256 + bj * 128 + wc * 32 + n * 16 + 4 * fq; tv[ai][m][bj][n] = *(const u32x2*)(res_b + (size_t)row * D + col); ) }
        EPI_ROWS(
            const float* gp = mod + (size_t)(row >> 12) * NMOD + gidx * D;
            _Pragma("unroll") for (int bj = 0; bj < 2; ++bj) _Pragma("unroll") for (int n = 0; n < 2; ++n) {
                const int col = u.pn * 256 + bj * 128 + wc * 32 + n * 16 + 4 * fq; const size_t off = (size_t)row * D + col;
                f32x4 r;
                if constexpr (RB) { const u32x2 t = tv[ai][m][bj][n]; r = (f32x4){bflo(t.x), bfhi(t.x), bflo(t.y), bfhi(t.y)}; } else r = *(const f32x4*)(res_f + off);
                const f32x4 gt = *(const f32x4*)(gp + col);
                const f32x4 o = r + scale * gt * acc[ai][bj][m][n];
                if constexpr (OB) { u32x2 w; w.x = pk2(o[0], o[1]); w.y = pk2(o[2], o[3]); *(u32x2*)(out_b + off) = w; } else *(f32x4*)(out_f + off) = o; }
        )
    }
};
struct EpiCtx {
    const float* res; float* out; const float* gate; float scale;
    __device__ __forceinline__ void operator()(AccRef acc, const Unit& u, int wr, int wc, int fr, int fq) const {
        EPI_ROWS(
            _Pragma("unroll") for (int bj = 0; bj < 2; ++bj) _Pragma("unroll") for (int n = 0; n < 2; ++n) {
                const int col = u.pn * 256 + bj * 128 + wc * 32 + n * 16 + 4 * fq; const size_t off = (size_t)row * D + col;
                const f32x4 gt = *(const f32x4*)(gate + col); f32x4 r = (f32x4){0.f, 0.f, 0.f, 0.f};
                if (res) r = *(const f32x4*)(res + off);
                *(f32x4*)(out + off) = r + scale * gt * acc[ai][bj][m][n]; }
        )
    }
};
struct EpiRw {
    bf16_t *RKV, *LIN, *GD;
    __device__ __forceinline__ void operator()(AccRef acc, const Unit& u, int wr, int wc, int fr, int fq) const {
        const int pn = u.pn;
        if (pn < 12) {
            bf16_t* base = RKV + (size_t)(pn >> 2) * ((size_t)MALL * D) + (pn & 3) * 256;
            EPI_ROWS(
                _Pragma("unroll") for (int bj = 0; bj < 2; ++bj) _Pragma("unroll") for (int n = 0; n < 2; ++n) {
                    const int cl = bj * 128 + wc * 32 + n * 16 + 4 * fq; const f32x4 a = acc[ai][bj][m][n];
                    u32x2 o; o.x = pk2(a[0], a[1]); o.y = pk2(a[2], a[3]);
                    *(u32x2*)(base + (size_t)row * D + cl) = o; }
            )
        } else if (pn == 12) {
            EPI_ROWS(
                _Pragma("unroll") for (int bj = 0; bj < 2; ++bj) _Pragma("unroll") for (int n = 0; n < 2; ++n) {
                    const int cl = bj * 128 + wc * 32 + n * 16 + 4 * fq; f32x4 a = acc[ai][bj][m][n];
                    if (bj == 0) { a[0] = tanh_f(a[0]); a[1] = tanh_f(a[1]); a[2] = tanh_f(a[2]); a[3] = tanh_f(a[3]); }
                    u32x2 o; o.x = pk2(a[0], a[1]); o.y = pk2(a[2], a[3]);
                    *(u32x2*)(LIN + (size_t)row * 256 + cl) = o; }
            )
        } else {
            EPI_ROWS(
                _Pragma("unroll") for (int bj = 0; bj < 2; ++bj) _Pragma("unroll") for (int n = 0; n < 2; ++n) {
                    const int cl = bj * 128 + wc * 32 + n * 16 + 4 * fq; const f32x4 a = acc[ai][bj][m][n];
                    u32x2 o; o.x = 0u; o.y = 0u;
                    if (bj == 0) { o.x = pk2(sigm(a[0]), sigm(a[1])); o.y = pk2(sigm(a[2]), sigm(a[3])); }
                    *(u32x2*)(GD + (size_t)row * 256 + cl) = o; }
            )
        }
    }
};
struct EpiBf {
    bf16_t* O; int ldo;
    __device__ __forceinline__ void operator()(AccRef acc, const Unit& u, int wr, int wc, int fr, int fq) const {
        EPI_ROWS(
            _Pragma("unroll") for (int bj = 0; bj < 2; ++bj) _Pragma("unroll") for (int n = 0; n < 2; ++n) {
                const int col = u.pn * 256 + bj * 128 + wc * 32 + n * 16 + 4 * fq; const f32x4 a = acc[ai][bj][m][n];
                u32x2 o; o.x = pk2(a[0], a[1]); o.y = pk2(a[2], a[3]);
                *(u32x2*)(O + (size_t)row * ldo + col) = o; }
        )
    }
};
struct EpiMul {
    bf16_t* T; const bf16_t* S2; int mode;
    __device__ __forceinline__ void operator()(AccRef acc, const Unit& u, int wr, int wc, int fr, int fq) const {
#pragma unroll
        for (int ai = 0; ai < 2; ++ai) {
            u32x2 tv[4][2][2], sv[4][2][2];
#pragma unroll
            for (int m = 0; m < 4; ++m)
#pragma unroll
                for (int bj = 0; bj < 2; ++bj)
#pragma unroll
                    for (int n = 0; n < 2; ++n) { const int row = u.pm * 256 + ai * 128 + wr * 64 + m * 16 + fr, col = u.pn * 256 + bj * 128 + wc * 32 + n * 16 + 4 * fq; const size_t off = (size_t)row * D + col;
                        tv[m][bj][n] = *(const u32x2*)(T + off); sv[m][bj][n] = (u32x2){0u, 0u}; if (mode != 0) sv[m][bj][n] = *(const u32x2*)(S2 + off); }
#pragma unroll
            for (int m = 0; m < 4; ++m)
#pragma unroll
                for (int bj = 0; bj < 2; ++bj)
#pragma unroll
                    for (int n = 0; n < 2; ++n) { const int row = u.pm * 256 + ai * 128 + wr * 64 + m * 16 + fr, col = u.pn * 256 + bj * 128 + wc * 32 + n * 16 + 4 * fq; const size_t off = (size_t)row * D + col;
                        const f32x4 a = acc[ai][bj][m][n]; const u32x2 t = tv[m][bj][n], q = sv[m][bj][n]; u32x2 o;
                        if (mode == 0) { o.x = pk2(bflo(t.x) * a[0], bfhi(t.x) * a[1]); o.y = pk2(bflo(t.y) * a[2], bfhi(t.y) * a[3]); }
                        else { o.x = pk2(bflo(t.x) + bflo(q.x) * a[0], bfhi(t.x) + bfhi(q.x) * a[1]); o.y = pk2(bflo(t.y) + bflo(q.y) * a[2], bfhi(t.y) + bfhi(q.y) * a[3]); }
                        *(u32x2*)(T + off) = o; }
        }
    }
};
struct EpiLru {
    const bf16_t* XC; bf16_t *GR0, *U0, *GR1, *U1; const float *ba, *bx, *cl;
    __device__ __forceinline__ void operator()(AccRef acc, const Unit& u, int wr, int wc, int fr, int fq) const {
        const int d = u.pn >> 3, pn8 = u.pn & 7;
        bf16_t* GR = GR0 + (size_t)d * ((size_t)(O_GRB - O_GRF) / 2); bf16_t* UU = U0 + (size_t)d * ((size_t)(O_UB - O_UF) / 2);
#pragma unroll
        for (int bj = 0; bj < 2; ++bj) { const int c0 = 128 * pn8 + 16 * (4 * bj + wc) + 4 * fq;
            const f32x4 vba = *(const f32x4*)(ba + d * D + c0), vbx = *(const f32x4*)(bx + d * D + c0), vcl = *(const f32x4*)(cl + d * D + c0);
            u32x2 xv[2][4];
            EPI_ROWS( xv[ai][m] = *(const u32x2*)(XC + (size_t)row * D + c0); )
            EPI_ROWS(
                const size_t off = (size_t)row * D + c0;
                const u32x2 xcv = xv[ai][m];
                const float xc[4] = {bflo(xcv.x), bfhi(xcv.x), bflo(xcv.y), bfhi(xcv.y)};
                float gr[4]; float uu[4];
                _Pragma("unroll") for (int j = 0; j < 4; ++j) {
                    gr[j] = sigm(acc[ai][bj][m][0][j] + vba[j]);
                    const float gi = sigm(acc[ai][bj][m][1][j] + vbx[j]);
                    const float x = 2.0f * gr[j] * vcl[j];
                    const float om = -x * (1.0f + 0.5f * x * (1.0f + (1.0f / 3.0f) * x * (1.0f + 0.25f * x)));
                    uu[j] = __builtin_amdgcn_sqrtf(om) * gi * xc[j]; }
                u32x2 o1; u32x2 o2; o1.x = pk2(gr[0], gr[1]); o1.y = pk2(gr[2], gr[3]); o2.x = pk2(uu[0], uu[1]); o2.y = pk2(uu[2], uu[3]);
                *(u32x2*)(GR + off) = o1; *(u32x2*)(UU + off) = o2;
            )
        }
    }
};
struct EpiLate {
    bf16_t *HS, *S1, *S2;
    __device__ __forceinline__ void operator()(AccRef acc, const Unit& u, int wr, int wc, int fr, int fq) const {
        const int part = u.pn >> 2;
        if (part == 0) {
            u32x2 tv[2][4][2][2];
            EPI_ALL( const int col = (u.pn & 3) * 256 + bj * 128 + wc * 32 + n * 16 + 4 * fq; tv[ai][m][bj][n] = *(const u32x2*)(HS + (size_t)row * D + col); )
            EPI_ALL( const int col = (u.pn & 3) * 256 + bj * 128 + wc * 32 + n * 16 + 4 * fq; const f32x4 a = acc[ai][bj][m][n]; const u32x2 t = tv[ai][m][bj][n]; u32x2 o;
                o.x = pk2(bflo(t.x) * gelu_f(a[0]), bfhi(t.x) * gelu_f(a[1])); o.y = pk2(bflo(t.y) * gelu_f(a[2]), bfhi(t.y) * gelu_f(a[3]));
                *(u32x2*)(HS + (size_t)row * D + col) = o; )
        } else {
            bf16_t* O = part == 1 ? S1 : S2;
            EPI_ALL( const int col = (u.pn & 3) * 256 + bj * 128 + wc * 32 + n * 16 + 4 * fq; const f32x4 a = acc[ai][bj][m][n]; u32x2 o;
                o.x = pk2(sigm(a[0]), sigm(a[1])); o.y = pk2(sigm(a[2]), sigm(a[3])); *(u32x2*)(O + (size_t)row * D + col) = o; )
        }
    }
};

struct EpiPostG {
    static constexpr bool AFTER_DRAIN = true;
    bf16_t* YF; const bf16_t* YB; const bf16_t* V; const float* cb; const float* lnw; const float* lnb;
    __device__ __forceinline__ void fused(f32x4 (&acc)[2][2][4][2], const Unit& u, int wr, int wc, int fr, int fq, LAS unsigned char* lds, int wid, int lane) const {
        LAS f32x2* P = (LAS f32x2*)lds;
#pragma unroll
        for (int ai = 0; ai < 2; ++ai)
#pragma unroll
            for (int bj = 0; bj < 2; ++bj) { const int qd = ai * 2 + bj;
                u32x2 a[4][2], b[4][2], vv[4][2];
#pragma unroll
                for (int m = 0; m < 4; ++m)
#pragma unroll
                    for (int n = 0; n < 2; ++n) { const size_t off = (size_t)(u.pm * 256 + ai * 128 + wr * 64 + m * 16 + fr) * D + u.pn * 256 + bj * 128 + wc * 32 + n * 16 + 4 * fq;
                        a[m][n] = *(const u32x2*)(YF + off); b[m][n] = *(const u32x2*)(YB + off); vv[m][n] = *(const u32x2*)(V + off); }
                f32x4 y[4][2];
#pragma unroll
                for (int m = 0; m < 4; ++m) { float s1 = 0.f, s2 = 0.f;
#pragma unroll
                    for (int n = 0; n < 2; ++n) { const f32x4 t = (f32x4){bflo(a[m][n].x) + bflo(b[m][n].x), bfhi(a[m][n].x) + bfhi(b[m][n].x), bflo(a[m][n].y) + bflo(b[m][n].y), bfhi(a[m][n].y) + bfhi(b[m][n].y)};
                        y[m][n] = t; s1 += (t[0] + t[1]) + (t[2] + t[3]); s2 += (t[0] * t[0] + t[1] * t[1]) + (t[2] * t[2] + t[3] * t[3]); }
                    s1 += __shfl_xor(s1, 16); s1 += __shfl_xor(s1, 32); s2 += __shfl_xor(s2, 16); s2 += __shfl_xor(s2, 32);
                    if (fq == 0) P[(qd * 128 + wr * 64 + m * 16 + fr) * 4 + wc] = (f32x2){s1, s2}; }
                __syncthreads();
                const int head = 4 * u.pn + 2 * bj + (wc >> 1);
#pragma unroll
                for (int m = 0; m < 4; ++m) { const int rl = wr * 64 + m * 16 + fr, row = u.pm * 256 + ai * 128 + rl;
                    const f32x2 p0 = P[(qd * 128 + rl) * 4 + wc], p1 = P[(qd * 128 + rl) * 4 + (wc ^ 1)];
                    const float mean = (p0[0] + p1[0]) * (1.0f / 64.0f), var = fmaxf((p0[1] + p1[1]) * (1.0f / 64.0f) - mean * mean, 0.f), rs = rsqrtf(var + 64e-5f);
                    const float cbs = cb[(size_t)row * 16 + head];
#pragma unroll
                    for (int n = 0; n < 2; ++n) { const int col = u.pn * 256 + bj * 128 + wc * 32 + n * 16 + 4 * fq; const size_t off = (size_t)row * D + col;
                        const f32x4 w = *(const f32x4*)(lnw + col), bb = *(const f32x4*)(lnb + col), g = acc[ai][bj][m][n];
                        const f32x4 v4 = (f32x4){bflo(vv[m][n].x), bfhi(vv[m][n].x), bflo(vv[m][n].y), bfhi(vv[m][n].y)};
                        const f32x4 o = ((y[m][n] - mean) * rs * w + bb + cbs * v4) * g;
                        u32x2 q; q.x = pk2(o[0], o[1]); q.y = pk2(o[2], o[3]); *(u32x2*)(YF + off) = q; } }
            }
        __syncthreads();
    }
};
struct RowX { unsigned* slots; unsigned* cnt; };
__device__ __forceinline__ void row_rstd_exchange(f32x4 (&v)[2][2][4][2], const Unit& u, int wr, int wc, int fr, int fq, LAS unsigned char* lds, int wid, int lane, const RowX& X) {
    LAS float* P = (LAS float*)lds; LAS float* S = (LAS float*)(lds + 4096);
#pragma unroll
    for (int ai = 0; ai < 2; ++ai)
#pragma unroll
        for (int m = 0; m < 4; ++m) { float q = 0.f;
#pragma unroll
            for (int bj = 0; bj < 2; ++bj)
#pragma unroll
                for (int n = 0; n < 2; ++n) { const f32x4 x = v[ai][bj][m][n]; q += (x[0] * x[0] + x[1] * x[1]) + (x[2] * x[2] + x[3] * x[3]); }
            q += __shfl_xor(q, 16); q += __shfl_xor(q, 32);
            if (fq == 0) P[(ai * 128 + wr * 64 + m * 16 + fr) * 4 + wc] = q; }
    __syncthreads();
    const int row = wid * 32 + (lane & 31);
    if (lane < 32) { const float t = (P[row * 4] + P[row * 4 + 1]) + (P[row * 4 + 2] + P[row * 4 + 3]);
        __hip_atomic_store(X.slots + ((size_t)(u.pm * 256 + row) * 4 + u.pn), __float_as_uint(t), __ATOMIC_RELAXED, __HIP_MEMORY_SCOPE_AGENT); }
    asm volatile("s_waitcnt vmcnt(0)" ::: "memory");
    if (lane == 0) __hip_atomic_fetch_add(X.cnt + 64 * u.pm, 1u, __ATOMIC_RELAXED, __HIP_MEMORY_SCOPE_AGENT);
    if (wid == 0) { unsigned sp = 0u;
        while ((unsigned)__builtin_amdgcn_readfirstlane(__hip_atomic_load(X.cnt + 64 * u.pm, __ATOMIC_RELAXED, __HIP_MEMORY_SCOPE_AGENT)) < 32u) { __builtin_amdgcn_s_sleep(1); if (++sp > (1u << 22)) break; } }
    __syncthreads();
    if (lane < 32) { const unsigned* sl = X.slots + (size_t)(u.pm * 256 + row) * 4; float t = 0.f;
#pragma unroll
        for (int q = 0; q < 4; ++q) t += __uint_as_float(__hip_atomic_load(sl + q, __ATOMIC_RELAXED, __HIP_MEMORY_SCOPE_AGENT));
        S[row] = rsqrtf(t * (1.0f / D) + 1e-6f); }
    __syncthreads();
}
struct EpiOutNorm {
    static constexpr bool AFTER_DRAIN = true;
    const bf16_t* res_b; bf16_t* x2b; bf16_t* hn; const float* mod; const float* g2; RowX X;
    __device__ __forceinline__ void fused(f32x4 (&acc)[2][2][4][2], const Unit& u, int wr, int wc, int fr, int fq, LAS unsigned char* lds, int wid, int lane) const {
        const float* mb = mod + (size_t)((u.pm * 256) >> 12) * NMOD;
#pragma unroll
        for (int ai = 0; ai < 2; ++ai) { u32x2 tv[4][2][2];
#pragma unroll
            for (int m = 0; m < 4; ++m)
#pragma unroll
                for (int bj = 0; bj < 2; ++bj)
#pragma unroll
                    for (int n = 0; n < 2; ++n) { const int row = u.pm * 256 + ai * 128 + wr * 64 + m * 16 + fr, col = u.pn * 256 + bj * 128 + wc * 32 + n * 16 + 4 * fq; tv[m][bj][n] = *(const u32x2*)(res_b + (size_t)row * D + col); }
#pragma unroll
            for (int m = 0; m < 4; ++m)
#pragma unroll
                for (int bj = 0; bj < 2; ++bj)
#pragma unroll
                    for (int n = 0; n < 2; ++n) { const int row = u.pm * 256 + ai * 128 + wr * 64 + m * 16 + fr, col = u.pn * 256 + bj * 128 + wc * 32 + n * 16 + 4 * fq; const u32x2 t = tv[m][bj][n];
                        const f32x4 gt = *(const f32x4*)(mb + 5 * D + col);
                        const f32x4 o = (f32x4){bflo(t.x), bfhi(t.x), bflo(t.y), bfhi(t.y)} + gt * acc[ai][bj][m][n];
                        acc[ai][bj][m][n] = o;
                        u32x2 w; w.x = pk2(o[0], o[1]); w.y = pk2(o[2], o[3]); *(u32x2*)(x2b + (size_t)row * D + col) = w; }
        }
        row_rstd_exchange(acc, u, wr, wc, fr, fq, lds, wid, lane, X);
        const LAS float* S = (const LAS float*)(lds + 4096);
#pragma unroll
        for (int bj = 0; bj < 2; ++bj)
#pragma unroll
            for (int n = 0; n < 2; ++n) { const int col = u.pn * 256 + bj * 128 + wc * 32 + n * 16 + 4 * fq;
                const f32x4 mul = *(const f32x4*)(g2 + col) * (1.0f + *(const f32x4*)(mb + 7 * D + col)), sh = *(const f32x4*)(mb + 6 * D + col);
#pragma unroll
                for (int ai = 0; ai < 2; ++ai)
#pragma unroll
                    for (int m = 0; m < 4; ++m) { const int rl = ai * 128 + wr * 64 + m * 16 + fr; const float rs = S[rl];
                        const f32x4 y = acc[ai][bj][m][n] * rs * mul + sh;
                        u32x2 w; w.x = pk2(y[0], y[1]); w.y = pk2(y[2], y[3]); *(u32x2*)(hn + (size_t)(u.pm * 256 + rl) * D + col) = w; } }
    }
};
struct EpiDn1Norm {
    static constexpr bool AFTER_DRAIN = true;
    const float* res_f; bf16_t* x1b; bf16_t* xnxs; bf16_t* xnp; const float* mod; const float* gm; RowX X;
    __device__ __forceinline__ void fused(f32x4 (&acc)[2][2][4][2], const Unit& u, int wr, int wc, int fr, int fq, LAS unsigned char* lds, int wid, int lane) const {
        const float* mb = mod + (size_t)((u.pm * 256) >> 12) * NMOD;
        f32x4 gt[2][2];
#pragma unroll
        for (int bj = 0; bj < 2; ++bj)
#pragma unroll
            for (int n = 0; n < 2; ++n) gt[bj][n] = 0.5f * *(const f32x4*)(mb + 2 * D + u.pn * 256 + bj * 128 + wc * 32 + n * 16 + 4 * fq);
#pragma unroll
        for (int ai = 0; ai < 2; ++ai)
#pragma unroll
            for (int mh = 0; mh < 2; ++mh) { f32x4 rv[2][2][2];
#pragma unroll
                for (int mm = 0; mm < 2; ++mm)
#pragma unroll
                    for (int bj = 0; bj < 2; ++bj)
#pragma unroll
                        for (int n = 0; n < 2; ++n) { const int m = 2 * mh + mm, row = u.pm * 256 + ai * 128 + wr * 64 + m * 16 + fr, col = u.pn * 256 + bj * 128 + wc * 32 + n * 16 + 4 * fq; rv[mm][bj][n] = *(const f32x4*)(res_f + (size_t)row * D + col); }
#pragma unroll
                for (int mm = 0; mm < 2; ++mm)
#pragma unroll
                    for (int bj = 0; bj < 2; ++bj)
#pragma unroll
                        for (int n = 0; n < 2; ++n) { const int m = 2 * mh + mm, row = u.pm * 256 + ai * 128 + wr * 64 + m * 16 + fr, col = u.pn * 256 + bj * 128 + wc * 32 + n * 16 + 4 * fq;
                            const f32x4 o = rv[mm][bj][n] + gt[bj][n] * acc[ai][bj][m][n]; acc[ai][bj][m][n] = o;
                            u32x2 w; w.x = pk2(o[0], o[1]); w.y = pk2(o[2], o[3]); *(u32x2*)(x1b + (size_t)row * D + col) = w; }
            }
        row_rstd_exchange(acc, u, wr, wc, fr, fq, lds, wid, lane, X);
        const LAS float* S = (const LAS float*)(lds + 4096);
#pragma unroll
        for (int bj = 0; bj < 2; ++bj)
#pragma unroll
            for (int n = 0; n < 2; ++n) { const int col = u.pn * 256 + bj * 128 + wc * 32 + n * 16 + 4 * fq;
                const f32x4 mul = *(const f32x4*)(gm + col) * (1.0f + *(const f32x4*)(mb + 4 * D + col)), sh = *(const f32x4*)(mb + 3 * D + col);
#pragma unroll
                for (int ai = 0; ai < 2; ++ai)
#pragma unroll
                    for (int m = 0; m < 4; ++m) { const int rl = ai * 128 + wr * 64 + m * 16 + fr; const float rs = S[rl]; const size_t row = (size_t)(u.pm * 256 + rl);
                        const f32x4 y = acc[ai][bj][m][n] * rs * mul + sh;
                        u32x2 w; w.x = pk2(y[0], y[1]); w.y = pk2(y[2], y[3]); *(u32x2*)(xnp + row * D + col) = w; } }
        __syncthreads();
    }
};
struct EpiFinalNorm {
    static constexpr bool AFTER_DRAIN = true;
    const bf16_t* res_b; float* out; const float* mod; const float* gfin; RowX X;
    __device__ __forceinline__ void fused(f32x4 (&acc)[2][2][4][2], const Unit& u, int wr, int wc, int fr, int fq, LAS unsigned char* lds, int wid, int lane) const {
        const float* mb = mod + (size_t)((u.pm * 256) >> 12) * NMOD;
#pragma unroll
        for (int ai = 0; ai < 2; ++ai) { u32x2 tv[4][2][2];
#pragma unroll
            for (int m = 0; m < 4; ++m)
#pragma unroll
                for (int bj = 0; bj < 2; ++bj)
#pragma unroll
                    for (int n = 0; n < 2; ++n) { const int row = u.pm * 256 + ai * 128 + wr * 64 + m * 16 + fr, col = u.pn * 256 + bj * 128 + wc * 32 + n * 16 + 4 * fq; tv[m][bj][n] = *(const u32x2*)(res_b + (size_t)row * D + col); }
#pragma unroll
            for (int m = 0; m < 4; ++m)
#pragma unroll
                for (int bj = 0; bj < 2; ++bj)
#pragma unroll
                    for (int n = 0; n < 2; ++n) { const int col = u.pn * 256 + bj * 128 + wc * 32 + n * 16 + 4 * fq; const u32x2 t = tv[m][bj][n];
                        const f32x4 gt = 0.5f * *(const f32x4*)(mb + 8 * D + col);
                        acc[ai][bj][m][n] = (f32x4){bflo(t.x), bfhi(t.x), bflo(t.y), bfhi(t.y)} + gt * acc[ai][bj][m][n]; }
        }
        row_rstd_exchange(acc, u, wr, wc, fr, fq, lds, wid, lane, X);
        const LAS float* S = (const LAS float*)(lds + 4096);
#pragma unroll
        for (int bj = 0; bj < 2; ++bj)
#pragma unroll
            for (int n = 0; n < 2; ++n) { const int col = u.pn * 256 + bj * 128 + wc * 32 + n * 16 + 4 * fq;
                const f32x4 gg = *(const f32x4*)(gfin + col);
#pragma unroll
                for (int ai = 0; ai < 2; ++ai)
#pragma unroll
                    for (int m = 0; m < 4; ++m) { const int rl = ai * 128 + wr * 64 + m * 16 + fr; const float rs = S[rl];
                        *(f32x4*)(out + (size_t)(u.pm * 256 + rl) * D + col) = acc[ai][bj][m][n] * rs * gg; } }
    }
};

enum { CV_PLAIN = 0, CV_UPI = 1, CV_RW = 2, CV_LRU = 3 };
__device__ __forceinline__ void cvt_store(const LAS float* scr, int tid, int k0, int n0, bf16_t* dst, int ldd, int mode, int p0, const float* sc) {
    const int nl = tid >> 3, kc = (tid & 7) * 8, n = n0 + nl;
    float s[8];
#pragma unroll
    for (int j = 0; j < 8; ++j) s[j] = scr[(kc + j) * 65 + nl];
    int row = n;
    if (mode == CV_UPI) row = 32 * (n >> 4) + 16 * p0 + (n & 15);
    else if (mode == CV_LRU) { const int dd = p0 >> 3, nb = (p0 >> 1) & 3, which = p0 & 1, c = 256 * nb + n; row = dd * 2048 + (c >> 7) * 256 + ((c & 127) >> 4) * 32 + which * 16 + (c & 15); }
    bf16_t* dp = dst + (size_t)row * ldd + k0 + kc;
    if (mode == CV_RW) { const float mu = sc[n], om = 1.0f - mu;
        u32x4 o; o.x = pk2(s[0] * om, s[1] * om); o.y = pk2(s[2] * om, s[3] * om); o.z = pk2(s[4] * om, s[5] * om); o.w = pk2(s[6] * om, s[7] * om);
        *(u32x4*)dp = o;
        o.x = pk2(s[0] * mu, s[1] * mu); o.y = pk2(s[2] * mu, s[3] * mu); o.z = pk2(s[4] * mu, s[5] * mu); o.w = pk2(s[6] * mu, s[7] * mu);
        *(u32x4*)(dp + 1024) = o;
    } else { u32x4 o; o.x = pk2(s[0], s[1]); o.y = pk2(s[2], s[3]); o.z = pk2(s[4], s[5]); o.w = pk2(s[6], s[7]); *(u32x4*)dp = o; }
}
__device__ __forceinline__ void cvt_run2(const float* src, int lds_, int K, int N, bf16_t* dst, int ldd, int mode, int p0, const float* sc, LAS float* scr, int bid, int nb) {
    const int tid = tidx(), ntn = N >> 6, nt = (K >> 6) * ntn;
    for (int t = bid; t < nt; t += 2 * nb) {
        const int t2 = t + nb; const bool has2 = t2 < nt;
        const int k0 = (t / ntn) << 6, n0 = (t % ntn) << 6, k1 = has2 ? (t2 / ntn) << 6 : k0, n1 = has2 ? (t2 % ntn) << 6 : n0;
        float va[8], vb[8];
#pragma unroll
        for (int j = 0; j < 8; ++j) { const int kk = (tid >> 6) + 8 * j, nn = tid & 63; va[j] = src[(size_t)(k0 + kk) * lds_ + n0 + nn]; vb[j] = src[(size_t)(k1 + kk) * lds_ + n1 + nn]; }
#pragma unroll
        for (int j = 0; j < 8; ++j) { const int kk = (tid >> 6) + 8 * j, nn = tid & 63; scr[kk * 65 + nn] = va[j]; scr[4160 + kk * 65 + nn] = vb[j]; }
        __syncthreads();
        cvt_store(scr, tid, k0, n0, dst, ldd, mode, p0, sc);
        if (has2) cvt_store(scr + 4160, tid, k1, n1, dst, ldd, mode, p0, sc);
        __syncthreads();
    }
}
__device__ __forceinline__ void cvt_run(const float* src, int lds_, int K, int N, bf16_t* dst, int ldd, int mode, int p0, const float* sc, LAS float* scr) {
    cvt_run2(src, lds_, K, N, dst, ldd, mode, p0, sc, scr, blockIdx.x, gridDim.x);
}
__device__ __forceinline__ void zero_fill(unsigned char* p, size_t row_bytes, size_t pitch, int rows) {
    const size_t per = row_bytes / 16, tot = per * rows;
    const int ztid = tidx();
    for (size_t i = (size_t)blockIdx.x * NTHREADS + ztid; i < tot; i += (size_t)gridDim.x * NTHREADS) {
        const size_t r = i / per, c = i % per; *(u32x4*)(p + r * pitch + c * 16) = (u32x4){0u, 0u, 0u, 0u}; }
}

__device__ __forceinline__ void mod_phase(const Params& p, float* mod, LAS float* red) {
    const int tid = tidx(), kq = tid >> 4, cq = tid & 15;
    const float* c = p.in[1]; const float* cc = p.in[3]; const float* wm = p.in[4]; const float* bm = p.in[5];
    for (int it = blockIdx.x; it < NMOD / 64; it += gridDim.x) {
        const int j0 = it * 64 + 4 * cq;
        f32x4 acc[5];
#pragma unroll
        for (int b = 0; b < 5; ++b) acc[b] = (f32x4){0.f, 0.f, 0.f, 0.f};
#pragma unroll 4
        for (int i = 0; i < 32; ++i) { const int k = kq + 32 * i;
            const f32x4 w = *(const f32x4*)(wm + (size_t)k * NMOD + j0);
            acc[0] += silu_f(c[k]) * w; acc[1] += silu_f(c[D + k]) * w; acc[2] += silu_f(c[2 * D + k]) * w; acc[3] += silu_f(c[3 * D + k]) * w; acc[4] += silu_f(cc[k]) * w; }
#pragma unroll
        for (int b = 0; b < 5; ++b)
#pragma unroll
            for (int j = 0; j < 4; ++j) red[(kq * 5 + b) * 64 + 4 * cq + j] = acc[b][j];
        __syncthreads();
        if (tid < 320) { const int b = tid >> 6, cl = tid & 63; float s = 0.f;
            for (int q = 0; q < 32; ++q) s += red[(q * 5 + b) * 64 + cl];
            mod[(size_t)b * NMOD + it * 64 + cl] = s + bm[it * 64 + cl]; }
        __syncthreads();
    }
}

template <bool LATB = false> __device__ __forceinline__ void norm_phase(const float* lat, const float* ctx, int nrows, const float* g, const float* mod, int ish, int isc, bf16_t* dst, int ldd, const float* ctx2 = nullptr, const bf16_t* latb = nullptr, bf16_t* dst2 = nullptr, int mstart = 0) {
    const int tid = tidx(), lane = tid & 63, gw = blockIdx.x * 8 + (tid >> 6), ngw = gridDim.x * 8;
    for (int m0 = mstart + gw; m0 < nrows; m0 += 2 * ngw) {
        const int m1 = m0 + ngw; const bool has1 = m1 < nrows; const int mb = has1 ? m1 : m0;
        const float* srca = m0 < MLAT ? lat + (size_t)m0 * D : ctx + (size_t)(m0 - MLAT) * D;
        const float* srcb = mb < MLAT ? lat + (size_t)mb * D : ctx + (size_t)(mb - MLAT) * D;
        f32x4 va[4], vb[4]; float sa = 0.f, sb = 0.f;
#pragma unroll
        for (int j = 0; j < 4; ++j) {
            if (LATB && m0 < MLAT) { const u32x2 t = *(const u32x2*)(latb + (size_t)m0 * D + 4 * lane + 256 * j); va[j] = (f32x4){bflo(t.x), bfhi(t.x), bflo(t.y), bfhi(t.y)}; } else va[j] = *(const f32x4*)(srca + 4 * lane + 256 * j);
            if (LATB && mb < MLAT) { const u32x2 t = *(const u32x2*)(latb + (size_t)mb * D + 4 * lane + 256 * j); vb[j] = (f32x4){bflo(t.x), bfhi(t.x), bflo(t.y), bfhi(t.y)}; } else vb[j] = *(const f32x4*)(srcb + 4 * lane + 256 * j); }
        if (ctx2) {
            if (m0 >= MLAT) { _Pragma("unroll") for (int j = 0; j < 4; ++j) va[j] += *(const f32x4*)(ctx2 + (size_t)(m0 - MLAT) * D + 4 * lane + 256 * j); }
            if (mb >= MLAT) { _Pragma("unroll") for (int j = 0; j < 4; ++j) vb[j] += *(const f32x4*)(ctx2 + (size_t)(mb - MLAT) * D + 4 * lane + 256 * j); } }
#pragma unroll
        for (int j = 0; j < 4; ++j) { sa += va[j][0] * va[j][0] + va[j][1] * va[j][1] + va[j][2] * va[j][2] + va[j][3] * va[j][3]; sb += vb[j][0] * vb[j][0] + vb[j][1] * vb[j][1] + vb[j][2] * vb[j][2] + vb[j][3] * vb[j][3]; }
#pragma unroll
        for (int o = 1; o < 64; o <<= 1) { sa += __shfl_xor(sa, o); sb += __shfl_xor(sb, o); }
        const float ra = rsqrtf(sa * (1.0f / D) + 1e-6f), rb = rsqrtf(sb * (1.0f / D) + 1e-6f);
        const int ba = m0 < MLAT ? (m0 >> 12) : 4, bb = mb < MLAT ? (mb >> 12) : 4;
        const float* sha = mod + (size_t)ba * NMOD + ish * D; const float* sca = mod + (size_t)ba * NMOD + isc * D;
        const float* shb = mod + (size_t)bb * NMOD + ish * D; const float* scb = mod + (size_t)bb * NMOD + isc * D;
#pragma unroll
        for (int j = 0; j < 4; ++j) { const int c = 4 * lane + 256 * j;
            const f32x4 gg = *(const f32x4*)(g + c);
            { const f32x4 s1 = *(const f32x4*)(sha + c), s2 = *(const f32x4*)(sca + c); const f32x4 y = va[j] * ra * gg * (1.0f + s2) + s1;
              u32x2 o; o.x = pk2(y[0], y[1]); o.y = pk2(y[2], y[3]); *(u32x2*)(dst + (size_t)m0 * ldd + c) = o; if (dst2 && m0 < MLAT) *(u32x2*)(dst2 + (size_t)m0 * D + c) = o; }
            if (has1) { const f32x4 s1 = *(const f32x4*)(shb + c), s2 = *(const f32x4*)(scb + c); const f32x4 y = vb[j] * rb * gg * (1.0f + s2) + s1;
              u32x2 o; o.x = pk2(y[0], y[1]); o.y = pk2(y[2], y[3]); *(u32x2*)(dst + (size_t)m1 * ldd + c) = o; if (dst2 && m1 < MLAT) *(u32x2*)(dst2 + (size_t)m1 * D + c) = o; } }
    }
}
__device__ __forceinline__ void final_norm_phase(float* x, const float* g) {
    const int tid = tidx(), lane = tid & 63, gw = blockIdx.x * 8 + (tid >> 6), ngw = gridDim.x * 8;
    for (int m0 = gw; m0 < MLAT; m0 += 2 * ngw) {
        const int m1 = m0 + ngw; const bool has1 = m1 < MLAT;
        float* sa_ = x + (size_t)m0 * D; float* sb_ = x + (size_t)(has1 ? m1 : m0) * D;
        f32x4 va[4], vb[4]; float sa = 0.f, sb = 0.f;
#pragma unroll
        for (int j = 0; j < 4; ++j) { va[j] = *(const f32x4*)(sa_ + 4 * lane + 256 * j); vb[j] = *(const f32x4*)(sb_ + 4 * lane + 256 * j); }
#pragma unroll
        for (int j = 0; j < 4; ++j) { sa += va[j][0] * va[j][0] + va[j][1] * va[j][1] + va[j][2] * va[j][2] + va[j][3] * va[j][3]; sb += vb[j][0] * vb[j][0] + vb[j][1] * vb[j][1] + vb[j][2] * vb[j][2] + vb[j][3] * vb[j][3]; }
#pragma unroll
        for (int o = 1; o < 64; o <<= 1) { sa += __shfl_xor(sa, o); sb += __shfl_xor(sb, o); }
        const float ra = rsqrtf(sa * (1.0f / D) + 1e-6f), rb = rsqrtf(sb * (1.0f / D) + 1e-6f);
#pragma unroll
        for (int j = 0; j < 4; ++j) { const int c = 4 * lane + 256 * j; const f32x4 gg = *(const f32x4*)(g + c);
            *(f32x4*)(sa_ + c) = va[j] * ra * gg; if (has1) *(f32x4*)(sb_ + c) = vb[j] * rb * gg; }
    }
}
__device__ __forceinline__ void add4(f32x4& a, const bf16_t* p) { const u32x2 t = *(const u32x2*)p; a[0] += bflo(t.x); a[1] += bfhi(t.x); a[2] += bflo(t.y); a[3] += bfhi(t.y); }
__device__ __forceinline__ void xs_phase(bf16_t* xnxs, const bf16_t* xnp, int nrows) {
    const int tid = tidx(), lane = tid & 63, gw = blockIdx.x * 8 + (tid >> 6), ngw = gridDim.x * 8;
    for (int m = gw; m < nrows; m += ngw) {
        int n0, n1, n2, n3; bool v0, v1, v2, v3; float wgt;
        if (m < MLAT) { const int t = m & 4095, gr = t >> 6, gc = t & 63; wgt = 0.25f; v0 = gr > 0; v1 = gr < 63; v2 = gc > 0; v3 = gc < 63; n0 = m - 64; n1 = m + 64; n2 = m - 1; n3 = m + 1; }
        else { const int j = (m - MLAT) & 255; wgt = 0.5f; v0 = false; v1 = false; v2 = j > 0; v3 = j < 255; n0 = m; n1 = m; n2 = m - 1; n3 = m + 1; }
        if (!v0) n0 = m; if (!v1) n1 = m; if (!v2) n2 = m; if (!v3) n3 = m;
        const float w0 = v0 ? wgt : 0.f, w1 = v1 ? wgt : 0.f, w2 = v2 ? wgt : 0.f, w3 = v3 ? wgt : 0.f;
        const bool plain = xnp != nullptr && m < MLAT;
        const bf16_t* sb = plain ? xnp : xnxs; const size_t ld = plain ? (size_t)D : (size_t)2048;
        u32x2 q0[4], q1[4], q2[4], q3[4], qs[4];
#pragma unroll
        for (int j = 0; j < 4; ++j) { const int c = 4 * lane + 256 * j;
            q0[j] = *(const u32x2*)(sb + (size_t)n0 * ld + c); q1[j] = *(const u32x2*)(sb + (size_t)n1 * ld + c);
            q2[j] = *(const u32x2*)(sb + (size_t)n2 * ld + c); q3[j] = *(const u32x2*)(sb + (size_t)n3 * ld + c); qs[j] = *(const u32x2*)(sb + (size_t)m * ld + c); }
#pragma unroll
        for (int j = 0; j < 4; ++j) { const int c = 4 * lane + 256 * j;
            const float a0 = w0 * bflo(q0[j].x) + w1 * bflo(q1[j].x) + w2 * bflo(q2[j].x) + w3 * bflo(q3[j].x);
            const float a1 = w0 * bfhi(q0[j].x) + w1 * bfhi(q1[j].x) + w2 * bfhi(q2[j].x) + w3 * bfhi(q3[j].x);
            const float a2 = w0 * bflo(q0[j].y) + w1 * bflo(q1[j].y) + w2 * bflo(q2[j].y) + w3 * bflo(q3[j].y);
            const float a3 = w0 * bfhi(q0[j].y) + w1 * bfhi(q1[j].y) + w2 * bfhi(q2[j].y) + w3 * bfhi(q3[j].y);
            u32x2 o; o.x = pk2(a0, a1); o.y = pk2(a2, a3);
            *(u32x2*)(xnxs + (size_t)m * 2048 + 1024 + c) = o;
            if (plain) *(u32x2*)(xnxs + (size_t)m * 2048 + c) = qs[j]; }
    }
}
__device__ __forceinline__ void xs_ctx_phase(const float* c1, const float* c2, const float* g, const float* mod, bf16_t* xnxs) {
    const int tid = tidx(), lane = tid & 63, gw = (int)gridDim.x * 8 - 1 - ((int)blockIdx.x * 8 + (tid >> 6)), ngw = gridDim.x * 8;
    const float* sh = mod + (size_t)4 * NMOD + 3 * D; const float* sc = mod + (size_t)4 * NMOD + 4 * D;
    for (int r = gw; r < MCTX; r += ngw) {
        const int j = r & 255; const bool vp = j > 0, vn = j < 255;
        const int rr[3] = {vp ? r - 1 : r, r, vn ? r + 1 : r};
        f32x4 x[3][4];
#pragma unroll
        for (int q = 0; q < 3; ++q)
#pragma unroll
            for (int i = 0; i < 4; ++i) { const size_t off = (size_t)rr[q] * D + 4 * lane + 256 * i; x[q][i] = *(const f32x4*)(c1 + off) + *(const f32x4*)(c2 + off); }
        float ss[3];
#pragma unroll
        for (int q = 0; q < 3; ++q) { float t = 0.f;
#pragma unroll
            for (int i = 0; i < 4; ++i) t += (x[q][i][0] * x[q][i][0] + x[q][i][1] * x[q][i][1]) + (x[q][i][2] * x[q][i][2] + x[q][i][3] * x[q][i][3]);
            ss[q] = t; }
#pragma unroll
        for (int o = 1; o < 64; o <<= 1) { ss[0] += __shfl_xor(ss[0], o); ss[1] += __shfl_xor(ss[1], o); ss[2] += __shfl_xor(ss[2], o); }
        const float r0 = rsqrtf(ss[0] * (1.0f / D) + 1e-6f) * (vp ? 0.5f : 0.f), r1 = rsqrtf(ss[1] * (1.0f / D) + 1e-6f), r2 = rsqrtf(ss[2] * (1.0f / D) + 1e-6f) * (vn ? 0.5f : 0.f);
        const float wsh = (vp ? 0.5f : 0.f) + (vn ? 0.5f : 0.f);
#pragma unroll
        for (int i = 0; i < 4; ++i) { const int c = 4 * lane + 256 * i;
            const f32x4 mul = *(const f32x4*)(g + c) * (1.0f + *(const f32x4*)(sc + c)), s0 = *(const f32x4*)(sh + c);
            const f32x4 xn = x[1][i] * r1 * mul + s0;
            const f32x4 xs = (x[0][i] * r0 + x[2][i] * r2) * mul + wsh * s0;
            u32x2 o; o.x = pk2(xn[0], xn[1]); o.y = pk2(xn[2], xn[3]); *(u32x2*)(xnxs + (size_t)(MLAT + r) * 2048 + c) = o;
            o.x = pk2(xs[0], xs[1]); o.y = pk2(xs[2], xs[3]); *(u32x2*)(xnxs + (size_t)(MLAT + r) * 2048 + 1024 + c) = o; }
    }
}
__device__ __forceinline__ void conv_phase(const bf16_t* plx, const bf16_t* plxc, bf16_t* xc, const float* cw, const float* cb) {
    const int tid = tidx(), lane = tid & 63, gw = blockIdx.x * 8 + (tid >> 6), ngw = gridDim.x * 8;
    for (int m = gw; m < MALL; m += ngw) {
        int t, len; if (m < MLAT) { t = m & 4095; len = 4096; } else { t = (m - MLAT) & 255; len = 256; }
        const bf16_t* pb = m < MLAT ? plx : plxc - (size_t)MLAT * D;
        int rq[4]; float wq[4];
#pragma unroll
        for (int q = 0; q < 4; ++q) { const int tt = t + q - 1; const bool ok = tt >= 0 && tt < len; rq[q] = ok ? m + q - 1 : m; wq[q] = ok ? 1.f : 0.f; }
        u32x2 x[4][4];
#pragma unroll
        for (int q = 0; q < 4; ++q)
#pragma unroll
            for (int j = 0; j < 4; ++j) x[q][j] = *(const u32x2*)(pb + (size_t)rq[q] * D + 4 * lane + 256 * j);
#pragma unroll
        for (int j = 0; j < 4; ++j) { const int c = 4 * lane + 256 * j; f32x4 a = *(const f32x4*)(cb + c);
#pragma unroll
            for (int q = 0; q < 4; ++q) { const f32x4 w = *(const f32x4*)(cw + q * D + c) * wq[q];
                a[0] += w[0] * bflo(x[q][j].x); a[1] += w[1] * bfhi(x[q][j].x); a[2] += w[2] * bflo(x[q][j].y); a[3] += w[3] * bfhi(x[q][j].y); }
            u32x2 o; o.x = pk2(a[0], a[1]); o.y = pk2(a[2], a[3]);
            *(u32x2*)(xc + (size_t)m * D + c) = o; }
    }
}
__device__ __forceinline__ void rncb_phase(const bf16_t* R, const bf16_t* Kk, const float* k_k, const float* r_k, float* rn, float* cbv) {
    const int tid = tidx(), g16 = (blockIdx.x * NTHREADS + tid) >> 4, ng = (gridDim.x * NTHREADS) >> 4, l = tid & 15;
    for (int it0 = g16; it0 < MALL * 16; it0 += 4 * ng) {
        u32x2 kv[4], rv[4];
#pragma unroll
        for (int u = 0; u < 4; ++u) { const int it = it0 + u * ng; kv[u] = (u32x2){0u, 0u}; rv[u] = (u32x2){0u, 0u};
            if (it < MALL * 16) { const size_t off = (size_t)(it >> 4) * D + (it & 15) * 64 + 4 * l; kv[u] = *(const u32x2*)(Kk + off); rv[u] = *(const u32x2*)(R + off); } }
#pragma unroll
        for (int u = 0; u < 4; ++u) { const int it = it0 + u * ng;
            if (it < MALL * 16) { const int c = (it & 15) * 64 + 4 * l;
                const f32x4 kk = *(const f32x4*)(k_k + c), rk = *(const f32x4*)(r_k + c);
                const float k0 = bflo(kv[u].x), k1 = bfhi(kv[u].x), k2 = bflo(kv[u].y), k3 = bfhi(kv[u].y);
                float s1 = k0 * kk[0] * k0 * kk[0] + k1 * kk[1] * k1 * kk[1] + k2 * kk[2] * k2 * kk[2] + k3 * kk[3] * k3 * kk[3];
                float s2 = bflo(rv[u].x) * k0 * rk[0] + bfhi(rv[u].x) * k1 * rk[1] + bflo(rv[u].y) * k2 * rk[2] + bfhi(rv[u].y) * k3 * rk[3];
                s1 = red16(s1); s2 = red16(s2);
                if (l == 0) { rn[it] = __builtin_amdgcn_rsqf(fmaxf(s1, 1e-24f)); cbv[it] = s2; } } }
    }
}
__device__ __forceinline__ void post_phase(bf16_t* YF, const bf16_t* YB, const bf16_t* V, const float* cbv, const float* lnw, const float* lnb) {
    const int tid = tidx(), g16 = (blockIdx.x * NTHREADS + tid) >> 4, ng = (gridDim.x * NTHREADS) >> 4, l = tid & 15;
    for (int it0 = g16; it0 < MLAT * 16; it0 += 4 * ng) {
        u32x2 av[4], bv[4], vv[4]; float cbs[4];
#pragma unroll
        for (int u = 0; u < 4; ++u) { const int it = it0 + u * ng; av[u] = (u32x2){0u, 0u}; bv[u] = av[u]; vv[u] = av[u]; cbs[u] = 0.f;
            if (it < MLAT * 16) { const size_t off = (size_t)(it >> 4) * D + (it & 15) * 64 + 4 * l; av[u] = *(const u32x2*)(YF + off); bv[u] = *(const u32x2*)(YB + off); vv[u] = *(const u32x2*)(V + off); cbs[u] = cbv[it]; } }
#pragma unroll
        for (int u = 0; u < 4; ++u) { const int it = it0 + u * ng;
            if (it < MLAT * 16) { const int c = (it & 15) * 64 + 4 * l; const size_t off = (size_t)(it >> 4) * D + c;
                float y[4] = {bflo(av[u].x) + bflo(bv[u].x), bfhi(av[u].x) + bfhi(bv[u].x), bflo(av[u].y) + bflo(bv[u].y), bfhi(av[u].y) + bfhi(bv[u].y)};
                const float mu = red16(y[0] + y[1] + y[2] + y[3]) * (1.0f / 64.0f);
                float q = 0.f;
#pragma unroll
                for (int j = 0; j < 4; ++j) { y[j] -= mu; q += y[j] * y[j]; }
                const float rs = rsqrtf(red16(q) * (1.0f / 64.0f) + 64e-5f);
                const f32x4 w = *(const f32x4*)(lnw + c), bb = *(const f32x4*)(lnb + c);
                const float v4[4] = {bflo(vv[u].x), bfhi(vv[u].x), bflo(vv[u].y), bfhi(vv[u].y)};
                float o[4];
#pragma unroll
                for (int j = 0; j < 4; ++j) o[j] = y[j] * rs * w[j] + bb[j] + cbs[u] * v4[j];
                u32x2 ov; ov.x = pk2(o[0], o[1]); ov.y = pk2(o[2], o[3]);
                *(u32x2*)(YF + off) = ov; } }
    }
}

constexpr int RS_STRIDE = 324;
constexpr int RS_BUF = 32 * RS_STRIDE + 1024 + 4096;
__device__ __forceinline__ int scan_row(int b, int dir, int s) {
    if (s < 256) return MLAT + b * 256 + (dir ? 255 - s : s);
    return b * 4096 + (dir ? 4095 - (s - 256) : (s - 256));
}
struct ScanIn { bf16x8 afr[2][2]; unsigned short xv[8]; float rnv[8]; unsigned vpair; };
__device__ __forceinline__ void rwkv_scan_phase(const Params& p, LAS float* lds) {
    unsigned char* ws = p.ws;
    const bf16_t* R = (const bf16_t*)(ws + O_R); const bf16_t* Kk = (const bf16_t*)(ws + O_K); const bf16_t* V = (const bf16_t*)(ws + O_V);
    const bf16_t* LIN = (const bf16_t*)(ws + O_LIN); const float* rn = (const float*)(ws + O_RN);
    const int tid = tidx(), lane = tid & 63, w = __builtin_amdgcn_readfirstlane(tid >> 6), fr = lane & 15, fq = lane >> 4;
    const int cgp = lane & 15, rw = lane >> 4;
    for (int unit = blockIdx.x; unit < 256; unit += gridDim.x) {
        const int xcd = unit & 7, slot = unit >> 3, half = slot & 1, chain = (slot >> 1) * 8 + xcd, dir = chain & 1, h = (chain >> 1) & 15, b = chain >> 5;
        bf16_t* Y = (bf16_t*)(ws + (dir ? O_YB : O_YF));
        const int lora = w >> 2, ct = w & 3, col = h * 64 + 16 * ct + fr;
        bf16x8 bfr[2];
        { const bf16_t* wt = (const bf16_t*)(ws + (lora ? O_LSCA : O_LSCW)) + (size_t)(dir * 1024 + col) * 64 + 8 * fq;
          bfr[0] = *(const bf16x8*)(wt); bfr[1] = *(const bf16x8*)(wt + 32); }
        const float c_bias = lora ? p.in[15][dir * D + col] : p.in[13][dir * D + col];
        const float c_kk = p.in[18][col], c_ka = p.in[19][col];
        const int lcol0 = (lora ? 128 : 0) + dir * 64;
        const int sgn = dir ? -1 : 1;
        f32x2 SA = (f32x2){0.f, 0.f}, SB = (f32x2){0.f, 0.f};
        ScanIn in;
#define SCAN_LOAD(c) do { const int m0 = scan_row(b, dir, 32 * (c)); \
            _Pragma("unroll") for (int tt = 0; tt < 2; ++tt) { const size_t mr = (size_t)(m0 + sgn * (16 * tt + fr)); \
                _Pragma("unroll") for (int ks = 0; ks < 2; ++ks) in.afr[tt][ks] = *(const bf16x8*)(LIN + mr * 256 + lcol0 + 32 * ks + 8 * fq); } \
            _Pragma("unroll") for (int tt = 0; tt < 2; ++tt) _Pragma("unroll") for (int j = 0; j < 4; ++j) { const size_t mr = (size_t)(m0 + sgn * (16 * tt + 4 * fq + j)); \
                in.xv[tt * 4 + j] = (lora ? Kk : R)[mr * D + col]; in.rnv[tt * 4 + j] = rn[mr * 16 + h]; } \
            { const size_t mr = (size_t)(m0 + sgn * (tid >> 4)); in.vpair = *(const unsigned*)(V + mr * D + h * 64 + half * 32 + 2 * (tid & 15)); } } while (0)
#define SCAN_PRODUCE(bufi) do { LAS float* sb = lds + (bufi) * RS_BUF; \
            _Pragma("unroll") for (int tt = 0; tt < 2; ++tt) { f32x4 acc = (f32x4){0.f, 0.f, 0.f, 0.f}; \
                acc = __builtin_amdgcn_mfma_f32_16x16x32_bf16(in.afr[tt][0], bfr[0], acc, 0, 0, 0); acc = __builtin_amdgcn_mfma_f32_16x16x32_bf16(in.afr[tt][1], bfr[1], acc, 0, 0, 0); \
                _Pragma("unroll") for (int j = 0; j < 4; ++j) { LAS float* rec = sb + (16 * tt + 4 * fq + j) * RS_STRIDE + 16 * ct + fr; const float x = bf2f(in.xv[tt * 4 + j]); \
                    if (lora == 0) { rec[0] = __expf(-0.60653066f * sigm(c_bias + acc[j])); rec[256] = x; } \
                    else { const float a = sigm(c_bias + acc[j]), kkv = x * c_kk * in.rnv[tt * 4 + j]; rec[64] = x * (1.0f + (a - 1.0f) * c_ka); rec[128] = -kkv; rec[192] = kkv * a; } } } \
            { LAS float* vb = sb + 32 * RS_STRIDE + (tid >> 4) * 32 + 2 * (tid & 15); vb[0] = bflo(in.vpair); vb[1] = bfhi(in.vpair); } } while (0)
#define SCAN_YOUT(c, bufi) do { if ((c) >= 8) { const LAS float* yb_ = lds + (bufi) * RS_BUF + 32 * RS_STRIDE + 1024 + ((tid >> 4) * 32 + 2 * (tid & 15)) * 4; \
            const f32x4 ya = *(const LAS f32x4*)(yb_), yc = *(const LAS f32x4*)(yb_ + 4); \
            const size_t mr = (size_t)(scan_row(b, dir, 32 * (c)) + sgn * (tid >> 4)); \
            *(unsigned*)(Y + mr * D + h * 64 + half * 32 + 2 * (tid & 15)) = pk2((ya[0] + ya[1]) + (ya[2] + ya[3]), (yc[0] + yc[1]) + (yc[2] + yc[3])); } } while (0)
        SCAN_LOAD(0);
        SCAN_PRODUCE(0);
        __syncthreads();
        for (int c = 0; c < 136; ++c) {
            const int cur = c & 1;
            if (c + 1 < 136) SCAN_LOAD(c + 1);
            if (c > 0 && w >= 4) SCAN_YOUT(c - 1, cur ^ 1);
            const LAS float* sp0 = lds + cur * RS_BUF + 4 * cgp;
            const LAS float* vb = lds + cur * RS_BUF + 32 * RS_STRIDE + w * 4 + rw;
            LAS float* yb = lds + cur * RS_BUF + 32 * RS_STRIDE + 1024 + (w * 4 + rw) * 4 + (cgp >> 2);
            f32x4 w4 = *(const LAS f32x4*)(sp0), kd4 = *(const LAS f32x4*)(sp0 + 64), ka4 = *(const LAS f32x4*)(sp0 + 192), r4 = *(const LAS f32x4*)(sp0 + 256);
            f32x4 nk1 = *(const LAS f32x4*)(sp0 + RS_STRIDE + 128);
            float vv = vb[0];
            float sa;
            { const f32x4 nk0 = *(const LAS f32x4*)(sp0 + 128); const f32x2 q = SA * (f32x2){nk0[0], nk0[1]} + SB * (f32x2){nk0[2], nk0[3]}; sa = red16(q[0] + q[1]); }
#define SCAN_STEPS(i0, cnt, YON) _Pragma("unroll") for (int ii = 0; ii < (cnt); ++ii) { const int i = (i0) + ii; \
                f32x4 w4n = w4, kd4n = kd4, ka4n = ka4, r4n = r4, nk2 = nk1; float vvn = vv; \
                if (i + 1 < 32) { const LAS float* spn = sp0 + (i + 1) * RS_STRIDE; \
                    w4n = *(const LAS f32x4*)(spn); kd4n = *(const LAS f32x4*)(spn + 64); ka4n = *(const LAS f32x4*)(spn + 192); r4n = *(const LAS f32x4*)(spn + 256); vvn = vb[(i + 1) * 32]; } \
                if (i + 2 < 32) nk2 = *(const LAS f32x4*)(sp0 + (i + 2) * RS_STRIDE + 128); \
                { const f32x2 ta = sa * (f32x2){ka4[0], ka4[1]} + vv * (f32x2){kd4[0], kd4[1]}, tb = sa * (f32x2){ka4[2], ka4[3]} + vv * (f32x2){kd4[2], kd4[3]}; \
                  SA = SA * (f32x2){w4[0], w4[1]} + ta; SB = SB * (f32x2){w4[2], w4[3]} + tb; } \
                float sn = 0.f; \
                if (i + 1 < 32) { const f32x2 ps = SA * (f32x2){nk1[0], nk1[1]} + SB * (f32x2){nk1[2], nk1[3]}; sn = ps[0] + ps[1]; } \
                if (YON) { const f32x2 py = SA * (f32x2){r4[0], r4[1]} + SB * (f32x2){r4[2], r4[3]}; float yp = py[0] + py[1]; \
                    sn += dppf<0xB1>(sn); yp += dppf<0xB1>(yp); sn += dppf<0x4E>(sn); yp += dppf<0x4E>(yp); sn += dppf<0x141>(sn); sn += dppf<0x140>(sn); \
                    if ((cgp & 3) == 0) yb[i * 128] = yp; } \
                else { sn += dppf<0xB1>(sn); sn += dppf<0x4E>(sn); sn += dppf<0x141>(sn); sn += dppf<0x140>(sn); }     \
                sa = sn; w4 = w4n; kd4 = kd4n; ka4 = ka4n; r4 = r4n; vv = vvn; nk1 = nk2; }
            __builtin_amdgcn_s_setprio(2);
#define SCAN_CHUNK(YON) \
            SCAN_STEPS(0, 8, YON) \
            if (c + 1 < 136 && w < 4) { __builtin_amdgcn_s_setprio(0); SCAN_PRODUCE(cur ^ 1); __builtin_amdgcn_s_setprio(2); }     \
            SCAN_STEPS(8, 8, YON) \
            if (c > 0 && w < 4) SCAN_YOUT(c - 1, cur ^ 1); \
            SCAN_STEPS(16, 8, YON) \
            if (c + 1 < 136 && w >= 4) { __builtin_amdgcn_s_setprio(0); SCAN_PRODUCE(cur ^ 1); __builtin_amdgcn_s_setprio(2); } \
            SCAN_STEPS(24, 8, YON)
            if (c < 8) { SCAN_CHUNK(false) } else { SCAN_CHUNK(true) }
#undef SCAN_CHUNK
            __builtin_amdgcn_s_setprio(0);
#undef SCAN_STEPS
            __syncthreads();
        }
        SCAN_YOUT(135, 1);
        __syncthreads();
#undef SCAN_LOAD
#undef SCAN_PRODUCE
#undef SCAN_YOUT
    }
}

__device__ __forceinline__ void lru_p1_phase(const Params& p) {
    unsigned char* ws = p.ws; const float* lam = (const float*)(ws + O_CL);
    float* PQ = (float*)(ws + O_PQ);
    const int tid = tidx(), lane = tid & 63, half = lane >> 5, l32 = lane & 31, gw = blockIdx.x * 8 + (tid >> 6), ngw = gridDim.x * 8;
    for (int it = gw; it < 2 * 4 * 68 * 16; it += ngw) {
        const int cb16 = it & 15, j = (it >> 4) % 68, b = ((it >> 4) / 68) & 3, d = (it >> 4) / 272;
        const int c = cb16 * 64 + 2 * l32;
        const bf16_t* GR = (const bf16_t*)(ws + (d ? O_GRB : O_GRF)); const bf16_t* UU = (const bf16_t*)(ws + (d ? O_UB : O_UF));
        const float cl0 = lam[d * D + c], cl1 = lam[d * D + c + 1];
        float P0 = 1.f, P1 = 1.f, Q0 = 0.f, Q1 = 0.f;
        const int sgn = d ? -1 : 1, m0 = scan_row(b, d, 64 * j) + sgn * 32 * half;
#pragma unroll 8
        for (int i = 0; i < 32; ++i) { const size_t off = (size_t)(m0 + sgn * i) * D + c;
            const unsigned g = *(const unsigned*)(GR + off), uv = *(const unsigned*)(UU + off);
            const float a0 = __expf(bflo(g) * cl0), a1 = __expf(bfhi(g) * cl1);
            P0 *= a0; P1 *= a1; Q0 = a0 * Q0 + bflo(uv); Q1 = a1 * Q1 + bfhi(uv); }
        const float oP0 = __shfl_xor(P0, 32), oP1 = __shfl_xor(P1, 32), oQ0 = __shfl_xor(Q0, 32), oQ1 = __shfl_xor(Q1, 32);
        if (half == 0) { const size_t o = ((size_t)((d * 4 + b) * 68 + j)) * D + c;
            *(f32x2*)(PQ + o) = (f32x2){P0 * oP0, P1 * oP1}; *(f32x2*)(PQ + (size_t)2 * 4 * 68 * D + o) = (f32x2){oP0 * Q0 + oQ0, oP1 * Q1 + oQ1}; }
    }
}
__device__ __forceinline__ void lru_p3_phase(const Params& p) {
    unsigned char* ws = p.ws; const float* lam = (const float*)(ws + O_CL);
    const float* PQ = (const float*)(ws + O_PQ); const float* QQ = PQ + (size_t)2 * 4 * 68 * D;
    bf16_t* HS = (bf16_t*)(ws + O_HSUM);
    const int tid = tidx(), lane = tid & 63, gw = blockIdx.x * 8 + (tid >> 6), ngw = gridDim.x * 8;
    for (int it = gw; it < 4 * 64 * 8; it += ngw) {
        const int cb8 = it & 7, T = (it >> 3) & 63, b = it >> 9, c = cb8 * 128 + 2 * lane;
        {
            const bf16_t* GR = (const bf16_t*)(ws + O_GRF); const bf16_t* UU = (const bf16_t*)(ws + O_UF);
            const float cl0 = lam[c], cl1 = lam[c + 1];
            float h0 = 0.f, h1 = 0.f;
#pragma unroll 8
            for (int jj = 0; jj < 4 + T; ++jj) { const size_t o = ((size_t)(b * 68 + jj)) * D + c; const f32x2 P = *(const f32x2*)(PQ + o), Q = *(const f32x2*)(QQ + o); h0 = P[0] * h0 + Q[0]; h1 = P[1] * h1 + Q[1]; }
            for (int i0 = 0; i0 < 64; i0 += 8) {
                unsigned g[8], uv[8];
#pragma unroll
                for (int i = 0; i < 8; ++i) { const size_t off = (size_t)(b * 4096 + 64 * T + i0 + i) * D + c; g[i] = *(const unsigned*)(GR + off); uv[i] = *(const unsigned*)(UU + off); }
#pragma unroll
                for (int i = 0; i < 8; ++i) { const size_t off = (size_t)(b * 4096 + 64 * T + i0 + i) * D + c;
                    h0 = __expf(bflo(g[i]) * cl0) * h0 + bflo(uv[i]); h1 = __expf(bfhi(g[i]) * cl1) * h1 + bfhi(uv[i]);
                    *(unsigned*)(HS + off) = pk2(h0, h1); }
            }
        }
        {
            const bf16_t* GR = (const bf16_t*)(ws + O_GRB); const bf16_t* UU = (const bf16_t*)(ws + O_UB);
            const float cl0 = lam[D + c], cl1 = lam[D + c + 1];
            float h0 = 0.f, h1 = 0.f;
#pragma unroll 8
            for (int jj = 0; jj < 67 - T; ++jj) { const size_t o = ((size_t)((4 + b) * 68 + jj)) * D + c; const f32x2 P = *(const f32x2*)(PQ + o), Q = *(const f32x2*)(QQ + o); h0 = P[0] * h0 + Q[0]; h1 = P[1] * h1 + Q[1]; }
            for (int i0 = 0; i0 < 64; i0 += 8) {
                unsigned g[8], uv[8], f[8];
#pragma unroll
                for (int i = 0; i < 8; ++i) { const size_t off = (size_t)(b * 4096 + 64 * T + 63 - i0 - i) * D + c; g[i] = *(const unsigned*)(GR + off); uv[i] = *(const unsigned*)(UU + off); f[i] = *(const unsigned*)(HS + off); }
#pragma unroll
                for (int i = 0; i < 8; ++i) { const size_t off = (size_t)(b * 4096 + 64 * T + 63 - i0 - i) * D + c;
                    h0 = __expf(bflo(g[i]) * cl0) * h0 + bflo(uv[i]); h1 = __expf(bfhi(g[i]) * cl1) * h1 + bfhi(uv[i]);
                    *(unsigned*)(HS + off) = pk2(bflo(f[i]) + h0, bfhi(f[i]) + h1); }
            }
        }
    }
}

#define XB_XCNT(j) (64 * (j))
#define XB_XSUB(j) (1024 + 64 * (j))
#define XB_XGEN(j) (2048 + 64 * (j))
#define XB_TOP 3072
#define XB_TOPGEN 3136
#define XB_WORDS 3200
__device__ __forceinline__ unsigned xb_ld(unsigned* p) { return __hip_atomic_load(p, __ATOMIC_RELAXED, __HIP_MEMORY_SCOPE_AGENT); }
__device__ __forceinline__ unsigned xb_add(unsigned* p, unsigned v) { return __hip_atomic_fetch_add(p, v, __ATOMIC_RELAXED, __HIP_MEMORY_SCOPE_AGENT); }
__device__ __forceinline__ void xb_st(unsigned* p, unsigned v) { __hip_atomic_store(p, v, __ATOMIC_RELAXED, __HIP_MEMORY_SCOPE_AGENT); }
struct XBar { unsigned* bar; unsigned x, nloc, nx, k; };
__device__ __forceinline__ void xbar_init(XBar& B, unsigned* bar) {
    B.bar = bar; B.x = (unsigned)__builtin_amdgcn_s_getreg((3 << 11) | 20) & 0xFu; B.nloc = 0u; B.nx = 0u; B.k = 0u;
    if (threadIdx.x == 0) (void)xb_add(&bar[XB_XCNT(B.x)], 1u);
}
__device__ __forceinline__ void gbar(XBar& B) {
    asm volatile("s_waitcnt vmcnt(0)" ::: "memory");
    __syncthreads();
    B.k += 1u;
    if (threadIdx.x == 0) {
        unsigned* bar = B.bar;
        if (B.nloc == 0u) {
            unsigned sum, cnt, mine;
            for (;;) { sum = 0u; cnt = 0u; mine = 0u;
#pragma unroll
                for (unsigned j = 0; j < 16; ++j) { const unsigned c = xb_ld(&bar[XB_XCNT(j)]); sum += c; cnt += (c > 0u) ? 1u : 0u; mine = (j == B.x) ? c : mine; }
                if (sum == gridDim.x) break;
                __builtin_amdgcn_s_sleep(1); }
            B.nloc = mine; B.nx = cnt;
        }
        const unsigned old = xb_add(&bar[XB_XSUB(B.x)], 1u);
        if (old + 1u == B.k * B.nloc) {
            __builtin_amdgcn_fence(__ATOMIC_RELEASE, "agent");
            asm volatile("s_waitcnt vmcnt(0)" ::: "memory");
            const unsigned t = xb_add(&bar[XB_TOP], 1u);
            if (t + 1u == B.k * B.nx) xb_st(&bar[XB_TOPGEN], B.k);
            else while (xb_ld(&bar[XB_TOPGEN]) < B.k) __builtin_amdgcn_s_sleep(1);
        } else {
            while (xb_ld(&bar[XB_TOPGEN]) < B.k) __builtin_amdgcn_s_sleep(1);
        }
        __builtin_amdgcn_fence(__ATOMIC_ACQUIRE, "agent");
        asm volatile("s_waitcnt vmcnt(0)" ::: "memory");
    }
    __syncthreads();
}

__device__ __forceinline__ Gemm mk_gemm(const void* A, const void* Bt, int M, int N, int K, int lda, int ldb) { Gemm g; g.A = (const bf16_t*)A; g.Bt = (const bf16_t*)Bt; g.M = M; g.N = N; g.K = K; g.lda = lda; g.ldb = ldb; g.ksh = 0; g.kmask = 0; g.kmul = 0; return g; }

__global__ void __launch_bounds__(NTHREADS, 2) mega(Params p) {
    extern __shared__ __attribute__((aligned(16))) unsigned char shm[];
    LAS unsigned char* lds = (LAS unsigned char*)shm;
    LAS float* ldsf = (LAS float*)shm;
    cg::grid_group grid = cg::this_grid();
    unsigned char* ws = p.ws;
    float* mod = (float*)(ws + O_MOD);
    bf16_t* X1B = (bf16_t*)p.out;
    bf16_t* XNP = (bf16_t*)p.out + (size_t)MLAT * D;
    pg8::StaticOrder S;
    XBar XB; xbar_init(XB, (unsigned*)(ws + O_BAR));
#define BF(off) ((bf16_t*)(ws + (off)))
#define GSYNC() gbar(XB)
    if (p.ws == nullptr) grid.sync();
    cvt_run(p.in[7], DFF, D, DFF, BF(O_UP1), D, CV_UPI, 0, nullptr, ldsf);
    cvt_run(p.in[8], DFF, D, DFF, BF(O_UP1), D, CV_UPI, 1, nullptr, ldsf);
    cvt_run(p.in[9], D, DFF, D, BF(O_DN1), DFF, CV_PLAIN, 0, nullptr, ldsf);
    mod_phase(p, mod, ldsf);
    GSYNC();
    norm_phase(p.in[0], p.in[2], MALL, p.in[6], mod, 0, 1, BF(O_HN), D);
    GSYNC();
    { S.init(MALL, 2 * DFF, gridDim.x, blockIdx.x); EpiUp E{BF(O_U)}; pg8::gemm_phase(lds, mk_gemm(BF(O_HN), BF(O_UP1), MALL, 2 * DFF, D, D, D), S, E); }
    GSYNC();
    const bool fuse_ok = gridDim.x == 256;
    if (fuse_ok) { S.init(MLAT, D, gridDim.x, blockIdx.x); EpiDn1Norm E{p.in[0], X1B, BF(O_XNXS), XNP, mod, p.in[10], RowX{(unsigned*)(ws + O_XSLOT_C), (unsigned*)(ws + O_XCNT_C)}};
        pg8::gemm_phase(lds, mk_gemm(BF(O_U), BF(O_DN1), MLAT, D, DFF, DFF, DFF), S, E); }
    else { S.init(MLAT, D, gridDim.x, blockIdx.x); EpiRes<false, true> E{p.in[0], nullptr, nullptr, X1B, mod, 2, 0.5f}; pg8::gemm_phase(lds, mk_gemm(BF(O_U), BF(O_DN1), MLAT, D, DFF, DFF, DFF), S, E); }
    { const float* gate = mod + (size_t)4 * NMOD + 2 * D; const bf16_t* Uc = BF(O_U) + (size_t)MLAT * DFF;
      { S.init(MCTX, D, gridDim.x, blockIdx.x); EpiCtx E{p.in[2], (float*)(ws + O_CTXX1), gate, 0.5f}; pg8::gemm_phase(lds, mk_gemm(Uc, BF(O_DN1), MCTX, D, DFF / 2, DFF, DFF), S, E); }
      { S.init(MCTX, D, gridDim.x, ((int)blockIdx.x + (int)gridDim.x - 16) % (int)gridDim.x); EpiCtx E{nullptr, (float*)(ws + O_CTXP2), gate, 0.5f}; pg8::gemm_phase(lds, mk_gemm(Uc + DFF / 2, BF(O_DN1) + DFF / 2, MCTX, D, DFF / 2, DFF, DFF), S, E); } }
    { const int cnb = gridDim.x > 64 ? (int)gridDim.x - 32 : (int)gridDim.x, cbid = gridDim.x > 64 ? (int)blockIdx.x - 32 : (int)blockIdx.x;
      if (cbid >= 0) {
        cvt_run2(p.in[11], 7552, D, 3456, BF(O_RW), 2048, CV_RW, 0, p.in[12], ldsf, cbid, cnb);
        for (int d = 0; d < 2; ++d) { cvt_run2(p.in[14] + (size_t)d * 64 * D, D, 64, D, BF(O_LSCW) + (size_t)d * D * 64, 64, CV_PLAIN, 0, nullptr, ldsf, cbid, cnb);
                                      cvt_run2(p.in[16] + (size_t)d * 64 * D, D, 64, D, BF(O_LSCA) + (size_t)d * D * 64, 64, CV_PLAIN, 0, nullptr, ldsf, cbid, cnb); }
        cvt_run2(p.in[17], D, 128, D, BF(O_GUP), 256, CV_PLAIN, 0, nullptr, ldsf, cbid, cnb);
        cvt_run2(p.in[11] + 3456, 7552, D, D, BF(O_LX), D, CV_PLAIN, 0, nullptr, ldsf, cbid, cnb);
        for (int q = 0; q < 8; ++q) { cvt_run2(p.in[27] + (size_t)q * 65536, 256, 256, 256, BF(O_LRUW), 256, CV_LRU, q * 2 + 0, nullptr, ldsf, cbid, cnb);
                                      cvt_run2(p.in[29] + (size_t)q * 65536, 256, 256, 256, BF(O_LRUW), 256, CV_LRU, q * 2 + 1, nullptr, ldsf, cbid, cnb); }
      } }
    zero_fill(ws + O_RW + (size_t)3456 * 2048 * 2, 128 * 2048 * 2, 128 * 2048 * 2, 1);
    zero_fill(ws + O_GUP + 256, 256, 512, 1024);
    { const int t = tidx(); if (blockIdx.x == 20) for (int i = t; i < 2 * D; i += NTHREADS) ((float*)(ws + O_CL))[i] = -8.0f * log1pf(expf(-p.in[26][i])); }
    GSYNC();
    if (fuse_ok) {
        xs_phase(BF(O_XNXS), XNP, MLAT);
        xs_ctx_phase((const float*)(ws + O_CTXX1), (const float*)(ws + O_CTXP2), p.in[10], mod, BF(O_XNXS));
    } else {
        norm_phase<true>(p.in[0], (const float*)(ws + O_CTXX1), MALL, p.in[10], mod, 3, 4, BF(O_XNXS), 2048, (const float*)(ws + O_CTXP2), X1B, XNP, 0);
        GSYNC();
        xs_phase(BF(O_XNXS), nullptr, MALL);
    }
    GSYNC();
    { S.init(MALL, 3584, gridDim.x, blockIdx.x); EpiRw E{BF(O_R), BF(O_LIN), BF(O_GD)}; pg8::gemm_phase(lds, mk_gemm(BF(O_XNXS), BF(O_RW), MALL, 3584, 2048, 2048, 2048), S, E); }
    { const int sh = ((MALL / 256) * 14) % (int)gridDim.x; S.init(MCTX, D, gridDim.x, ((int)blockIdx.x + (int)gridDim.x - sh) % (int)gridDim.x); EpiBf E{BF(O_PLXC), D};
      pg8::gemm_phase(lds, mk_gemm(BF(O_XNXS) + (size_t)MLAT * 2048, BF(O_LX), MCTX, D, D, 2048, D), S, E); }
    GSYNC();
    rncb_phase(BF(O_R), BF(O_K), p.in[18], p.in[20], (float*)(ws + O_RN), (float*)(ws + O_CB));
    cvt_run(p.in[11] + 4480, 7552, D, 3072, BF(O_LATE), D, CV_PLAIN, 0, nullptr, ldsf);
    cvt_run(p.in[23], D, D, D, BF(O_PRW), D, CV_PLAIN, 0, nullptr, ldsf);
    cvt_run(p.in[31], D, D, D, BF(O_PLRU), D, CV_PLAIN, 0, nullptr, ldsf);
    cvt_run(p.in[32], D, D, D, BF(O_WOUT), D, CV_PLAIN, 0, nullptr, ldsf);
    cvt_run(p.in[36], D, DFF, D, BF(O_DN2), DFF, CV_PLAIN, 0, nullptr, ldsf);
    GSYNC();
    rwkv_scan_phase(p, ldsf);
    GSYNC();
    if (gridDim.x == 256) {
        S.init(MLAT, D, gridDim.x, blockIdx.x); EpiPostG E{BF(O_YF), BF(O_YB), BF(O_V), (const float*)(ws + O_CB), p.in[21], p.in[22]};
        pg8::gemm_phase(lds, mk_gemm(BF(O_GD), BF(O_GUP), MLAT, D, 256, 256, 256), S, E);
    } else {
        post_phase(BF(O_YF), BF(O_YB), BF(O_V), (const float*)(ws + O_CB), p.in[21], p.in[22]);
        GSYNC();
        { S.init(MLAT, D, gridDim.x, blockIdx.x); EpiMul E{BF(O_YF), nullptr, 0}; pg8::gemm_phase(lds, mk_gemm(BF(O_GD), BF(O_GUP), MLAT, D, 256, 256, 256), S, E); }
    }
    { S.init(MLAT, D, gridDim.x, blockIdx.x); EpiBf E{BF(O_PLX), D}; pg8::gemm_phase(lds, mk_gemm(XNP, BF(O_LX), MLAT, D, D, D, D), S, E); }
    GSYNC();
    conv_phase(BF(O_PLX), BF(O_PLXC), BF(O_XC), p.in[24], p.in[25]);
    GSYNC();
    { S.init(MALL, 4096, gridDim.x, blockIdx.x); EpiLru E{BF(O_XC), BF(O_GRF), BF(O_UF), BF(O_GRB), BF(O_UB), p.in[28], p.in[30], (const float*)(ws + O_CL)};
      Gemm g = mk_gemm(BF(O_XC), BF(O_LRUW), MALL, 4096, 256, D, 256); g.ksh = 1; g.kmask = 3; g.kmul = 256; pg8::gemm_phase(lds, g, S, E); }
    GSYNC();
    lru_p1_phase(p);
    cvt_run(p.in[34], DFF, D, DFF, BF(O_UP2), D, CV_UPI, 0, nullptr, ldsf);
    cvt_run(p.in[35], DFF, D, DFF, BF(O_UP2), D, CV_UPI, 1, nullptr, ldsf);
    GSYNC();
    lru_p3_phase(p);
    GSYNC();
    { S.init(MLAT, 3072, gridDim.x, blockIdx.x); EpiLate E{BF(O_HSUM), BF(O_SMRW), BF(O_SMLRU)}; pg8::gemm_phase(lds, mk_gemm(XNP, BF(O_LATE), MLAT, 3072, D, D, D), S, E); }
    GSYNC();
    { S.init(MLAT, D, gridDim.x, blockIdx.x); EpiMul E{BF(O_SMRW), nullptr, 0}; pg8::gemm_phase(lds, mk_gemm(BF(O_YF), BF(O_PRW), MLAT, D, D, D, D), S, E); }
    { S.init(MLAT, D, gridDim.x, blockIdx.x); EpiMul E{BF(O_SMRW), BF(O_SMLRU), 1}; pg8::gemm_phase(lds, mk_gemm(BF(O_HSUM), BF(O_PLRU), MLAT, D, D, D, D), S, E); }
    GSYNC();
    if (gridDim.x == 256) {
        S.init(MLAT, D, gridDim.x, blockIdx.x); EpiOutNorm E{X1B, BF(O_X2B), BF(O_HN2), mod, p.in[33], RowX{(unsigned*)(ws + O_XSLOT_B), (unsigned*)(ws + O_XCNT_B)}};
        pg8::gemm_phase(lds, mk_gemm(BF(O_SMRW), BF(O_WOUT), MLAT, D, D, D, D), S, E);
        GSYNC();
    } else {
        { S.init(MLAT, D, gridDim.x, blockIdx.x); EpiRes<true, true> E{nullptr, X1B, nullptr, BF(O_X2B), mod, 5, 1.0f}; pg8::gemm_phase(lds, mk_gemm(BF(O_SMRW), BF(O_WOUT), MLAT, D, D, D, D), S, E); }
        GSYNC();
        norm_phase<true>(p.in[0], (const float*)(ws + O_CTXX1), MLAT, p.in[33], mod, 6, 7, BF(O_HN2), D, nullptr, BF(O_X2B));
        GSYNC();
    }
    { S.init(MLAT, 2 * DFF, gridDim.x, blockIdx.x); EpiUp E{BF(O_U2)}; pg8::gemm_phase(lds, mk_gemm(BF(O_HN2), BF(O_UP2), MLAT, 2 * DFF, D, D, D), S, E); }
    GSYNC();
    if (gridDim.x == 256) {
        S.init(MLAT, D, gridDim.x, blockIdx.x); EpiFinalNorm E{BF(O_X2B), p.out, mod, p.in[37], RowX{(unsigned*)(ws + O_XSLOT_A), (unsigned*)(ws + O_XCNT_A)}};
        pg8::gemm_phase(lds, mk_gemm(BF(O_U2), BF(O_DN2), MLAT, D, DFF, DFF, DFF), S, E);
    } else {
        { S.init(MLAT, D, gridDim.x, blockIdx.x); EpiRes<true, false> E{nullptr, BF(O_X2B), p.out, nullptr, mod, 8, 0.5f}; pg8::gemm_phase(lds, mk_gemm(BF(O_U2), BF(O_DN2), MLAT, D, DFF, DFF, DFF), S, E); }
        GSYNC();
        final_norm_phase(p.out, p.in[37]);
    }
}

extern "C" void kernel_launch(void* const* d_in, const int* in_sizes, int n_in, void* d_out, int out_size, void* d_ws, size_t ws_size, hipStream_t stream) {
    static int grid = 0;
    if (grid == 0) {
        if (n_in != 38 || out_size != MLAT * D || ws_size < WS_NEED) { fprintf(stderr, "kernel_launch: unexpected shapes (n_in %d, out %d, ws %zu); nothing launched\n", n_in, out_size, ws_size); grid = -1; return; }
        int dev = 0, cus = 0, per_cu = 0;
        hipGetDevice(&dev);
        hipDeviceGetAttribute(&cus, hipDeviceAttributeMultiprocessorCount, dev);
        if (hipFuncSetAttribute((const void*)mega, hipFuncAttributeMaxDynamicSharedMemorySize, LDS_BYTES) != hipSuccess) { fprintf(stderr, "kernel_launch: hipFuncSetAttribute failed\n"); grid = -1; return; }
        if (hipOccupancyMaxActiveBlocksPerMultiprocessor(&per_cu, (const void*)mega, NTHREADS, LDS_BYTES) != hipSuccess || per_cu < 1) { fprintf(stderr, "kernel_launch: occupancy query failed (%d)\n", per_cu); per_cu = 1; }
        (void)hipGetLastError();
        grid = cus * (per_cu > 1 ? 1 : per_cu);
    }
    if (grid < 0) return;
    Params p{};
    for (int i = 0; i < 38; ++i) p.in[i] = (const float*)d_in[i];
    p.out = (float*)d_out; p.ws = (unsigned char*)d_ws;
    if (hipMemsetAsync((unsigned char*)d_ws + O_BAR, 0, 65536, stream) != hipSuccess) { fprintf(stderr, "kernel_launch: memset failed\n"); return; }
    void* args[] = {&p};
    hipError_t e = hipLaunchCooperativeKernel((const void*)mega, dim3(grid), dim3(NTHREADS), args, LDS_BYTES, stream);
    if (e != hipSuccess) fprintf(stderr, "kernel_launch: cooperative launch failed: %s (grid %d)\n", hipGetErrorString(e), grid);
}
```

```cpp
#include <hip/hip_runtime.h>
#include <hip/hip_cooperative_groups.h>
#include <cstdio>
#include <cstdint>
namespace cg = cooperative_groups;

#define LAS __attribute__((address_space(3)))
typedef unsigned short bf16_t;
typedef short bf16x8 __attribute__((ext_vector_type(8)));
typedef float f32x4 __attribute__((ext_vector_type(4)));
typedef float f32x2 __attribute__((ext_vector_type(2)));
typedef unsigned u32x4 __attribute__((ext_vector_type(4)));
typedef unsigned u32x2 __attribute__((ext_vector_type(2)));

constexpr int D = 1024, DFF = 2816, MLAT = 16384, MCTX = 1024, MALL = 17408, NMOD = 9216;
constexpr int NTHREADS = 512, LDS_BYTES = 131072;
constexpr size_t MiB = 1048576;
constexpr size_t W0 = 0, W1 = 18 * MiB, SP = 34 * MiB, ACT = 50 * MiB;
constexpr size_t O_UP1 = W0, O_RW = W0, O_LATE = W0, O_PRW = W0 + 6 * MiB, O_PLRU = W0 + 8 * MiB, O_WOUT = W0 + 10 * MiB, O_DN2 = W0 + 12 * MiB;
constexpr size_t O_DN1 = W1 + 10 * MiB, O_LSCW = W1, O_LSCA = W1 + 256 * 1024, O_GUP = W1 + 512 * 1024, O_LX = W1 + 1 * MiB, O_LRUW = W1 + 3 * MiB, O_UP2 = W1;
constexpr size_t O_MOD = SP, O_RN = SP + 256 * 1024, O_CB = O_RN + 1280 * 1024, O_PQ = SP + 3 * MiB, O_CTXX1 = SP + 8 * MiB, O_CL = SP + 12 * MiB, O_BAR = SP + 13 * MiB, O_PLXC = SP + 14 * MiB, O_XCNT_B = SP + 13 * MiB + 16384, O_XCNT_A = SP + 13 * MiB + 32768, O_XSLOT_B = SP + 15 * MiB, O_XSLOT_A = SP + 15 * MiB + 262144, O_XCNT_C = SP + 13 * MiB + 49152, O_XSLOT_C = SP + 15 * MiB + 524288, O_CTXP2 = ACT + 200 * MiB, O_X2B = ACT + 136 * MiB;
constexpr size_t O_HN = ACT, O_U = ACT + 34 * MiB;
constexpr size_t O_XNXS = ACT, O_R = ACT + 68 * MiB, O_K = ACT + 102 * MiB, O_V = ACT + 136 * MiB, O_LIN = ACT + 170 * MiB, O_GD = ACT + 178 * MiB + 512 * 1024;
constexpr size_t O_YF = ACT, O_YB = ACT + 32 * MiB, O_XN2 = ACT + 68 * MiB, O_PLX = ACT + 102 * MiB, O_XC = ACT + 136 * MiB;
constexpr size_t O_GRF = ACT + 32 * MiB, O_UF = ACT + 66 * MiB, O_GRB = ACT + 100 * MiB, O_UB = ACT + 170 * MiB;
constexpr size_t O_HSUM = ACT + 136 * MiB, O_XN3 = ACT + 32 * MiB, O_SMRW = ACT + 66 * MiB, O_SMLRU = ACT + 98 * MiB;
constexpr size_t O_HN2 = ACT, O_U2 = ACT + 34 * MiB;
constexpr size_t WS_NEED = 256 * MiB;

struct Params { const float* in[38]; float* out; unsigned char* ws; };

__device__ __forceinline__ float bf2f(unsigned short b) { return __uint_as_float(((unsigned)b) << 16); }
__device__ __forceinline__ float bflo(unsigned u) { return __uint_as_float(u << 16); }
__device__ __forceinline__ float bfhi(unsigned u) { return __uint_as_float(u & 0xffff0000u); }
typedef __bf16 bf16x2_t __attribute__((ext_vector_type(2)));
__device__ __forceinline__ unsigned pk2(float lo, float hi) { const f32x2 v = {lo, hi}; const bf16x2_t b = __builtin_convertvector(v, bf16x2_t); return __builtin_bit_cast(unsigned, b); }
__device__ __forceinline__ int tidx() { int t = threadIdx.x; asm volatile("" : "+v"(t)); return t; }
__device__ __forceinline__ float frcp(float x) { return __builtin_amdgcn_rcpf(x); }
__device__ __forceinline__ float sigm(float x) { return frcp(1.0f + __expf(-x)); }
__device__ __forceinline__ float tanh_f(float x) { return 1.0f - 2.0f * frcp(__expf(2.0f * x) + 1.0f); }
__device__ __forceinline__ float silu_f(float x) { return x * sigm(x); }
__device__ __forceinline__ float gelu_f(float x) { return x * sigm(1.5957691216f * (x + 0.044715f * x * x * x)); }
__device__ __forceinline__ float wave_sum(float v) {
#pragma unroll
    for (int o = 1; o < 64; o <<= 1) v += __shfl_xor(v, o);
    return v;
}
template <int CTRL> __device__ __forceinline__ float dppf(float v) {
    return __builtin_bit_cast(float, __builtin_amdgcn_update_dpp(0, __builtin_bit_cast(int, v), CTRL, 0xF, 0xF, true));
}
__device__ __forceinline__ float red16(float v) {
    v += dppf<0xB1>(v); v += dppf<0x4E>(v); v += dppf<0x141>(v); v += dppf<0x140>(v); return v;
}

namespace pg8 {
constexpr int BM = 256, BK = 64, HALF = 128, HTB = HALF * BK * 2, NXCD = 8, WGM = 8;
__device__ __forceinline__ int lds_byte(int r, int c) { const int st = (r >> 4) * 2 + (c >> 5), rr = r & 15, cc = c & 31, ob = rr * 64 + cc * 2; return st * 1024 + (ob ^ (((ob >> 9) & 1) << 5)); }
__device__ __forceinline__ void stage_rc(int b, int& R, int& C) { const int st = b / 1024, sb = b % 1024, swz = sb ^ (((sb >> 9) & 1) << 5); R = (st >> 1) * 16 + swz / 64; C = (st & 1) * 32 + (swz % 64) / 2; }
struct Unit { int pm, pn; };
struct Gemm { const bf16_t* A; const bf16_t* Bt; int M, N, K, lda, ldb, ksh, kmask, kmul; };
struct StaticOrder {
    int nM, nN, nwg, G, c;
    __device__ void init(int M, int N, int G_, int c_) { nM = M / BM; nN = N / BM; nwg = nM * nN; G = G_; c = c_; }
    __device__ bool next(int i, Unit& u) const {
        const long L = (long)i * G + c; if (L >= nwg) return false;
        int wgid = (int)L; { const int q = nwg / NXCD, r = nwg % NXCD, xcd = wgid % NXCD, off = wgid / NXCD; wgid = (xcd < r ? xcd * (q + 1) : r * (q + 1) + (xcd - r) * q) + off; }
        const int nig = WGM * nN, gid = wgid / nig, fm = gid * WGM, gsz = (nM - fm) < WGM ? (nM - fm) : WGM;
        u.pm = fm + ((wgid % nig) % gsz); u.pn = (wgid % nig) / gsz; return true;
    }
};

template <class E, class = void> struct is_ad { static constexpr bool value = false; };
template <class E> struct is_ad<E, decltype((void)E::AFTER_DRAIN)> { static constexpr bool value = true; };

template <class Epi>
__device__ __forceinline__ void gemm_phase(LAS unsigned char* lds, const Gemm g, const StaticOrder& S, const Epi& E) {
    const int tid = tidx(), wid = __builtin_amdgcn_readfirstlane(tid >> 6), lane = tid & 63, wr = wid >> 2, wc = wid & 3, fr = lane & 15, fq = lane >> 4;
    const int K = g.K, nt = K / BK;
    unsigned voffA[2], voffB[2];
#pragma unroll
    for (int i = 0; i < 2; ++i) { int R, C; stage_rc(tid * 16 + i * 8192, R, C);
        voffA[i] = (unsigned)(R * g.lda + C) * 2u; voffB[i] = (unsigned)(R * g.ldb + C) * 2u; }
    const size_t kstep = (size_t)(BK * 2);
    const size_t hstepA = (size_t)HALF * g.lda * 2, hstepB = (size_t)HALF * g.ldb * 2;
    const size_t tstepA = 2 * hstepA, tstepB = 2 * hstepB;
    const unsigned ldsw = (unsigned)wid * 1024u;
    const int aoff = lds_byte(wr * 64 + fr, fq * 8), boff = lds_byte(wc * 32 + fr, fq * 8);
#define PG8_SA(b, h) (((b) * 2 + (h)) * HTB)
#define PG8_SB(b, h) ((4 + (b) * 2 + (h)) * HTB)
#define PG8_STAGE(bufoff, gbase, voff) do { _Pragma("unroll") for (int _i = 0; _i < 2; ++_i) \
        __builtin_amdgcn_global_load_lds((const unsigned*)((const char*)(gbase) + (voff)[_i]), (LAS unsigned*)(lds + (bufoff) + ldsw + _i * 8192), 16, 0, 0); } while (0)
#define PG8_LDA(dst, b, h) do { _Pragma("unroll") for (int m = 0; m < 4; ++m) _Pragma("unroll") for (int k = 0; k < 2; ++k) dst[m][k] = *(const LAS bf16x8*)(lds + PG8_SA(b, h) + aoff + m * 2048 + k * 1024); } while (0)
#define PG8_LDB(dst, b, h) do { _Pragma("unroll") for (int n = 0; n < 2; ++n) _Pragma("unroll") for (int k = 0; k < 2; ++k) dst[n][k] = *(const LAS bf16x8*)(lds + PG8_SB(b, h) + boff + n * 2048 + k * 1024); } while (0)
#define PG8_MMA(ai, bj, At, Bt) do { __builtin_amdgcn_s_setprio(1); _Pragma("unroll") for (int m = 0; m < 4; ++m) _Pragma("unroll") for (int n = 0; n < 2; ++n) _Pragma("unroll") for (int k = 0; k < 2; ++k) \
        acc[ai][bj][m][n] = __builtin_amdgcn_mfma_f32_16x16x32_bf16(Bt[n][k], At[m][k], acc[ai][bj][m][n], 0, 0, 0); __builtin_amdgcn_s_setprio(0); } while (0)
#define PG8_WAIT_V(n) asm volatile("s_waitcnt vmcnt(" #n ")" ::: "memory")
#define PG8_WAIT_L(n) asm volatile("s_waitcnt lgkmcnt(" #n ")" ::: "memory")
#define PG8_BAR __builtin_amdgcn_s_barrier()
#define PG8_SCHED __builtin_amdgcn_sched_barrier(0)
#define PG8_KOFF(u) ((size_t)((((u).pn >> g.ksh) & g.kmask) * g.kmul) * 2)
    Unit cur, nxt; int ui = 0;
    if (!S.next(0, cur)) return;
    f32x4 acc[2][2][4][2];
#pragma unroll
    for (int a = 0; a < 2; ++a)
#pragma unroll
        for (int b = 0; b < 2; ++b)
#pragma unroll
            for (int m = 0; m < 4; ++m)
#pragma unroll
                for (int n = 0; n < 2; ++n) acc[a][b][m][n] = (f32x4){0.f, 0.f, 0.f, 0.f};
    bf16x8 At[4][2], B0[2][2], B1[2][2];
    const char* cA = (const char*)g.A + (size_t)cur.pm * tstepA + PG8_KOFF(cur); const char* cB = (const char*)g.Bt + (size_t)cur.pn * tstepB;
    PG8_STAGE(PG8_SB(0, 0), cB, voffB); PG8_STAGE(PG8_SA(0, 0), cA, voffA); PG8_STAGE(PG8_SB(0, 1), cB + hstepB, voffB); PG8_STAGE(PG8_SA(0, 1), cA + hstepA, voffA);
    if (wr == 1) PG8_BAR;
    PG8_WAIT_V(4); PG8_BAR;
    PG8_STAGE(PG8_SB(1, 0), cB + kstep, voffB); PG8_STAGE(PG8_SA(1, 0), cA + kstep, voffA); PG8_STAGE(PG8_SB(1, 1), cB + hstepB + kstep, voffB);
    PG8_WAIT_V(6); PG8_BAR;
    for (;;) {
        const bool has_next = S.next(ui + 1, nxt);
        const char* nA = has_next ? (const char*)g.A + (size_t)nxt.pm * tstepA + PG8_KOFF(nxt) : cA; const char* nB = has_next ? (const char*)g.Bt + (size_t)nxt.pn * tstepB : cB;
        for (int t = 0; t < nt; t += 2) {
            const bool last = (t == nt - 2);
            const char* a1 = cA + (size_t)(t + 1) * kstep;
            const char* a2 = last ? nA : cA + (size_t)(t + 2) * kstep; const char* b2 = last ? nB : cB + (size_t)(t + 2) * kstep;
            const char* a3 = a2 + kstep; const char* b3 = b2 + kstep;
            PG8_LDB(B0, 0, 0); PG8_SCHED; PG8_LDA(At, 0, 0); PG8_STAGE(PG8_SA(1, 1), a1 + hstepA, voffA);
            PG8_WAIT_L(8); PG8_BAR; PG8_WAIT_L(0); PG8_MMA(0, 0, At, B0); PG8_BAR; PG8_SCHED;
            PG8_LDB(B1, 0, 1); PG8_STAGE(PG8_SB(0, 0), b2, voffB);
            PG8_BAR; PG8_WAIT_L(0); PG8_MMA(0, 1, At, B1); PG8_BAR;
            PG8_LDA(At, 0, 1); PG8_STAGE(PG8_SA(0, 0), a2, voffA);
            PG8_BAR; PG8_WAIT_L(0); PG8_MMA(1, 0, At, B0); PG8_BAR; PG8_SCHED;
            PG8_STAGE(PG8_SB(0, 1), b2 + hstepB, voffB);
            PG8_WAIT_V(6); PG8_BAR; PG8_MMA(1, 1, At, B1); PG8_BAR;
            PG8_LDB(B0, 1, 0); PG8_SCHED; PG8_LDA(At, 1, 0); PG8_STAGE(PG8_SA(0, 1), a2 + hstepA, voffA);
            PG8_WAIT_L(8); PG8_BAR; PG8_WAIT_L(0); PG8_MMA(0, 0, At, B0); PG8_BAR; PG8_SCHED;
            PG8_LDB(B1, 1, 1); PG8_STAGE(PG8_SB(1, 0), b3, voffB);
            PG8_BAR; PG8_WAIT_L(0); PG8_MMA(0, 1, At, B1); PG8_BAR;
            PG8_LDA(At, 1, 1); PG8_STAGE(PG8_SA(1, 0), a3, voffA);
            PG8_BAR; PG8_WAIT_L(0); PG8_MMA(1, 0, At, B0); PG8_BAR; PG8_SCHED;
            PG8_STAGE(PG8_SB(1, 1), b3 + hstepB, voffB);
            PG8_WAIT_V(6); PG8_BAR; PG8_MMA(1, 1, At, B1); PG8_BAR;
        }
        if constexpr (!is_ad<Epi>::value) E(acc, cur, wr, wc, fr, fq);
        if (!has_next) break;
#pragma unroll
        for (int a = 0; a < 2; ++a)
#pragma unroll
            for (int b = 0; b < 2; ++b)
#pragma unroll
                for (int m = 0; m < 4; ++m)
#pragma unroll
                    for (int n = 0; n < 2; ++n) acc[a][b][m][n] = (f32x4){0.f, 0.f, 0.f, 0.f};
        cur = nxt; cA = nA; cB = nB; ++ui;
    }
    PG8_WAIT_V(0);
    if (wr == 0) PG8_BAR;
    PG8_BAR;
    if constexpr (is_ad<Epi>::value) E.fused(acc, cur, wr, wc, fr, fq, lds, wid, lane);
#undef PG8_SA
#undef PG8_SB
#undef PG8_STAGE
#undef PG8_LDA
#undef PG8_LDB
#undef PG8_MMA
#undef PG8_WAIT_V
#undef PG8_WAIT_L
#undef PG8_BAR
#undef PG8_SCHED
#undef PG8_KOFF
}
}
using pg8::Unit;
using pg8::Gemm;

#define EPI_ROWS(...) _Pragma("unroll") for (int ai = 0; ai < 2; ++ai) _Pragma("unroll") for (int m = 0; m < 4; ++m) { const int row = u.pm * 256 + ai * 128 + wr * 64 + m * 16 + fr; __VA_ARGS__ }
#define EPI_ALL(...) _Pragma("unroll") for (int ai = 0; ai < 2; ++ai) _Pragma("unroll") for (int m = 0; m < 4; ++m) _Pragma("unroll") for (int bj = 0; bj < 2; ++bj) _Pragma("unroll") for (int n = 0; n < 2; ++n) { \
        const int row = u.pm * 256 + ai * 128 + wr * 64 + m * 16 + fr; __VA_ARGS__ }
typedef const f32x4 (&AccRef)[2][2][4][2];

struct EpiUp {
    bf16_t* U;
    __device__ __forceinline__ void operator()(AccRef acc, const Unit& u, int wr, int wc, int fr, int fq) const {
        EPI_ROWS(
            _Pragma("unroll") for (int bj = 0; bj < 2; ++bj) {
                const f32x4 g = acc[ai][bj][m][0], v = acc[ai][bj][m][1];
                const int f0 = ((u.pn * 256 + bj * 128 + wc * 32) >> 1) + 4 * fq;
                u32x2 o; o.x = pk2(silu_f(g[0]) * v[0], silu_f(g[1]) * v[1]); o.y = pk2(silu_f(g[2]) * v[2], silu_f(g[3]) * v[3]);
                *(u32x2*)(U + (size_t)row * DFF + f0) = o; }
        )
    }
};
template <bool RB, bool OB> struct EpiRes {
    const float* res_f; const bf16_t* res_b; float* out_f; bf16_t* out_b; const float* mod; int gidx; float scale;
    __device__ __forceinline__ void operator()(AccRef acc, const Unit& u, int wr, int wc, int fr, int fq) const {
        u32x2 tv[2][4][2][2];
        if constexpr (RB) { EPI_ALL( const int col = u.pn * 256 + bj * 128 + wc * 32 + n * 16 + 4 * fq; tv[ai][m][bj][n] = *(const u32x2*)(res_b + (size_t)row * D + col); ) }
        EPI_ROWS(
            const float* gp = mod + (size_t)(row >> 12) * NMOD + gidx * D;
            _Pragma("unroll") for (int bj = 0; bj < 2; ++bj) _Pragma("unroll") for (int n = 0; n < 2; ++n) {
                const int col = u.pn * 256 + bj * 128 + wc * 32 + n * 16 + 4 * fq; const size_t off = (size_t)row * D + col;
                f32x4 r;
                if constexpr (RB) { const u32x2 t = tv[ai][m][bj][n]; r = (f32x4){bflo(t.x), bfhi(t.x), bflo(t.y), bfhi(t.y)}; } else r = *(const f32x4*)(res_f + off);
                const f32x4 gt = *(const f32x4*)(gp + col);
                const f32x4 o = r + scale * gt * acc[ai][bj][m][n];
                if constexpr (OB) { u32x2 w; w.x = pk2(o[0], o[1]); w.y = pk2(o[2], o[3]); *(u32x2*)(out_b + off) = w; } else *(f32x4*)(out_f + off) = o; }
        )
    }
};
struct EpiCtx {
    const float* res; float* out; const float* gate; float scale;
    __device__ __forceinline__ void operator()(AccRef acc, const Unit& u, int wr, int wc, int fr, int fq) const {
        EPI_ROWS(
            _Pragma("unroll") for (int bj = 0; bj < 2; ++bj) _Pragma("unroll") for (int n = 0; n < 2; ++n) {
                const int col = u.pn * 256 + bj * 128 + wc * 32 + n * 16 + 4 * fq; const size_t off = (size_t)row * D + col;
                const f32x4 gt = *(const f32x4*)(gate + col); f32x4 r = (f32x4){0.f, 0.f, 0.f, 0.f};
                if (res) r = *(const f32x4*)(res + off);
                *(f32x4*)(out + off) = r + scale * gt * acc[ai][bj][m][n]; }
        )
    }
};
struct EpiRw {
    bf16_t *RKV, *LIN, *GD;
    __device__ __forceinline__ void operator()(AccRef acc, const Unit& u, int wr, int wc, int fr, int fq) const {
        const int pn = u.pn;
        if (pn < 12) {
            bf16_t* base = RKV + (size_t)(pn >> 2) * ((size_t)MALL * D) + (pn & 3) * 256;
            EPI_ROWS(
                _Pragma("unroll") for (int bj = 0; bj < 2; ++bj) _Pragma("unroll") for (int n = 0; n < 2; ++n) {
                    const int cl = bj * 128 + wc * 32 + n * 16 + 4 * fq; const f32x4 a = acc[ai][bj][m][n];
                    u32x2 o; o.x = pk2(a[0], a[1]); o.y = pk2(a[2], a[3]);
                    *(u32x2*)(base + (size_t)row * D + cl) = o; }
            )
        } else if (pn == 12) {
            EPI_ROWS(
                _Pragma("unroll") for (int bj = 0; bj < 2; ++bj) _Pragma("unroll") for (int n = 0; n < 2; ++n) {
                    const int cl = bj * 128 + wc * 32 + n * 16 + 4 * fq; f32x4 a = acc[ai][bj][m][n];
                    if (bj == 0) { a[0] = tanh_f(a[0]); a[1] = tanh_f(a[1]); a[2] = tanh_f(a[2]); a[3] = tanh_f(a[3]); }
                    u32x2 o; o.x = pk2(a[0], a[1]); o.y = pk2(a[2], a[3]);
                    *(u32x2*)(LIN + (size_t)row * 256 + cl) = o; }
            )
        } else {
            EPI_ROWS(
                _Pragma("unroll") for (int bj = 0; bj < 2; ++bj) _Pragma("unroll") for (int n = 0; n < 2; ++n) {
                    const int cl = bj * 128 + wc * 32 + n * 16 + 4 * fq; const f32x4 a = acc[ai][bj][m][n];
                    u32x2 o; o.x = 0u; o.y = 0u;
                    if (bj == 0) { o.x = pk2(sigm(a[0]), sigm(a[1])); o.y = pk2(sigm(a[2]), sigm(a[3])); }
                    *(u32x2*)(GD + (size_t)row * 256 + cl) = o; }
            )
        }
    }
};
struct EpiBf {
    bf16_t* O; int ldo;
    __device__ __forceinline__ void operator()(AccRef acc, const Unit& u, int wr, int wc, int fr, int fq) const {
        EPI_ROWS(
            _Pragma("unroll") for (int bj = 0; bj < 2; ++bj) _Pragma("unroll") for (int n = 0; n < 2; ++n) {
                const int col = u.pn * 256 + bj * 128 + wc * 32 + n * 16 + 4 * fq; const f32x4 a = acc[ai][bj][m][n];
                u32x2 o; o.x = pk2(a[0], a[1]); o.y = pk2(a[2], a[3]);
                *(u32x2*)(O + (size_t)row * ldo + col) = o; }
        )
    }
};
struct EpiMul {
    bf16_t* T; const bf16_t* S2; int mode;
    __device__ __forceinline__ void operator()(AccRef acc, const Unit& u, int wr, int wc, int fr, int fq) const {
#pragma unroll
        for (int ai = 0; ai < 2; ++ai) {
            u32x2 tv[4][2][2], sv[4][2][2];
#pragma unroll
            for (int m = 0; m < 4; ++m)
#pragma unroll
                for (int bj = 0; bj < 2; ++bj)
#pragma unroll
                    for (int n = 0; n < 2; ++n) { const int row = u.pm * 256 + ai * 128 + wr * 64 + m * 16 + fr, col = u.pn * 256 + bj * 128 + wc * 32 + n * 16 + 4 * fq; const size_t off = (size_t)row * D + col;
                        tv[m][bj][n] = *(const u32x2*)(T + off); sv[m][bj][n] = (u32x2){0u, 0u}; if (mode != 0) sv[m][bj][n] = *(const u32x2*)(S2 + off); }
#pragma unroll
            for (int m = 0; m < 4; ++m)
#pragma unroll
                for (int bj = 0; bj < 2; ++bj)
#pragma unroll
                    for (int n = 0; n < 2; ++n) { const int row = u.pm * 256 + ai * 128 + wr * 64 + m * 16 + fr, col = u.pn * 256 + bj * 128 + wc * 32 + n * 16 + 4 * fq; const size_t off = (size_t)row * D + col;
                        const f32x4 a = acc[ai][bj][m][n]; const u32x2 t = tv[m][bj][n], q = sv[m][bj][n]; u32x2 o;
                        if (mode == 0) { o.x = pk2(bflo(t.x) * a[0], bfhi(t.x) * a[1]); o.y = pk2(bflo(t.y) * a[2], bfhi(t.y) * a[3]); }
                        else { o.x = pk2(bflo(t.x) + bflo(q.x) * a[0], bfhi(t.x) + bfhi(q.x) * a[1]); o.y = pk2(bflo(t.y) + bflo(q.y) * a[2], bfhi(t.y) + bfhi(q.y) * a[3]); }
                        *(u32x2*)(T + off) = o; }
        }
    }
};
struct EpiLru {
    const bf16_t* XC; bf16_t *GR0, *U0, *GR1, *U1; const float *ba, *bx, *cl;
    __device__ __forceinline__ void operator()(AccRef acc, const Unit& u, int wr, int wc, int fr, int fq) const {
        const int d = u.pn >> 3, pn8 = u.pn & 7;
        bf16_t* GR = GR0 + (size_t)d * ((size_t)(O_GRB - O_GRF) / 2); bf16_t* UU = U0 + (size_t)d * ((size_t)(O_UB - O_UF) / 2);
#pragma unroll
        for (int bj = 0; bj < 2; ++bj) { const int c0 = 128 * pn8 + 16 * (4 * bj + wc) + 4 * fq;
            const f32x4 vba = *(const f32x4*)(ba + d * D + c0), vbx = *(const f32x4*)(bx + d * D + c0), vcl = *(const f32x4*)(cl + d * D + c0);
            u32x2 xv[2][4];
            EPI_ROWS( xv[ai][m] = *(const u32x2*)(XC + (size_t)row * D + c0); )
            EPI_ROWS(
                const size_t off = (size_t)row * D + c0;
                const u32x2 xcv = xv[ai][m];
                const float xc[4] = {bflo(xcv.x), bfhi(xcv.x), bflo(xcv.y), bfhi(xcv.y)};
                float gr[4]; float uu[4];
                _Pragma("unroll") for (int j = 0; j < 4; ++j) {
                    gr[j] = sigm(acc[ai][bj][m][0][j] + vba[j]);
                    const float gi = sigm(acc[ai][bj][m][1][j] + vbx[j]);
                    const float x = 2.0f * gr[j] * vcl[j];
                    const float om = -x * (1.0f + 0.5f * x * (1.0f + (1.0f / 3.0f) * x * (1.0f + 0.25f * x)));
                    uu[j] = __builtin_amdgcn_sqrtf(om) * gi * xc[j]; }
                u32x2 o1; u32x2 o2; o1.x = pk2(gr[0], gr[1]); o1.y = pk2(gr[2], gr[3]); o2.x = pk2(uu[0], uu[1]); o2.y = pk2(uu[2], uu[3]);
                *(u32x2*)(GR + off) = o1; *(u32x2*)(UU + off) = o2;
            )
        }
    }
};
struct EpiLate {
    bf16_t *HS, *S1, *S2;
    __device__ __forceinline__ void operator()(AccRef acc, const Unit& u, int wr, int wc, int fr, int fq) const {
        const int part = u.pn >> 2;
        if (part == 0) {
            u32x2 tv[2][4][2][2];
            EPI_ALL( const int col = (u.pn & 3) * 256 + bj * 128 + wc * 32 + n * 16 + 4 * fq; tv[ai][m][bj][n] = *(const u32x2*)(HS + (size_t)row * D + col); )
            EPI_ALL( const int col = (u.pn & 3) * 256 + bj * 128 + wc * 32 + n * 16 + 4 * fq; const f32x4 a = acc[ai][bj][m][n]; const u32x2 t = tv[ai][m][bj][n]; u32x2 o;
                o.x = pk2(bflo(t.x) * gelu_f(a[0]), bfhi(t.x) * gelu_f(a[1])); o.y = pk2(bflo(t.y) * gelu_f(a[2]), bfhi(t.y) * gelu_f(a[3]));
                *(u32x2*)(HS + (size_t)row * D + col) = o; )
        } else {
            bf16_t* O = part == 1 ? S1 : S2;
            EPI_ALL( const int col = (u.pn & 3) * 256 + bj * 128 + wc * 32 + n * 16 + 4 * fq; const f32x4 a = acc[ai][bj][m][n]; u32x2 o;
                o.x = pk2(sigm(a[0]), sigm(a[1])); o.y = pk2(sigm(a[2]), sigm(a[3])); *(u32x2*)(O + (size_t)row * D + col) = o; )
        }
    }
};

struct EpiPostG {
    static constexpr bool AFTER_DRAIN = true;
    bf16_t* YF; const bf16_t* YB; const bf16_t* V; const float* cb; const float* lnw; const float* lnb;
    __device__ __forceinline__ void fused(f32x4 (&acc)[2][2][4][2], const Unit& u, int wr, int wc, int fr, int fq, LAS unsigned char* lds, int wid, int lane) const {
        LAS f32x2* P = (LAS f32x2*)lds;
#pragma unroll
        for (int ai = 0; ai < 2; ++ai)
#pragma unroll
            for (int bj = 0; bj < 2; ++bj) { const int qd = ai * 2 + bj;
                u32x2 a[4][2], b[4][2], vv[4][2];
#pragma unroll
                for (int m = 0; m < 4; ++m)
#pragma unroll
                    for (int n = 0; n < 2; ++n) { const size_t off = (size_t)(u.pm * 256 + ai * 128 + wr * 64 + m * 16 + fr) * D + u.pn * 256 + bj * 128 + wc * 32 + n * 16 + 4 * fq;
                        a[m][n] = *(const u32x2*)(YF + off); b[m][n] = *(const u32x2*)(YB + off); vv[m][n] = *(const u32x2*)(V + off); }
                f32x4 y[4][2];
#pragma unroll
                for (int m = 0; m < 4; ++m) { float s1 = 0.f, s2 = 0.f;
#pragma unroll
                    for (int n = 0; n < 2; ++n) { const f32x4 t = (f32x4){bflo(a[m][n].x) + bflo(b[m][n].x), bfhi(a[m][n].x) + bfhi(b[m][n].x), bflo(a[m][n].y) + bflo(b[m][n].y), bfhi(a[m][n].y) + bfhi(b[m][n].y)};
                        y[m][n] = t; s1 += (t[0] + t[1]) + (t[2] + t[3]); s2 += (t[0] * t[0] + t[1] * t[1]) + (t[2] * t[2] + t[3] * t[3]); }
                    s1 += __shfl_xor(s1, 16); s1 += __shfl_xor(s1, 32); s2 += __shfl_xor(s2, 16); s2 += __shfl_xor(s2, 32);
                    if (fq == 0) P[(qd * 128 + wr * 64 + m * 16 + fr) * 4 + wc] = (f32x2){s1, s2}; }
                __syncthreads();
                const int head = 4 * u.pn + 2 * bj + (wc >> 1);
#pragma unroll
                for (int m = 0; m < 4; ++m) { const int rl = wr * 64 + m * 16 + fr, row = u.pm * 256 + ai * 128 + rl;
                    const f32x2 p0 = P[(qd * 128 + rl) * 4 + wc], p1 = P[(qd * 128 + rl) * 4 + (wc ^ 1)];
                    const float mean = (p0[0] + p1[0]) * (1.0f / 64.0f), var = fmaxf((p0[1] + p1[1]) * (1.0f / 64.0f) - mean * mean, 0.f), rs = rsqrtf(var + 64e-5f);
                    const float cbs = cb[(size_t)row * 16 + head];
#pragma unroll
                    for (int n = 0; n < 2; ++n) { const int col = u.pn * 256 + bj * 128 + wc * 32 + n * 16 + 4 * fq; const size_t off = (size_t)row * D + col;
                        const f32x4 w = *(const f32x4*)(lnw + col), bb = *(const f32x4*)(lnb + col), g = acc[ai][bj][m][n];
                        const f32x4 v4 = (f32x4){bflo(vv[m][n].x), bfhi(vv[m][n].x), bflo(vv[m][n].y), bfhi(vv[m][n].y)};
                        const f32x4 o = ((y[m][n] - mean) * rs * w + bb + cbs * v4) * g;
                        u32x2 q; q.x = pk2(o[0], o[1]); q.y = pk2(o[2], o[3]); *(u32x2*)(YF + off) = q; } }
            }
        __syncthreads();
    }
};
struct RowX { unsigned* slots; unsigned* cnt; };
__device__ __forceinline__ void row_rstd_exchange(f32x4 (&v)[2][2][4][2], const Unit& u, int wr, int wc, int fr, int fq, LAS unsigned char* lds, int wid, int lane, const RowX& X) {
    LAS float* P = (LAS float*)lds; LAS float* S = (LAS float*)(lds + 4096);
#pragma unroll
    for (int ai = 0; ai < 2; ++ai)
#pragma unroll
        for (int m = 0; m < 4; ++m) { float q = 0.f;
#pragma unroll
            for (int bj = 0; bj < 2; ++bj)
#pragma unroll
                for (int n = 0; n < 2; ++n) { const f32x4 x = v[ai][bj][m][n]; q += (x[0] * x[0] + x[1] * x[1]) + (x[2] * x[2] + x[3] * x[3]); }
            q += __shfl_xor(q, 16); q += __shfl_xor(q, 32);
            if (fq == 0) P[(ai * 128 + wr * 64 + m * 16 + fr) * 4 + wc] = q; }
    __syncthreads();
    const int row = wid * 32 + (lane & 31);
    if (lane < 32) { const float t = (P[row * 4] + P[row * 4 + 1]) + (P[row * 4 + 2] + P[row * 4 + 3]);
        __hip_atomic_store(X.slots + ((size_t)(u.pm * 256 + row) * 4 + u.pn), __float_as_uint(t), __ATOMIC_RELAXED, __HIP_MEMORY_SCOPE_AGENT); }
    asm volatile("s_waitcnt vmcnt(0)" ::: "memory");
    if (lane == 0) __hip_atomic_fetch_add(X.cnt + 64 * u.pm, 1u, __ATOMIC_RELAXED, __HIP_MEMORY_SCOPE_AGENT);
    if (wid == 0) { unsigned sp = 0u;
        while ((unsigned)__builtin_amdgcn_readfirstlane(__hip_atomic_load(X.cnt + 64 * u.pm, __ATOMIC_RELAXED, __HIP_MEMORY_SCOPE_AGENT)) < 32u) { __builtin_amdgcn_s_sleep(1); if (++sp > (1u << 22)) break; } }
    __syncthreads();
    if (lane < 32) { const unsigned* sl = X.slots + (size_t)(u.pm * 256 + row) * 4; float t = 0.f;
#pragma unroll
        for (int q = 0; q < 4; ++q) t += __uint_as_float(__hip_atomic_load(sl + q, __ATOMIC_RELAXED, __HIP_MEMORY_SCOPE_AGENT));
        S[row] = rsqrtf(t * (1.0f / D) + 1e-6f); }
    __syncthreads();
}
struct EpiOutNorm {
    static constexpr bool AFTER_DRAIN = true;
    const bf16_t* res_b; bf16_t* x2b; bf16_t* hn; const float* mod; const float* g2; RowX X;
    __device__ __forceinline__ void fused(f32x4 (&acc)[2][2][4][2], const Unit& u, int wr, int wc, int fr, int fq, LAS unsigned char* lds, int wid, int lane) const {
        const float* mb = mod + (size_t)((u.pm * 256) >> 12) * NMOD;
#pragma unroll
        for (int ai = 0; ai < 2; ++ai) { u32x2 tv[4][2][2];
#pragma unroll
            for (int m = 0; m < 4; ++m)
#pragma unroll
                for (int bj = 0; bj < 2; ++bj)
#pragma unroll
                    for (int n = 0; n < 2; ++n) { const int row = u.pm * 256 + ai * 128 + wr * 64 + m * 16 + fr, col = u.pn * 256 + bj * 128 + wc * 32 + n * 16 + 4 * fq; tv[m][bj][n] = *(const u32x2*)(res_b + (size_t)row * D + col); }
#pragma unroll
            for (int m = 0; m < 4; ++m)
#pragma unroll
                for (int bj = 0; bj < 2; ++bj)
#pragma unroll
                    for (int n = 0; n < 2; ++n) { const int row = u.pm * 256 + ai * 128 + wr * 64 + m * 16 + fr, col = u.pn * 256 + bj * 128 + wc * 32 + n * 16 + 4 * fq; const u32x2 t = tv[m][bj][n];
                        const f32x4 gt = *(const f32x4*)(mb + 5 * D + col);
                        const f32x4 o = (f32x4){bflo(t.x), bfhi(t.x), bflo(t.y), bfhi(t.y)} + gt * acc[ai][bj][m][n];
                        acc[ai][bj][m][n] = o;
                        u32x2 w; w.x = pk2(o[0], o[1]); w.y = pk2(o[2], o[3]); *(u32x2*)(x2b + (size_t)row * D + col) = w; }
        }
        row_rstd_exchange(acc, u, wr, wc, fr, fq, lds, wid, lane, X);
        const LAS float* S = (const LAS float*)(lds + 4096);
#pragma unroll
        for (int bj = 0; bj < 2; ++bj)
#pragma unroll
            for (int n = 0; n < 2; ++n) { const int col = u.pn * 256 + bj * 128 + wc * 32 + n * 16 + 4 * fq;
                const f32x4 mul = *(const f32x4*)(g2 + col) * (1.0f + *(const f32x4*)(mb + 7 * D + col)), sh = *(const f32x4*)(mb + 6 * D + col);
#pragma unroll
                for (int ai = 0; ai < 2; ++ai)
#pragma unroll
                    for (int m = 0; m < 4; ++m) { const int rl = ai * 128 + wr * 64 + m * 16 + fr; const float rs = S[rl];
                        const f32x4 y = acc[ai][bj][m][n] * rs * mul + sh;
                        u32x2 w; w.x = pk2(y[0], y[1]); w.y = pk2(y[2], y[3]); *(u32x2*)(hn + (size_t)(u.pm * 256 + rl) * D + col) = w; } }
    }
};
struct EpiDn1Norm {
    static constexpr bool AFTER_DRAIN = true;
    const float* res_f; bf16_t* x1b; bf16_t* xnxs; bf16_t* xnp; const float* mod; const float* gm; RowX X;
    __device__ __forceinline__ void fused(f32x4 (&acc)[2][2][4][2], const Unit& u, int wr, int wc, int fr, int fq, LAS unsigned char* lds, int wid, int lane) const {
        const float* mb = mod + (size_t)((u.pm * 256) >> 12) * NMOD;
        f32x4 gt[2][2];
#pragma unroll
        for (int bj = 0; bj < 2; ++bj)
#pragma unroll
            for (int n = 0; n < 2; ++n) gt[bj][n] = 0.5f * *(const f32x4*)(mb + 2 * D + u.pn * 256 + bj * 128 + wc * 32 + n * 16 + 4 * fq);
#pragma unroll
        for (int ai = 0; ai < 2; ++ai)
#pragma unroll
            for (int mh = 0; mh < 2; ++mh) { f32x4 rv[2][2][2];
#pragma unroll
                for (int mm = 0; mm < 2; ++mm)
#pragma unroll
                    for (int bj = 0; bj < 2; ++bj)
#pragma unroll
                        for (int n = 0; n < 2; ++n) { const int m = 2 * mh + mm, row = u.pm * 256 + ai * 128 + wr * 64 + m * 16 + fr, col = u.pn * 256 + bj * 128 + wc * 32 + n * 16 + 4 * fq; rv[mm][bj][n] = *(const f32x4*)(res_f + (size_t)row * D + col); }
#pragma unroll
                for (int mm = 0; mm < 2; ++mm)
#pragma unroll
                    for (int bj = 0; bj < 2; ++bj)
#pragma unroll
                        for (int n = 0; n < 2; ++n) { const int m = 2 * mh + mm, row = u.pm * 256 + ai * 128 + wr * 64 + m * 16 + fr, col = u.pn * 256 + bj * 128 + wc * 32 + n * 16 + 4 * fq;
                            const f32x4 o = rv[mm][bj][n] + gt[bj][n] * acc[ai][bj][m][n]; acc[ai][bj][m][n] = o;
                            u32x2 w; w.x = pk2(o[0], o[1]); w.y = pk2(o[2], o[3]); *(u32x2*)(x1b + (size_t)row * D + col) = w; }
            }
        row_rstd_exchange(acc, u, wr, wc, fr, fq, lds, wid, lane, X);
        const LAS float* S = (const LAS float*)(lds + 4096);
#pragma unroll
        for (int bj = 0; bj < 2; ++bj)
#pragma unroll
            for (int n = 0; n < 2; ++n) { const int col = u.pn * 256 + bj * 128 + wc * 32 + n * 16 + 4 * fq;
                const f32x4 mul = *(const f32x4*)(gm + col) * (1.0f + *(const f32x4*)(mb + 4 * D + col)), sh = *(const f32x4*)(mb + 3 * D + col);
#pragma unroll
                for (int ai = 0; ai < 2; ++ai)
#pragma unroll
                    for (int m = 0; m < 4; ++m) { const int rl = ai * 128 + wr * 64 + m * 16 + fr; const float rs = S[rl]; const size_t row = (size_t)(u.pm * 256 + rl);
                        const f32x4 y = acc[ai][bj][m][n] * rs * mul + sh;
                        u32x2 w; w.x = pk2(y[0], y[1]); w.y = pk2(y[2], y[3]); *(u32x2*)(xnp + row * D + col) = w; } }
        __syncthreads();
    }
};
struct EpiFinalNorm {
    static constexpr bool AFTER_DRAIN = true;
    const bf16_t* res_b; float* out; const float* mod; const float* gfin; RowX X;
    __device__ __forceinline__ void fused(f32x4 (&acc)[2][2][4][2], const Unit& u, int wr, int wc, int fr, int fq, LAS unsigned char* lds, int wid, int lane) const {
        const float* mb = mod + (size_t)((u.pm * 256) >> 12) * NMOD;
#pragma unroll
        for (int ai = 0; ai < 2; ++ai) { u32x2 tv[4][2][2];
#pragma unroll
            for (int m = 0; m < 4; ++m)
#pragma unroll
                for (int bj = 0; bj < 2; ++bj)
#pragma unroll
                    for (int n = 0; n < 2; ++n) { const int row = u.pm * 256 + ai * 128 + wr * 64 + m * 16 + fr, col = u.pn * 256 + bj * 128 + wc * 32 + n * 16 + 4 * fq; tv[m][bj][n] = *(const u32x2*)(res_b + (size_t)row * D + col); }
#pragma unroll
            for (int m = 0; m < 4; ++m)
#pragma unroll
                for (int bj = 0; bj < 2; ++bj)
#pragma unroll
                    for (int n = 0; n < 2; ++n) { const int col = u.pn * 256 + bj * 128 + wc * 32 + n * 16 + 4 * fq; const u32x2 t = tv[m][bj][n];
                        const f32x4 gt = 0.5f * *(const f32x4*)(mb + 8 * D + col);
                        acc[ai][bj][m][n] = (f32x4){bflo(t.x), bfhi(t.x), bflo(t.y), bfhi(t.y)} + gt * acc[ai][bj][m][n]; }
        }
        row_rstd_exchange(acc, u, wr, wc, fr, fq, lds, wid, lane, X);
        const LAS float* S = (const LAS float*)(lds + 4096);
#pragma unroll
        for (int bj = 0; bj < 2; ++bj)
#pragma unroll
            for (int n = 0; n < 2; ++n) { const int col = u.pn * 256 + bj * 128 + wc * 32 + n * 16 + 4 * fq;
                const f32x4 gg = *(const f32x4*)(gfin + col);
#pragma unroll
                for (int ai = 0; ai < 2; ++ai)
#pragma unroll
                    for (int m = 0; m < 4; ++m) { const int rl = ai * 128 + wr * 64 + m * 16 + fr; const float rs = S[rl];
                        *(f32x4*)(out + (size_t)(u.pm * 256 + rl) * D + col) = acc[ai][bj][m][n] * rs * gg; } }
    }
};

enum { CV_PLAIN = 0, CV_UPI = 1, CV_RW = 2, CV_LRU = 3 };
__device__ __forceinline__ void cvt_store(const LAS float* scr, int tid, int k0, int n0, bf16_t* dst, int ldd, int mode, int p0, const float* sc) {
    const int nl = tid >> 3, kc = (tid & 7) * 8, n = n0 + nl;
    float s[8];
#pragma unroll
    for (int j = 0; j < 8; ++j) s[j] = scr[(kc + j) * 65 + nl];
    int row = n;
    if (mode == CV_UPI) row = 32 * (n >> 4) + 16 * p0 + (n & 15);
    else if (mode == CV_LRU) { const int dd = p0 >> 3, nb = (p0 >> 1) & 3, which = p0 & 1, c = 256 * nb + n; row = dd * 2048 + (c >> 7) * 256 + ((c & 127) >> 4) * 32 + which * 16 + (c & 15); }
    bf16_t* dp = dst + (size_t)row * ldd + k0 + kc;
    if (mode == CV_RW) { const float mu = sc[n], om = 1.0f - mu;
        u32x4 o; o.x = pk2(s[0] * om, s[1] * om); o.y = pk2(s[2] * om, s[3] * om); o.z = pk2(s[4] * om, s[5] * om); o.w = pk2(s[6] * om, s[7] * om);
        *(u32x4*)dp = o;
        o.x = pk2(s[0] * mu, s[1] * mu); o.y = pk2(s[2] * mu, s[3] * mu); o.z = pk2(s[4] * mu, s[5] * mu); o.w = pk2(s[6] * mu, s[7] * mu);
        *(u32x4*)(dp + 1024) = o;
    } else { u32x4 o; o.x = pk2(s[0], s[1]); o.y = pk2(s[2], s[3]); o.z = pk2(s[4], s[5]); o.w = pk2(s[6], s[7]); *(u32x4*)dp = o; }
}
__device__ __forceinline__ void cvt_run2(const float* src, int lds_, int K, int N, bf16_t* dst, int ldd, int mode, int p0, const float* sc, LAS float* scr, int bid, int nb) {
    const int tid = tidx(), ntn = N >> 6, nt = (K >> 6) * ntn;
    for (int t = bid; t < nt; t += 2 * nb) {
        const int t2 = t + nb; const bool has2 = t2 < nt;
        const int k0 = (t / ntn) << 6, n0 = (t % ntn) << 6, k1 = has2 ? (t2 / ntn) << 6 : k0, n1 = has2 ? (t2 % ntn) << 6 : n0;
        float va[8], vb[8];
#pragma unroll
        for (int j = 0; j < 8; ++j) { const int kk = (tid >> 6) + 8 * j, nn = tid & 63; va[j] = src[(size_t)(k0 + kk) * lds_ + n0 + nn]; vb[j] = src[(size_t)(k1 + kk) * lds_ + n1 + nn]; }
#pragma unroll
        for (int j = 0; j < 8; ++j) { const int kk = (tid >> 6) + 8 * j, nn = tid & 63; scr[kk * 65 + nn] = va[j]; scr[4160 + kk * 65 + nn] = vb[j]; }
        __syncthreads();
        cvt_store(scr, tid, k0, n0, dst, ldd, mode, p0, sc);
        if (has2) cvt_store(scr + 4160, tid, k1, n1, dst, ldd, mode, p0, sc);
        __syncthreads();
    }
}
__device__ __forceinline__ void cvt_run(const float* src, int lds_, int K, int N, bf16_t* dst, int ldd, int mode, int p0, const float* sc, LAS float* scr) {
    cvt_run2(src, lds_, K, N, dst, ldd, mode, p0, sc, scr, blockIdx.x, gridDim.x);
}
__device__ __forceinline__ void zero_fill(unsigned char* p, size_t row_bytes, size_t pitch, int rows) {
    const size_t per = row_bytes / 16, tot = per * rows;
    const int ztid = tidx();
    for (size_t i = (size_t)blockIdx.x * NTHREADS + ztid; i < tot; i += (size_t)gridDim.x * NTHREADS) {
        const size_t r = i / per, c = i % per; *(u32x4*)(p + r * pitch + c * 16) = (u32x4){0u, 0u, 0u, 0u}; }
}

__device__ __forceinline__ void mod_phase(const Params& p, float* mod, LAS float* red) {
    const int tid = tidx(), kq = tid >> 4, cq = tid & 15;
    const float* c = p.in[1]; const float* cc = p.in[3]; const float* wm = p.in[4]; const float* bm = p.in[5];
    for (int it = blockIdx.x; it < NMOD / 64; it += gridDim.x) {
        const int j0 = it * 64 + 4 * cq;
        f32x4 acc[5];
#pragma unroll
        for (int b = 0; b < 5; ++b) acc[b] = (f32x4){0.f, 0.f, 0.f, 0.f};
#pragma unroll 4
        for (int i = 0; i < 32; ++i) { const int k = kq + 32 * i;
            const f32x4 w = *(const f32x4*)(wm + (size_t)k * NMOD + j0);
            acc[0] += silu_f(c[k]) * w; acc[1] += silu_f(c[D + k]) * w; acc[2] += silu_f(c[2 * D + k]) * w; acc[3] += silu_f(c[3 * D + k]) * w; acc[4] += silu_f(cc[k]) * w; }
#pragma unroll
        for (int b = 0; b < 5; ++b)
#pragma unroll
            for (int j = 0; j < 4; ++j) red[(kq * 5 + b) * 64 + 4 * cq + j] = acc[b][j];
        __syncthreads();
        if (tid < 320) { const int b = tid >> 6, cl = tid & 63; float s = 0.f;
            for (int q = 0; q < 32; ++q) s += red[(q * 5 + b) * 64 + cl];
            mod[(size_t)b * NMOD + it * 64 + cl] = s + bm[it * 64 + cl]; }
        __syncthreads();
    }
}

template <bool LATB = false> __device__ __forceinline__ void norm_phase(const float* lat, const float* ctx, int nrows, const float* g, const float* mod, int ish, int isc, bf16_t* dst, int ldd, const float* ctx2 = nullptr, const bf16_t* latb = nullptr, bf16_t* dst2 = nullptr, int mstart = 0) {
    const int tid = tidx(), lane = tid & 63, gw = blockIdx.x * 8 + (tid >> 6), ngw = gridDim.x * 8;
    for (int m0 = mstart + gw; m0 < nrows; m0 += 2 * ngw) {
        const int m1 = m0 + ngw; const bool has1 = m1 < nrows; const int mb = has1 ? m1 : m0;
        const float* srca = m0 < MLAT ? lat + (size_t)m0 * D : ctx + (size_t)(m0 - MLAT) * D;
        const float* srcb = mb < MLAT ? lat + (size_t)mb * D : ctx + (size_t)(mb - MLAT) * D;
        f32x4 va[4], vb[4]; float sa = 0.f, sb = 0.f;
#pragma unroll
        for (int j = 0; j < 4; ++j) {
            if (LATB && m0 < MLAT) { const u32x2 t = *(const u32x2*)(latb + (size_t)m0 * D + 4 * lane + 256 * j); va[j] = (f32x4){bflo(t.x), bfhi(t.x), bflo(t.y), bfhi(t.y)}; } else va[j] = *(const f32x4*)(srca + 4 * lane + 256 * j);
            if (LATB && mb < MLAT) { const u32x2 t = *(const u32x2*)(latb + (size_t)mb * D + 4 * lane + 256 * j); vb[j] = (f32x4){bflo(t.x), bfhi(t.x), bflo(t.y), bfhi(t.y)}; } else vb[j] = *(const f32x4*)(srcb + 4 * lane + 256 * j); }
        if (ctx2) {
            if (m0 >= MLAT) { _Pragma("unroll") for (int j = 0; j < 4; ++j) va[j] += *(const f32x4*)(ctx2 + (size_t)(m0 - MLAT) * D + 4 * lane + 256 * j); }
            if (mb >= MLAT) { _Pragma("unroll") for (int j = 0; j < 4; ++j) vb[j] += *(const f32x4*)(ctx2 + (size_t)(mb - MLAT) * D + 4 * lane + 256 * j); } }
#pragma unroll
        for (int j = 0; j < 4; ++j) { sa += va[j][0] * va[j][0] + va[j][1] * va[j][1] + va[j][2] * va[j][2] + va[j][3] * va[j][3]; sb += vb[j][0] * vb[j][0] + vb[j][1] * vb[j][1] + vb[j][2] * vb[j][2] + vb[j][3] * vb[j][3]; }
#pragma unroll
        for (int o = 1; o < 64; o <<= 1) { sa += __shfl_xor(sa, o); sb += __shfl_xor(sb, o); }
        const float ra = rsqrtf(sa * (1.0f / D) + 1e-6f), rb = rsqrtf(sb * (1.0f / D) + 1e-6f);
        const int ba = m0 < MLAT ? (m0 >> 12) : 4, bb = mb < MLAT ? (mb >> 12) : 4;
        const float* sha = mod + (size_t)ba * NMOD + ish * D; const float* sca = mod + (size_t)ba * NMOD + isc * D;
        const float* shb = mod + (size_t)bb * NMOD + ish * D; const float* scb = mod + (size_t)bb * NMOD + isc * D;
#pragma unroll
        for (int j = 0; j < 4; ++j) { const int c = 4 * lane + 256 * j;
            const f32x4 gg = *(const f32x4*)(g + c);
            { const f32x4 s1 = *(const f32x4*)(sha + c), s2 = *(const f32x4*)(sca + c); const f32x4 y = va[j] * ra * gg * (1.0f + s2) + s1;
              u32x2 o; o.x = pk2(y[0], y[1]); o.y = pk2(y[2], y[3]); *(u32x2*)(dst + (size_t)m0 * ldd + c) = o; if (dst2 && m0 < MLAT) *(u32x2*)(dst2 + (size_t)m0 * D + c) = o; }
            if (has1) { const f32x4 s1 = *(const f32x4*)(shb + c), s2 = *(const f32x4*)(scb + c); const f32x4 y = vb[j] * rb * gg * (1.0f + s2) + s1;
              u32x2 o; o.x = pk2(y[0], y[1]); o.y = pk2(y[2], y[3]); *(u32x2*)(dst + (size_t)m1 * ldd + c) = o; if (dst2 && m1 < MLAT) *(u32x2*)(dst2 + (size_t)m1 * D + c) = o; } }
    }
}
__device__ __forceinline__ void final_norm_phase(float* x, const float* g) {
    const int tid = tidx(), lane = tid & 63, gw = blockIdx.x * 8 + (tid >> 6), ngw = gridDim.x * 8;
    for (int m0 = gw; m0 < MLAT; m0 += 2 * ngw) {
        const int m1 = m0 + ngw; const bool has1 = m1 < MLAT;
        float* sa_ = x + (size_t)m0 * D; float* sb_ = x + (size_t)(has1 ? m1 : m0) * D;
        f32x4 va[4], vb[4]; float sa = 0.f, sb = 0.f;
#pragma unroll
        for (int j = 0; j < 4; ++j) { va[j] = *(const f32x4*)(sa_ + 4 * lane + 256 * j); vb[j] = *(const f32x4*)(sb_ + 4 * lane + 256 * j); }
#pragma unroll
        for (int j = 0; j < 4; ++j) { sa += va[j][0] * va[j][0] + va[j][1] * va[j][1] + va[j][2] * va[j][2] + va[j][3] * va[j][3]; sb += vb[j][0] * vb[j][0] + vb[j][1] * vb[j][1] + vb[j][2] * vb[j][2] + vb[j][3] * vb[j][3]; }
#pragma unroll
        for (int o = 1; o < 64; o <<= 1) { sa += __shfl_xor(sa, o); sb += __shfl_xor(sb, o); }
        const float ra = rsqrtf(sa * (1.0f / D) + 1e-6f), rb = rsqrtf(sb * (1.0f / D) + 1e-6f);
#pragma unroll
        for (int j = 0; j < 4; ++j) { const int c = 4 * lane + 256 * j; const f32x4 gg = *(const f32x4*)(g + c);
            *(f32x4*)(sa_ + c) = va[j] * ra * gg; if (has1) *(f32x4*)(sb_ + c) = vb[j] * rb * gg; }
    }
}
__device__ __forceinline__ void add4(f32x4& a, const bf16_t* p) { const u32x2 t = *(const u32x2*)p; a[0] += bflo(t.x); a[1] += bfhi(t.x); a[2] += bflo(t.y); a[3] += bfhi(t.y); }
__device__ __forceinline__ void xs_phase(bf16_t* xnxs, const bf16_t* xnp, int nrows) {
    const int tid = tidx(), lane = tid & 63, gw = blockIdx.x * 8 + (tid >> 6), ngw = gridDim.x * 8;
    for (int m = gw; m < nrows; m += ngw) {
        int n0, n1, n2, n3; bool v0, v1, v2, v3; float wgt;
        if (m < MLAT) { const int t = m & 4095, gr = t >> 6, gc = t & 63; wgt = 0.25f; v0 = gr > 0; v1 = gr < 63; v2 = gc > 0; v3 = gc < 63; n0 = m - 64; n1 = m + 64; n2 = m - 1; n3 = m + 1; }
        else { const int j = (m - MLAT) & 255; wgt = 0.5f; v0 = false; v1 = false; v2 = j > 0; v3 = j < 255; n0 = m; n1 = m; n2 = m - 1; n3 = m + 1; }
        if (!v0) n0 = m; if (!v1) n1 = m; if (!v2) n2 = m; if (!v3) n3 = m;
        const float w0 = v0 ? wgt : 0.f, w1 = v1 ? wgt : 0.f, w2 = v2 ? wgt : 0.f, w3 = v3 ? wgt : 0.f;
        const bool plain = xnp != nullptr && m < MLAT;
        const bf16_t* sb = plain ? xnp : xnxs; const size_t ld = plain ? (size_t)D : (size_t)2048;
        u32x2 q0[4], q1[4], q2[4], q3[4], qs[4];
#pragma unroll
        for (int j = 0; j < 4; ++j) { const int c = 4 * lane + 256 * j;
            q0[j] = *(const u32x2*)(sb + (size_t)n0 * ld + c); q1[j] = *(const u32x2*)(sb + (size_t)n1 * ld + c);
            q2[j] = *(const u32x2*)(sb + (size_t)n2 * ld + c); q3[j] = *(const u32x2*)(sb + (size_t)n3 * ld + c); qs[j] = *(const u32x2*)(sb + (size_t)m * ld + c); }
#pragma unroll
        for (int j = 0; j < 4; ++j) { const int c = 4 * lane + 256 * j;
            const float a0 = w0 * bflo(q0[j].x) + w1 * bflo(q1[j].x) + w2 * bflo(q2[j].x) + w3 * bflo(q3[j].x);
            const float a1 = w0 * bfhi(q0[j].x) + w1 * bfhi(q1[j].x) + w2 * bfhi(q2[j].x) + w3 * bfhi(q3[j].x);
            const float a2 = w0 * bflo(q0[j].y) + w1 * bflo(q1[j].y) + w2 * bflo(q2[j].y) + w3 * bflo(q3[j].y);
            const float a3 = w0 * bfhi(q0[j].y) + w1 * bfhi(q1[j].y) + w2 * bfhi(q2[j].y) + w3 * bfhi(q3[j].y);
            u32x2 o; o.x = pk2(a0, a1); o.y = pk2(a2, a3);
            *(u32x2*)(xnxs + (size_t)m * 2048 + 1024 + c) = o;
            if (plain) *(u32x2*)(xnxs + (size_t)m * 2048 + c) = qs[j]; }
    }
}
__device__ __forceinline__ void xs_ctx_phase(const float* c1, const float* c2, const float* g, const float* mod, bf16_t* xnxs) {
    const int tid = tidx(), lane = tid & 63, gw = (int)gridDim.x * 8 - 1 - ((int)blockIdx.x * 8 + (tid >> 6)), ngw = gridDim.x * 8;
    const float* sh = mod + (size_t)4 * NMOD + 3 * D; const float* sc = mod + (size_t)4 * NMOD + 4 * D;
    for (int r = gw; r < MCTX; r += ngw) {
        const int j = r & 255; const bool vp = j > 0, vn = j < 255;
        const int rr[3] = {vp ? r - 1 : r, r, vn ? r + 1 : r};
        f32x4 x[3][4];
#pragma unroll
        for (int q = 0; q < 3; ++q)
#pragma unroll
            for (int i = 0; i < 4; ++i) { const size_t off = (size_t)rr[q] * D + 4 * lane + 256 * i; x[q][i] = *(const f32x4*)(c1 + off) + *(const f32x4*)(c2 + off); }
        float ss[3];
#pragma unroll
        for (int q = 0; q < 3; ++q) { float t = 0.f;
#pragma unroll
            for (int i = 0; i < 4; ++i) t += (x[q][i][0] * x[q][i][0] + x[q][i][1] * x[q][i][1]) + (x[q][i][2] * x[q][i][2] + x[q][i][3] * x[q][i][3]);
            ss[q] = t; }
#pragma unroll
        for (int o = 1; o < 64; o <<= 1) { ss[0] += __shfl_xor(ss[0], o); ss[1] += __shfl_xor(ss[1], o); ss[2] += __shfl_xor(ss[2], o); }
        const float r0 = rsqrtf(ss[0] * (1.0f / D) + 1e-6f) * (vp ? 0.5f : 0.f), r1 = rsqrtf(ss[1] * (1.0f / D) + 1e-6f), r2 = rsqrtf(ss[2] * (1.0f / D) + 1e-6f) * (vn ? 0.5f : 0.f);
        const float wsh = (vp ? 0.5f : 0.f) + (vn ? 0.5f : 0.f);
#pragma unroll
        for (int i = 0; i < 4; ++i) { const int c = 4 * lane + 256 * i;
            const f32x4 mul = *(const f32x4*)(g + c) * (1.0f + *(const f32x4*)(sc + c)), s0 = *(const f32x4*)(sh + c);
            const f32x4 xn = x[1][i] * r1 * mul + s0;
            const f32x4 xs = (x[0][i] * r0 + x[2][i] * r2) * mul + wsh * s0;
            u32x2 o; o.x = pk2(xn[0], xn[1]); o.y = pk2(xn[2], xn[3]); *(u32x2*)(xnxs + (size_t)(MLAT + r) * 2048 + c) = o;
            o.x = pk2(xs[0], xs[1]); o.y = pk2(xs[2], xs[3]); *(u32x2*)(xnxs + (size_t)(MLAT + r) * 2048 + 1024 + c) = o; }
    }
}
__device__ __forceinline__ void conv_phase(const bf16_t* plx, const bf16_t* plxc, bf16_t* xc, const float* cw, const float* cb) {
    const int tid = tidx(), lane = tid & 63, gw = blockIdx.x * 8 + (tid >> 6), ngw = gridDim.x * 8;
    for (int m = gw; m < MALL; m += ngw) {
        int t, len; if (m < MLAT) { t = m & 4095; len = 4096; } else { t = (m - MLAT) & 255; len = 256; }
        const bf16_t* pb = m < MLAT ? plx : plxc - (size_t)MLAT * D;
        int rq[4]; float wq[4];
#pragma unroll
        for (int q = 0; q < 4; ++q) { const int tt = t + q - 1; const bool ok = tt >= 0 && tt < len; rq[q] = ok ? m + q - 1 : m; wq[q] = ok ? 1.f : 0.f; }
        u32x2 x[4][4];
#pragma unroll
        for (int q = 0; q < 4; ++q)
#pragma unroll
            for (int j = 0; j < 4; ++j) x[q][j] = *(const u32x2*)(pb + (size_t)rq[q] * D + 4 * lane + 256 * j);
#pragma unroll
        for (int j = 0; j < 4; ++j) { const int c = 4 * lane + 256 * j; f32x4 a = *(const f32x4*)(cb + c);
#pragma unroll
            for (int q = 0; q < 4; ++q) { const f32x4 w = *(const f32x4*)(cw + q * D + c) * wq[q];
                a[0] += w[0] * bflo(x[q][j].x); a[1] += w[1] * bfhi(x[q][j].x); a[2] += w[2] * bflo(x[q][j].y); a[3] += w[3] * bfhi(x[q][j].y); }
            u32x2 o; o.x = pk2(a[0], a[1]); o.y = pk2(a[2], a[3]);
            *(u32x2*)(xc + (size_t)m * D + c) = o; }
    }
}
__device__ __forceinline__ void rncb_phase(const bf16_t* R, const bf16_t* Kk, const float* k_k, const float* r_k, float* rn, float* cbv) {
    const int tid = tidx(), g16 = (blockIdx.x * NTHREADS + tid) >> 4, ng = (gridDim.x * NTHREADS) >> 4, l = tid & 15;
    for (int it0 = g16; it0 < MALL * 16; it0 += 4 * ng) {
        u32x2 kv[4], rv[4];
#pragma unroll
        for (int u = 0; u < 4; ++u) { const int it = it0 + u * ng; kv[u] = (u32x2){0u, 0u}; rv[u] = (u32x2){0u, 0u};
            if (it < MALL * 16) { const size_t off = (size_t)(it >> 4) * D + (it & 15) * 64 + 4 * l; kv[u] = *(const u32x2*)(Kk + off); rv[u] = *(const u32x2*)(R + off); } }
#pragma unroll
        for (int u = 0; u < 4; ++u) { const int it = it0 + u * ng;
            if (it < MALL * 16) { const int c = (it & 15) * 64 + 4 * l;
                const f32x4 kk = *(const f32x4*)(k_k + c), rk = *(const f32x4*)(r_k + c);
                const float k0 = bflo(kv[u].x), k1 = bfhi(kv[u].x), k2 = bflo(kv[u].y), k3 = bfhi(kv[u].y);
                float s1 = k0 * kk[0] * k0 * kk[0] + k1 * kk[1] * k1 * kk[1] + k2 * kk[2] * k2 * kk[2] + k3 * kk[3] * k3 * kk[3];
                float s2 = bflo(rv[u].x) * k0 * rk[0] + bfhi(rv[u].x) * k1 * rk[1] + bflo(rv[u].y) * k2 * rk[2] + bfhi(rv[u].y) * k3 * rk[3];
                s1 = red16(s1); s2 = red16(s2);
                if (l == 0) { rn[it] = __builtin_amdgcn_rsqf(fmaxf(s1, 1e-24f)); cbv[it] = s2; } } }
    }
}
__device__ __forceinline__ void post_phase(bf16_t* YF, const bf16_t* YB, const bf16_t* V, const float* cbv, const float* lnw, const float* lnb) {
    const int tid = tidx(), g16 = (blockIdx.x * NTHREADS + tid) >> 4, ng = (gridDim.x * NTHREADS) >> 4, l = tid & 15;
    for (int it0 = g16; it0 < MLAT * 16; it0 += 4 * ng) {
        u32x2 av[4], bv[4], vv[4]; float cbs[4];
#pragma unroll
        for (int u = 0; u < 4; ++u) { const int it = it0 + u * ng; av[u] = (u32x2){0u, 0u}; bv[u] = av[u]; vv[u] = av[u]; cbs[u] = 0.f;
            if (it < MLAT * 16) { const size_t off = (size_t)(it >> 4) * D + (it & 15) * 64 + 4 * l; av[u] = *(const u32x2*)(YF + off); bv[u] = *(const u32x2*)(YB + off); vv[u] = *(const u32x2*)(V + off); cbs[u] = cbv[it]; } }
#pragma unroll
        for (int u = 0; u < 4; ++u) { const int it = it0 + u * ng;
            if (it < MLAT * 16) { const int c = (it & 15) * 64 + 4 * l; const size_t off = (size_t)(it >> 4) * D + c;
                float y[4] = {bflo(av[u].x) + bflo(bv[u].x), bfhi(av[u].x) + bfhi(bv[u].x), bflo(av[u].y) + bflo(bv[u].y), bfhi(av[u].y) + bfhi(bv[u].y)};
                const float mu = red16(y[0] + y[1] + y[2] + y[3]) * (1.0f / 64.0f);
                float q = 0.f;
#pragma unroll
                for (int j = 0; j < 4; ++j) { y[j] -= mu; q += y[j] * y[j]; }
                const float rs = rsqrtf(red16(q) * (1.0f / 64.0f) + 64e-5f);
                const f32x4 w = *(const f32x4*)(lnw + c), bb = *(const f32x4*)(lnb + c);
                const float v4[4] = {bflo(vv[u].x), bfhi(vv[u].x), bflo(vv[u].y), bfhi(vv[u].y)};
                float o[4];
#pragma unroll
                for (int j = 0; j < 4; ++j) o[j] = y[j] * rs * w[j] + bb[j] + cbs[u] * v4[j];
                u32x2 ov; ov.x = pk2(o[0], o[1]); ov.y = pk2(o[2], o[3]);
                *(u32x2*)(YF + off) = ov; } }
    }
}

constexpr int RS_STRIDE = 324;
constexpr int RS_BUF = 32 * RS_STRIDE + 1024 + 4096;
__device__ __forceinline__ int scan_row(int b, int dir, int s) {
    if (s < 256) return MLAT + b * 256 + (dir ? 255 - s : s);
    return b * 4096 + (dir ? 4095 - (s - 256) : (s - 256));
}
struct ScanIn { bf16x8 afr[2][2]; unsigned short xv[8]; float rnv[8]; unsigned vpair; };
__device__ __forceinline__ void rwkv_scan_phase(const Params& p, LAS float* lds) {
    unsigned char* ws = p.ws;
    const bf16_t* R = (const bf16_t*)(ws + O_R); const bf16_t* Kk = (const bf16_t*)(ws + O_K); const bf16_t* V = (const bf16_t*)(ws + O_V);
    const bf16_t* LIN = (const bf16_t*)(ws + O_LIN); const float* rn = (const float*)(ws + O_RN);
    const int tid = tidx(), lane = tid & 63, w = __builtin_amdgcn_readfirstlane(tid >> 6), fr = lane & 15, fq = lane >> 4;
    const int cgp = lane & 15, rw = lane >> 4;
    for (int unit = blockIdx.x; unit < 256; unit += gridDim.x) {
        const int xcd = unit & 7, slot = unit >> 3, half = slot & 1, chain = (slot >> 1) * 8 + xcd, dir = chain & 1, h = (chain >> 1) & 15, b = chain >> 5;
        bf16_t* Y = (bf16_t*)(ws + (dir ? O_YB : O_YF));
        const int lora = w >> 2, ct = w & 3, col = h * 64 + 16 * ct + fr;
        bf16x8 bfr[2];
        { const bf16_t* wt = (const bf16_t*)(ws + (lora ? O_LSCA : O_LSCW)) + (size_t)(dir * 1024 + col) * 64 + 8 * fq;
          bfr[0] = *(const bf16x8*)(wt); bfr[1] = *(const bf16x8*)(wt + 32); }
        const float c_bias = lora ? p.in[15][dir * D + col] : p.in[13][dir * D + col];
        const float c_kk = p.in[18][col], c_ka = p.in[19][col];
        const int lcol0 = (lora ? 128 : 0) + dir * 64;
        const int sgn = dir ? -1 : 1;
        f32x2 SA = (f32x2){0.f, 0.f}, SB = (f32x2){0.f, 0.f};
        ScanIn in;
#define SCAN_LOAD(c) do { const int m0 = scan_row(b, dir, 32 * (c)); \
            _Pragma("unroll") for (int tt = 0; tt < 2; ++tt) { const size_t mr = (size_t)(m0 + sgn * (16 * tt + fr)); \
                _Pragma("unroll") for (int ks = 0; ks < 2; ++ks) in.afr[tt][ks] = *(const bf16x8*)(LIN + mr * 256 + lcol0 + 32 * ks + 8 * fq); } \
            _Pragma("unroll") for (int tt = 0; tt < 2; ++tt) _Pragma("unroll") for (int j = 0; j < 4; ++j) { const size_t mr = (size_t)(m0 + sgn * (16 * tt + 4 * fq + j)); \
                in.xv[tt * 4 + j] = (lora ? Kk : R)[mr * D + col]; in.rnv[tt * 4 + j] = rn[mr * 16 + h]; } \
            { const size_t mr = (size_t)(m0 + sgn * (tid >> 4)); in.vpair = *(const unsigned*)(V + mr * D + h * 64 + half * 32 + 2 * (tid & 15)); } } while (0)
#define SCAN_PRODUCE(bufi) do { LAS float* sb = lds + (bufi) * RS_BUF; \
            _Pragma("unroll") for (int tt = 0; tt < 2; ++tt) { f32x4 acc = (f32x4){0.f, 0.f, 0.f, 0.f}; \
                acc = __builtin_amdgcn_mfma_f32_16x16x32_bf16(in.afr[tt][0], bfr[0], acc, 0, 0, 0); acc = __builtin_amdgcn_mfma_f32_16x16x32_bf16(in.afr[tt][1], bfr[1], acc, 0, 0, 0); \
                _Pragma("unroll") for (int j = 0; j < 4; ++j) { LAS float* rec = sb + (16 * tt + 4 * fq + j) * RS_STRIDE + 16 * ct + fr; const float x = bf2f(in.xv[tt * 4 + j]); \
                    if (lora == 0) { rec[0] = __expf(-0.60653066f * sigm(c_bias + acc[j])); rec[256] = x; } \
                    else { const float a = sigm(c_bias + acc[j]), kkv = x * c_kk * in.rnv[tt * 4 + j]; rec[64] = x * (1.0f + (a - 1.0f) * c_ka); rec[128] = -kkv; rec[192] = kkv * a; } } } \
            { LAS float* vb = sb + 32 * RS_STRIDE + (tid >> 4) * 32 + 2 * (tid & 15); vb[0] = bflo(in.vpair); vb[1] = bfhi(in.vpair); } } while (0)
#define SCAN_YOUT(c, bufi) do { if ((c) >= 8) { const LAS float* yb_ = lds + (bufi) * RS_BUF + 32 * RS_STRIDE + 1024 + ((tid >> 4) * 32 + 2 * (tid & 15)) * 4; \
            const f32x4 ya = *(const LAS f32x4*)(yb_), yc = *(const LAS f32x4*)(yb_ + 4); \
            const size_t mr = (size_t)(scan_row(b, dir, 32 * (c)) + sgn * (tid >> 4)); \
            *(unsigned*)(Y + mr * D + h * 64 + half * 32 + 2 * (tid & 15)) = pk2((ya[0] + ya[1]) + (ya[2] + ya[3]), (yc[0] + yc[1]) + (yc[2] + yc[3])); } } while (0)
        SCAN_LOAD(0);
        SCAN_PRODUCE(0);
        __syncthreads();
        for (int c = 0; c < 136; ++c) {
            const int cur = c & 1;
            if (c + 1 < 136) SCAN_LOAD(c + 1);
            if (c > 0 && w >= 4) SCAN_YOUT(c - 1, cur ^ 1);
            const LAS float* sp0 = lds + cur * RS_BUF + 4 * cgp;
            const LAS float* vb = lds + cur * RS_BUF + 32 * RS_STRIDE + w * 4 + rw;
            LAS float* yb = lds + cur * RS_BUF + 32 * RS_STRIDE + 1024 + (w * 4 + rw) * 4 + (cgp >> 2);
            f32x4 w4 = *(const LAS f32x4*)(sp0), kd4 = *(const LAS f32x4*)(sp0 + 64), ka4 = *(const LAS f32x4*)(sp0 + 192), r4 = *(const LAS f32x4*)(sp0 + 256);
            f32x4 nk1 = *(const LAS f32x4*)(sp0 + RS_STRIDE + 128);
            float vv = vb[0];
            float sa;
            { const f32x4 nk0 = *(const LAS f32x4*)(sp0 + 128); const f32x2 q = SA * (f32x2){nk0[0], nk0[1]} + SB * (f32x2){nk0[2], nk0[3]}; sa = red16(q[0] + q[1]); }
#define SCAN_STEPS(i0, cnt, YON) _Pragma("unroll") for (int ii = 0; ii < (cnt); ++ii) { const int i = (i0) + ii; \
                f32x4 w4n = w4, kd4n = kd4, ka4n = ka4, r4n = r4, nk2 = nk1; float vvn = vv; \
                if (i + 1 < 32) { const LAS float* spn = sp0 + (i + 1) * RS_STRIDE; \
                    w4n = *(const LAS f32x4*)(spn); kd4n = *(const LAS f32x4*)(spn + 64); ka4n = *(const LAS f32x4*)(spn + 192); r4n = *(const LAS f32x4*)(spn + 256); vvn = vb[(i + 1) * 32]; } \
                if (i + 2 < 32) nk2 = *(const LAS f32x4*)(sp0 + (i + 2) * RS_STRIDE + 128); \
                { const f32x2 ba = SA * (f32x2){w4[0], w4[1]} + vv * (f32x2){kd4[0], kd4[1]}, bb = SB * (f32x2){w4[2], w4[3]} + vv * (f32x2){kd4[2], kd4[3]};     \
                  SA = sa * (f32x2){ka4[0], ka4[1]} + ba; SB = sa * (f32x2){ka4[2], ka4[3]} + bb; }                                                     \
                float sn = 0.f; \
                if (i + 1 < 32) { const f32x2 ps = SA * (f32x2){nk1[0], nk1[1]} + SB * (f32x2){nk1[2], nk1[3]}; sn = ps[0] + ps[1]; } \
                if (YON) { const f32x2 py = SA * (f32x2){r4[0], r4[1]} + SB * (f32x2){r4[2], r4[3]}; float yp = py[0] + py[1]; \
                    sn += dppf<0xB1>(sn); yp += dppf<0xB1>(yp); sn += dppf<0x4E>(sn); yp += dppf<0x4E>(yp); sn += dppf<0x141>(sn); sn += dppf<0x140>(sn); \
                    if ((cgp & 3) == 0) yb[i * 128] = yp; } \
                else { sn += dppf<0xB1>(sn); sn += dppf<0x4E>(sn); sn += dppf<0x141>(sn); sn += dppf<0x140>(sn); }     \
                sa = sn; w4 = w4n; kd4 = kd4n; ka4 = ka4n; r4 = r4n; vv = vvn; nk1 = nk2; }
            __builtin_amdgcn_s_setprio(2);
#define SCAN_CHUNK(YON) \
            SCAN_STEPS(0, 8, YON) \
            if (c + 1 < 136 && w < 4) { __builtin_amdgcn_s_setprio(0); SCAN_PRODUCE(cur ^ 1); __builtin_amdgcn_s_setprio(2); }     \
            SCAN_STEPS(8, 8, YON) \
            if (c > 0 && w < 4) SCAN_YOUT(c - 1, cur ^ 1); \
            SCAN_STEPS(16, 8, YON) \
            if (c + 1 < 136 && w >= 4) { __builtin_amdgcn_s_setprio(0); SCAN_PRODUCE(cur ^ 1); __builtin_amdgcn_s_setprio(2); } \
            SCAN_STEPS(24, 8, YON)
            if (c < 8) { SCAN_CHUNK(false) } else { SCAN_CHUNK(true) }
#undef SCAN_CHUNK
            __builtin_amdgcn_s_setprio(0);
#undef SCAN_STEPS
            __syncthreads();
        }
        SCAN_YOUT(135, 1);
        __syncthreads();
#undef SCAN_LOAD
#undef SCAN_PRODUCE
#undef SCAN_YOUT
    }
}

__device__ __forceinline__ void lru_p1_phase(const Params& p) {
    unsigned char* ws = p.ws; const float* lam = (const float*)(ws + O_CL);
    float* PQ = (float*)(ws + O_PQ);
    const int tid = tidx(), lane = tid & 63, half = lane >> 5, l32 = lane & 31, gw = blockIdx.x * 8 + (tid >> 6), ngw = gridDim.x * 8;
    for (int it = gw; it < 2 * 4 * 68 * 16; it += ngw) {
        const int cb16 = it & 15, j = (it >> 4) % 68, b = ((it >> 4) / 68) & 3, d = (it >> 4) / 272;
        const int c = cb16 * 64 + 2 * l32;
        const bf16_t* GR = (const bf16_t*)(ws + (d ? O_GRB : O_GRF)); const bf16_t* UU = (const bf16_t*)(ws + (d ? O_UB : O_UF));
        const float cl0 = lam[d * D + c], cl1 = lam[d * D + c + 1];
        float P0 = 1.f, P1 = 1.f, Q0 = 0.f, Q1 = 0.f;
        const int sgn = d ? -1 : 1, m0 = scan_row(b, d, 64 * j) + sgn * 32 * half;
#pragma unroll 8
        for (int i = 0; i < 32; ++i) { const size_t off = (size_t)(m0 + sgn * i) * D + c;
            const unsigned g = *(const unsigned*)(GR + off), uv = *(const unsigned*)(UU + off);
            const float a0 = __expf(bflo(g) * cl0), a1 = __expf(bfhi(g) * cl1);
            P0 *= a0; P1 *= a1; Q0 = a0 * Q0 + bflo(uv); Q1 = a1 * Q1 + bfhi(uv); }
        const float oP0 = __shfl_xor(P0, 32), oP1 = __shfl_xor(P1, 32), oQ0 = __shfl_xor(Q0, 32), oQ1 = __shfl_xor(Q1, 32);
        if (half == 0) { const size_t o = ((size_t)((d * 4 + b) * 68 + j)) * D + c;
            *(f32x2*)(PQ + o) = (f32x2){P0 * oP0, P1 * oP1}; *(f32x2*)(PQ + (size_t)2 * 4 * 68 * D + o) = (f32x2){oP0 * Q0 + oQ0, oP1 * Q1 + oQ1}; }
    }
}
__device__ __forceinline__ void lru_p3_phase(const Params& p) {
    unsigned char* ws = p.ws; const float* lam = (const float*)(ws + O_CL);
    const float* PQ = (const float*)(ws + O_PQ); const float* QQ = PQ + (size_t)2 * 4 * 68 * D;
    bf16_t* HS = (bf16_t*)(ws + O_HSUM);
    const int tid = tidx(), lane = tid & 63, gw = blockIdx.x * 8 + (tid >> 6), ngw = gridDim.x * 8;
    for (int it = gw; it < 4 * 64 * 8; it += ngw) {
        const int cb8 = it & 7, T = (it >> 3) & 63, b = it >> 9, c = cb8 * 128 + 2 * lane;
        {
            const bf16_t* GR = (const bf16_t*)(ws + O_GRF); const bf16_t* UU = (const bf16_t*)(ws + O_UF);
            const float cl0 = lam[c], cl1 = lam[c + 1];
            float h0 = 0.f, h1 = 0.f;
#pragma unroll 8
            for (int jj = 0; jj < 4 + T; ++jj) { const size_t o = ((size_t)(b * 68 + jj)) * D + c; const f32x2 P = *(const f32x2*)(PQ + o), Q = *(const f32x2*)(QQ + o); h0 = P[0] * h0 + Q[0]; h1 = P[1] * h1 + Q[1]; }
            for (int i0 = 0; i0 < 64; i0 += 8) {
                unsigned g[8], uv[8];
#pragma unroll
                for (int i = 0; i < 8; ++i) { const size_t off = (size_t)(b * 4096 + 64 * T + i0 + i) * D + c; g[i] = *(const unsigned*)(GR + off); uv[i] = *(const unsigned*)(UU + off); }
#pragma unroll
                for (int i = 0; i < 8; ++i) { const size_t off = (size_t)(b * 4096 + 64 * T + i0 + i) * D + c;
                    h0 = __expf(bflo(g[i]) * cl0) * h0 + bflo(uv[i]); h1 = __expf(bfhi(g[i]) * cl1) * h1 + bfhi(uv[i]);
                    *(unsigned*)(HS + off) = pk2(h0, h1); }
            }
        }
        {
            const bf16_t* GR = (const bf16_t*)(ws + O_GRB); const bf16_t* UU = (const bf16_t*)(ws + O_UB);
            const float cl0 = lam[D + c], cl1 = lam[D + c + 1];
            float h0 = 0.f, h1 = 0.f;
#pragma unroll 8
            for (int jj = 0; jj < 67 - T; ++jj) { const size_t o = ((size_t)((4 + b) * 68 + jj)) * D + c; const f32x2 P = *(const f32x2*)(PQ + o), Q = *(const f32x2*)(QQ + o); h0 = P[0] * h0 + Q[0]; h1 = P[1] * h1 + Q[1]; }
            for (int i0 = 0; i0 < 64; i0 += 8) {
                unsigned g[8], uv[8], f[8];
#pragma unroll
                for (int i = 0; i < 8; ++i) { const size_t off = (size_t)(b * 4096 + 64 * T + 63 - i0 - i) * D + c; g[i] = *(const unsigned*)(GR + off); uv[i] = *(const unsigned*)(UU + off); f[i] = *(const unsigned*)(HS + off); }
#pragma unroll
                for (int i = 0; i < 8; ++i) { const size_t off = (size_t)(b * 4096 + 64 * T + 63 - i0 - i) * D + c;
                    h0 = __expf(bflo(g[i]) * cl0) * h0 + bflo(uv[i]); h1 = __expf(bfhi(g[i]) * cl1) * h1 + bfhi(uv[i]);
                    *(unsigned*)(HS + off) = pk2(bflo(f[i]) + h0, bfhi(f[i]) + h1); }
            }
        }
    }
}

#define XB_XCNT(j) (64 * (j))
#define XB_XSUB(j) (1024 + 64 * (j))
#define XB_XGEN(j) (2048 + 64 * (j))
#define XB_TOP 3072
#define XB_TOPGEN 3136
#define XB_WORDS 3200
__device__ __forceinline__ unsigned xb_ld(unsigned* p) { return __hip_atomic_load(p, __ATOMIC_RELAXED, __HIP_MEMORY_SCOPE_AGENT); }
__device__ __forceinline__ unsigned xb_add(unsigned* p, unsigned v) { return __hip_atomic_fetch_add(p, v, __ATOMIC_RELAXED, __HIP_MEMORY_SCOPE_AGENT); }
__device__ __forceinline__ void xb_st(unsigned* p, unsigned v) { __hip_atomic_store(p, v, __ATOMIC_RELAXED, __HIP_MEMORY_SCOPE_AGENT); }
struct XBar { unsigned* bar; unsigned x, nloc, nx, k; };
__device__ __forceinline__ void xbar_init(XBar& B, unsigned* bar) {
    B.bar = bar; B.x = (unsigned)__builtin_amdgcn_s_getreg((3 << 11) | 20) & 0xFu; B.nloc = 0u; B.nx = 0u; B.k = 0u;
    if (threadIdx.x == 0) (void)xb_add(&bar[XB_XCNT(B.x)], 1u);
}
__device__ __forceinline__ void gbar(XBar& B) {
    asm volatile("s_waitcnt vmcnt(0)" ::: "memory");
    __syncthreads();
    B.k += 1u;
    if (threadIdx.x == 0) {
        unsigned* bar = B.bar;
        if (B.nloc == 0u) {
            unsigned sum, cnt, mine;
            for (;;) { sum = 0u; cnt = 0u; mine = 0u;
#pragma unroll
                for (unsigned j = 0; j < 16; ++j) { const unsigned c = xb_ld(&bar[XB_XCNT(j)]); sum += c; cnt += (c > 0u) ? 1u : 0u; mine = (j == B.x) ? c : mine; }
                if (sum == gridDim.x) break;
                __builtin_amdgcn_s_sleep(1); }
            B.nloc = mine; B.nx = cnt;
        }
        const unsigned old = xb_add(&bar[XB_XSUB(B.x)], 1u);
        if (old + 1u == B.k * B.nloc) {
            __builtin_amdgcn_fence(__ATOMIC_RELEASE, "agent");
            asm volatile("s_waitcnt vmcnt(0)" ::: "memory");
            const unsigned t = xb_add(&bar[XB_TOP], 1u);
            if (t + 1u == B.k * B.nx) xb_st(&bar[XB_TOPGEN], B.k);
            else while (xb_ld(&bar[XB_TOPGEN]) < B.k) __builtin_amdgcn_s_sleep(1);
        } else {
            while (xb_ld(&bar[XB_TOPGEN]) < B.k) __builtin_amdgcn_s_sleep(1);
        }
        __builtin_amdgcn_fence(__ATOMIC_ACQUIRE, "agent");
        asm volatile("s_waitcnt vmcnt(0)" ::: "memory");
    }
    __syncthreads();
}

__device__ __forceinline__ Gemm mk_gemm(const void* A, const void* Bt, int M, int N, int K, int lda, int ldb) { Gemm g; g.A = (const bf16_t*)A; g.Bt = (const bf16_t*)Bt; g.M = M; g.N = N; g.K = K; g.lda = lda; g.ldb = ldb; g.ksh = 0; g.kmask = 0; g.kmul = 0; return g; }

__global__ void __launch_bounds__(NTHREADS, 2) mega(Params p) {
    extern __shared__ __attribute__((aligned(16))) unsigned char shm[];
    LAS unsigned char* lds = (LAS unsigned char*)shm;
    LAS float* ldsf = (LAS float*)shm;
    cg::grid_group grid = cg::this_grid();
    unsigned char* ws = p.ws;
    float* mod = (float*)(ws + O_MOD);
    bf16_t* X1B = (bf16_t*)p.out;
    bf16_t* XNP = (bf16_t*)p.out + (size_t)MLAT * D;
    pg8::StaticOrder S;
    XBar XB; xbar_init(XB, (unsigned*)(ws + O_BAR));
#define BF(off) ((bf16_t*)(ws + (off)))
#define GSYNC() gbar(XB)
    if (p.ws == nullptr) grid.sync();
    cvt_run(p.in[7], DFF, D, DFF, BF(O_UP1), D, CV_UPI, 0, nullptr, ldsf);
    cvt_run(p.in[8], DFF, D, DFF, BF(O_UP1), D, CV_UPI, 1, nullptr, ldsf);
    cvt_run(p.in[9], D, DFF, D, BF(O_DN1), DFF, CV_PLAIN, 0, nullptr, ldsf);
    mod_phase(p, mod, ldsf);
    GSYNC();
    norm_phase(p.in[0], p.in[2], MALL, p.in[6], mod, 0, 1, BF(O_HN), D);
    GSYNC();
    { S.init(MALL, 2 * DFF, gridDim.x, blockIdx.x); EpiUp E{BF(O_U)}; pg8::gemm_phase(lds, mk_gemm(BF(O_HN), BF(O_UP1), MALL, 2 * DFF, D, D, D), S, E); }
    GSYNC();
    const bool fuse_ok = gridDim.x == 256;
    if (fuse_ok) { S.init(MLAT, D, gridDim.x, blockIdx.x); EpiDn1Norm E{p.in[0], X1B, BF(O_XNXS), XNP, mod, p.in[10], RowX{(unsigned*)(ws + O_XSLOT_C), (unsigned*)(ws + O_XCNT_C)}};
        pg8::gemm_phase(lds, mk_gemm(BF(O_U), BF(O_DN1), MLAT, D, DFF, DFF, DFF), S, E); }
    else { S.init(MLAT, D, gridDim.x, blockIdx.x); EpiRes<false, true> E{p.in[0], nullptr, nullptr, X1B, mod, 2, 0.5f}; pg8::gemm_phase(lds, mk_gemm(BF(O_U), BF(O_DN1), MLAT, D, DFF, DFF, DFF), S, E); }
    { const float* gate = mod + (size_t)4 * NMOD + 2 * D; const bf16_t* Uc = BF(O_U) + (size_t)MLAT * DFF;
      { S.init(MCTX, D, gridDim.x, blockIdx.x); EpiCtx E{p.in[2], (float*)(ws + O_CTXX1), gate, 0.5f}; pg8::gemm_phase(lds, mk_gemm(Uc, BF(O_DN1), MCTX, D, DFF / 2, DFF, DFF), S, E); }
      { S.init(MCTX, D, gridDim.x, ((int)blockIdx.x + (int)gridDim.x - 16) % (int)gridDim.x); EpiCtx E{nullptr, (float*)(ws + O_CTXP2), gate, 0.5f}; pg8::gemm_phase(lds, mk_gemm(Uc + DFF / 2, BF(O_DN1) + DFF / 2, MCTX, D, DFF / 2, DFF, DFF), S, E); } }
    { const int cnb = gridDim.x > 64 ? (int)gridDim.x - 32 : (int)gridDim.x, cbid = gridDim.x > 64 ? (int)blockIdx.x - 32 : (int)blockIdx.x;
      if (cbid >= 0) {
        cvt_run2(p.in[11], 7552, D, 3456, BF(O_RW), 2048, CV_RW, 0, p.in[12], ldsf, cbid, cnb);
        for (int d = 0; d < 2; ++d) { cvt_run2(p.in[14] + (size_t)d * 64 * D, D, 64, D, BF(O_LSCW) + (size_t)d * D * 64, 64, CV_PLAIN, 0, nullptr, ldsf, cbid, cnb);
                                      cvt_run2(p.in[16] + (size_t)d * 64 * D, D, 64, D, BF(O_LSCA) + (size_t)d * D * 64, 64, CV_PLAIN, 0, nullptr, ldsf, cbid, cnb); }
        cvt_run2(p.in[17], D, 128, D, BF(O_GUP), 256, CV_PLAIN, 0, nullptr, ldsf, cbid, cnb);
        cvt_run2(p.in[11] + 3456, 7552, D, D, BF(O_LX), D, CV_PLAIN, 0, nullptr, ldsf, cbid, cnb);
        for (int q = 0; q < 8; ++q) { cvt_run2(p.in[27] + (size_t)q * 65536, 256, 256, 256, BF(O_LRUW), 256, CV_LRU, q * 2 + 0, nullptr, ldsf, cbid, cnb);
                                      cvt_run2(p.in[29] + (size_t)q * 65536, 256, 256, 256, BF(O_LRUW), 256, CV_LRU, q * 2 + 1, nullptr, ldsf, cbid, cnb); }
      } }
    zero_fill(ws + O_RW + (size_t)3456 * 2048 * 2, 128 * 2048 * 2, 128 * 2048 * 2, 1);
    zero_fill(ws + O_GUP + 256, 256, 512, 1024);
    { const int t = tidx(); if (blockIdx.x == 20) for (int i = t; i < 2 * D; i += NTHREADS) ((float*)(ws + O_CL))[i] = -8.0f * log1pf(expf(-p.in[26][i])); }
    GSYNC();
    if (fuse_ok) {
        xs_phase(BF(O_XNXS), XNP, MLAT);
        xs_ctx_phase((const float*)(ws + O_CTXX1), (const float*)(ws + O_CTXP2), p.in[10], mod, BF(O_XNXS));
    } else {
        norm_phase<true>(p.in[0], (const float*)(ws + O_CTXX1), MALL, p.in[10], mod, 3, 4, BF(O_XNXS), 2048, (const float*)(ws + O_CTXP2), X1B, XNP, 0);
        GSYNC();
        xs_phase(BF(O_XNXS), nullptr, MALL);
    }
    GSYNC();
    { S.init(MALL, 3584, gridDim.x, blockIdx.x); EpiRw E{BF(O_R), BF(O_LIN), BF(O_GD)}; pg8::gemm_phase(lds, mk_gemm(BF(O_XNXS), BF(O_RW), MALL, 3584, 2048, 2048, 2048), S, E); }
    { const int sh = ((MALL / 256) * 14) % (int)gridDim.x; S.init(MCTX, D, gridDim.x, ((int)blockIdx.x + (int)gridDim.x - sh) % (int)gridDim.x); EpiBf E{BF(O_PLXC), D};
      pg8::gemm_phase(lds, mk_gemm(BF(O_XNXS) + (size_t)MLAT * 2048, BF(O_LX), MCTX, D, D, 2048, D), S, E); }
    GSYNC();
    rncb_phase(BF(O_R), BF(O_K), p.in[18], p.in[20], (float*)(ws + O_RN), (float*)(ws + O_CB));
    cvt_run(p.in[11] + 4480, 7552, D, 3072, BF(O_LATE), D, CV_PLAIN, 0, nullptr, ldsf);
    cvt_run(p.in[23], D, D, D, BF(O_PRW), D, CV_PLAIN, 0, nullptr, ldsf);
    cvt_run(p.in[31], D, D, D, BF(O_PLRU), D, CV_PLAIN, 0, nullptr, ldsf);
    cvt_run(p.in[32], D, D, D, BF(O_WOUT), D, CV_PLAIN, 0, nullptr, ldsf);
    cvt_run(p.in[36], D, DFF, D, BF(O_DN2), DFF, CV_PLAIN, 0, nullptr, ldsf);
    GSYNC();
    rwkv_scan_phase(p, ldsf);
    GSYNC();
    if (gridDim.x == 256) {
        S.init(MLAT, D, gridDim.x, blockIdx.x); EpiPostG E{BF(O_YF), BF(O_YB), BF(O_V), (const float*)(ws + O_CB), p.in[21], p.in[22]};
        pg8::gemm_phase(lds, mk_gemm(BF(O_GD), BF(O_GUP), MLAT, D, 256, 256, 256), S, E);
    } else {
        post_phase(BF(O_YF), BF(O_YB), BF(O_V), (const float*)(ws + O_CB), p.in[21], p.in[22]);
        GSYNC();
        { S.init(MLAT, D, gridDim.x, blockIdx.x); EpiMul E{BF(O_YF), nullptr, 0}; pg8::gemm_phase(lds, mk_gemm(BF(O_GD), BF(O_GUP), MLAT, D, 256, 256, 256), S, E); }
    }
    { S.init(MLAT, D, gridDim.x, blockIdx.x); EpiBf E{BF(O_PLX), D}; pg8::gemm_phase(lds, mk_gemm(XNP, BF(O_LX), MLAT, D, D, D, D), S, E); }
    GSYNC();
    conv_phase(BF(O_PLX), BF(O_PLXC), BF(O_XC), p.in[24], p.in[25]);
    GSYNC();
    { S.init(MALL, 4096, gridDim.x, blockIdx.x); EpiLru E{BF(O_XC), BF(O_GRF), BF(O_UF), BF(O_GRB), BF(O_UB), p.in[28], p.in[30], (const float*)(ws + O_CL)};
      Gemm g = mk_gemm(BF(O_XC), BF(O_LRUW), MALL, 4096, 256, D, 256); g.ksh = 1; g.kmask = 3; g.kmul = 256; pg8::gemm_phase(lds, g, S, E); }
    GSYNC();
    lru_p1_phase(p);
    cvt_run(p.in[34], DFF, D, DFF, BF(O_UP2), D, CV_UPI, 0, nullptr, ldsf);
    cvt_run(p.in[35], DFF, D, DFF, BF(O_UP2), D, CV_UPI, 1, nullptr, ldsf);
    GSYNC();
    lru_p3_phase(p);
    GSYNC();
    { S.init(MLAT, 3072, gridDim.x, blockIdx.x); EpiLate E{BF(O_HSUM), BF(O_SMRW), BF(O_SMLRU)}; pg8::gemm_phase(lds, mk_gemm(XNP, BF(O_LATE), MLAT, 3072, D, D, D), S, E); }
    GSYNC();
    { S.init(MLAT, D, gridDim.x, blockIdx.x); EpiMul E{BF(O_SMRW), nullptr, 0}; pg8::gemm_phase(lds, mk_gemm(BF(O_YF), BF(O_PRW), MLAT, D, D, D, D), S, E); }
    { S.init(MLAT, D, gridDim.x, blockIdx.x); EpiMul E{BF(O_SMRW), BF(O_SMLRU), 1}; pg8::gemm_phase(lds, mk_gemm(BF(O_HSUM), BF(O_PLRU), MLAT, D, D, D, D), S, E); }
    GSYNC();
    if (gridDim.x == 256) {
        S.init(MLAT, D, gridDim.x, blockIdx.x); EpiOutNorm E{X1B, BF(O_X2B), BF(O_HN2), mod, p.in[33], RowX{(unsigned*)(ws + O_XSLOT_B), (unsigned*)(ws + O_XCNT_B)}};
        pg8::gemm_phase(lds, mk_gemm(BF(O_SMRW), BF(O_WOUT), MLAT, D, D, D, D), S, E);
        GSYNC();
    } else {
        { S.init(MLAT, D, gridDim.x, blockIdx.x); EpiRes<true, true> E{nullptr, X1B, nullptr, BF(O_X2B), mod, 5, 1.0f}; pg8::gemm_phase(lds, mk_gemm(BF(O_SMRW), BF(O_WOUT), MLAT, D, D, D, D), S, E); }
        GSYNC();
        norm_phase<true>(p.in[0], (const float*)(ws + O_CTXX1), MLAT, p.in[33], mod, 6, 7, BF(O_HN2), D, nullptr, BF(O_X2B));
        GSYNC();
    }
    { S.init(MLAT, 2 * DFF, gridDim.x, blockIdx.x); EpiUp E{BF(O_U2)}; pg8::gemm_phase(lds, mk_gemm(BF(O_HN2), BF(O_UP2), MLAT, 2 * DFF, D, D, D), S, E); }
    GSYNC();
    if (gridDim.x == 256) {
        S.init(MLAT, D, gridDim.x, blockIdx.x); EpiFinalNorm E{BF(O_X2B), p.out, mod, p.in[37], RowX{(unsigned*)(ws + O_XSLOT_A), (unsigned*)(ws + O_XCNT_A)}};
        pg8::gemm_phase(lds, mk_gemm(BF(O_U2), BF(O_DN2), MLAT, D, DFF, DFF, DFF), S, E);
    } else {
        { S.init(MLAT, D, gridDim.x, blockIdx.x); EpiRes<true, false> E{nullptr, BF(O_X2B), p.out, nullptr, mod, 8, 0.5f}; pg8::gemm_phase(lds, mk_gemm(BF(O_U2), BF(O_DN2), MLAT, D, DFF, DFF, DFF), S, E); }
        GSYNC();
        final_norm_phase(p.out, p.in[37]);
    }
}

extern "C" void kernel_launch(void* const* d_in, const int* in_sizes, int n_in, void* d_out, int out_size, void* d_ws, size_t ws_size, hipStream_t stream) {
    static int grid = 0;
    if (grid == 0) {
        if (n_in != 38 || out_size != MLAT * D || ws_size < WS_NEED) { fprintf(stderr, "kernel_launch: unexpected shapes (n_in %d, out %d, ws %zu); nothing launched\n", n_in, out_size, ws_size); grid = -1; return; }
        int dev = 0, cus = 0, per_cu = 0;
        hipGetDevice(&dev);
        hipDeviceGetAttribute(&cus, hipDeviceAttributeMultiprocessorCount, dev);
        if (hipFuncSetAttribute((const void*)mega, hipFuncAttributeMaxDynamicSharedMemorySize, LDS_BYTES) != hipSuccess) { fprintf(stderr, "kernel_launch: hipFuncSetAttribute failed\n"); grid = -1; return; }
        if (hipOccupancyMaxActiveBlocksPerMultiprocessor(&per_cu, (const void*)mega, NTHREADS, LDS_BYTES) != hipSuccess || per_cu < 1) { fprintf(stderr, "kernel_launch: occupancy query failed (%d)\n", per_cu); per_cu = 1; }
        (void)hipGetLastError();
        grid = cus * (per_cu > 1 ? 1 : per_cu);
    }
    if (grid < 0) return;
    Params p{};
    for (int i = 0; i < 38; ++i) p.in[i] = (const float*)d_in[i];
    p.out = (float*)d_out; p.ws = (unsigned char*)d_ws;
    if (hipMemsetAsync((unsigned char*)d_ws + O_BAR, 0, 65536, stream) != hipSuccess) { fprintf(stderr, "kernel_launch: memset failed\n"); return; }
    void* args[] = {&p};
    hipError_t e = hipLaunchCooperativeKernel((const void*)mega, dim3(grid), dim3(NTHREADS), args, LDS_BYTES, stream);
    if (e != hipSuccess) fprintf(stderr, "kernel_launch: cooperative launch failed: %s (grid %d)\n", hipGetErrorString(e), grid);
}
```

```cpp
#include <hip/hip_runtime.h>
#include <hip/hip_cooperative_groups.h>
#include <cstdio>
#include <cstdint>
namespace cg = cooperative_groups;

#define LAS __attribute__((address_space(3)))
typedef unsigned short bf16_t;
typedef short bf16x8 __attribute__((ext_vector_type(8)));
typedef float f32x4 __attribute__((ext_vector_type(4)));
typedef float f32x2 __attribute__((ext_vector_type(2)));
typedef unsigned u32x4 __attribute__((ext_vector_type(4)));
typedef unsigned u32x2 __attribute__((ext_vector_type(2)));

constexpr int D = 1024, DFF = 2816, MLAT = 16384, MCTX = 1024, MALL = 17408, NMOD = 9216;
constexpr int NTHREADS = 512, LDS_BYTES = 131072;
constexpr size_t MiB = 1048576;
constexpr size_t W0 = 0, W1 = 18 * MiB, SP = 34 * MiB, ACT = 50 * MiB;
constexpr size_t O_UP1 = W0, O_RW = W0, O_LATE = W0, O_PRW = W0 + 6 * MiB, O_PLRU = W0 + 8 * MiB, O_WOUT = W0 + 10 * MiB, O_DN2 = W0 + 12 * MiB;
constexpr size_t O_DN1 = W1 + 10 * MiB, O_LSCW = W1, O_LSCA = W1 + 256 * 1024, O_GUP = W1 + 512 * 1024, O_LX = W1 + 1 * MiB, O_LRUW = W1 + 3 * MiB, O_UP2 = W1;
constexpr size_t O_MOD = SP, O_RN = SP + 256 * 1024, O_CB = O_RN + 1280 * 1024, O_PQ = SP + 3 * MiB, O_CTXX1 = SP + 8 * MiB, O_CL = SP + 12 * MiB, O_BAR = SP + 13 * MiB, O_PLXC = SP + 14 * MiB, O_XCNT_B = SP + 13 * MiB + 16384, O_XCNT_A = SP + 13 * MiB + 32768, O_XSLOT_B = SP + 15 * MiB, O_XSLOT_A = SP + 15 * MiB + 262144, O_XCNT_C = SP + 13 * MiB + 49152, O_XSLOT_C = SP + 15 * MiB + 524288, O_CTXP2 = ACT + 200 * MiB, O_X2B = ACT + 136 * MiB;
constexpr size_t O_HN = ACT, O_U = ACT + 34 * MiB;
constexpr size_t O_XNXS = ACT, O_R = ACT + 68 * MiB, O_K = ACT + 102 * MiB, O_V = ACT + 136 * MiB, O_LIN = ACT + 170 * MiB, O_GD = ACT + 178 * MiB + 512 * 1024;
constexpr size_t O_YF = ACT, O_YB = ACT + 32 * MiB, O_XN2 = ACT + 68 * MiB, O_PLX = ACT + 102 * MiB, O_XC = ACT + 136 * MiB;
constexpr size_t O_GRF = ACT + 32 * MiB, O_UF = ACT + 66 * MiB, O_GRB = ACT + 100 * MiB, O_UB = ACT + 170 * MiB;
constexpr size_t O_HSUM = ACT + 136 * MiB, O_XN3 = ACT + 32 * MiB, O_SMRW = ACT + 66 * MiB, O_SMLRU = ACT + 98 * MiB;
constexpr size_t O_HN2 = ACT, O_U2 = ACT + 34 * MiB;
constexpr size_t WS_NEED = 256 * MiB;

struct Params { const float* in[38]; float* out; unsigned char* ws; };

__device__ __forceinline__ float bf2f(unsigned short b) { return __uint_as_float(((unsigned)b) << 16); }
__device__ __forceinline__ float bflo(unsigned u) { return __uint_as_float(u << 16); }
__device__ __forceinline__ float bfhi(unsigned u) { return __uint_as_float(u & 0xffff0000u); }
typedef __bf16 bf16x2_t __attribute__((ext_vector_type(2)));
__device__ __forceinline__ unsigned pk2(float lo, float hi) { const f32x2 v = {lo, hi}; const bf16x2_t b = __builtin_convertvector(v, bf16x2_t); return __builtin_bit_cast(unsigned, b); }
__device__ __forceinline__ int tidx() { int t = threadIdx.x; asm volatile("" : "+v"(t)); return t; }
__device__ __forceinline__ float frcp(float x) { return __builtin_amdgcn_rcpf(x); }
__device__ __forceinline__ float sigm(float x) { return frcp(1.0f + __expf(-x)); }
__device__ __forceinline__ float tanh_f(float x) { return 1.0f - 2.0f * frcp(__expf(2.0f * x) + 1.0f); }
__device__ __forceinline__ float silu_f(float x) { return x * sigm(x); }
__device__ __forceinline__ float gelu_f(float x) { return x * sigm(1.5957691216f * (x + 0.044715f * x * x * x)); }
__device__ __forceinline__ float wave_sum(float v) {
#pragma unroll
    for (int o = 1; o < 64; o <<= 1) v += __shfl_xor(v, o);
    return v;
}
template <int CTRL> __device__ __forceinline__ float dppf(float v) {
    return __builtin_bit_cast(float, __builtin_amdgcn_update_dpp(0, __builtin_bit_cast(int, v), CTRL, 0xF, 0xF, true));
}
__device__ __forceinline__ float red16(float v) {
    v += dppf<0xB1>(v); v += dppf<0x4E>(v); v += dppf<0x141>(v); v += dppf<0x140>(v); return v;
}

namespace pg8 {
constexpr int BM = 256, BK = 64, HALF = 128, HTB = HALF * BK * 2, NXCD = 8, WGM = 8;
__device__ __forceinline__ int lds_byte(int r, int c) { const int st = (r >> 4) * 2 + (c >> 5), rr = r & 15, cc = c & 31, ob = rr * 64 + cc * 2; return st * 1024 + (ob ^ (((ob >> 9) & 1) << 5)); }
__device__ __forceinline__ void stage_rc(int b, int& R, int& C) { const int st = b / 1024, sb = b % 1024, swz = sb ^ (((sb >> 9) & 1) << 5); R = (st >> 1) * 16 + swz / 64; C = (st & 1) * 32 + (swz % 64) / 2; }
struct Unit { int pm, pn; };
struct Gemm { const bf16_t* A; const bf16_t* Bt; int M, N, K, lda, ldb, ksh, kmask, kmul; };
struct StaticOrder {
    int nM, nN, nwg, G, c;
    __device__ void init(int M, int N, int G_, int c_) { nM = M / BM; nN = N / BM; nwg = nM * nN; G = G_; c = c_; }
    __device__ bool next(int i, Unit& u) const {
        const long L = (long)i * G + c; if (L >= nwg) return false;
        int wgid = (int)L; { const int q = nwg / NXCD, r = nwg % NXCD, xcd = wgid % NXCD, off = wgid / NXCD; wgid = (xcd < r ? xcd * (q + 1) : r * (q + 1) + (xcd - r) * q) + off; }
        const int nig = WGM * nN, gid = wgid / nig, fm = gid * WGM, gsz = (nM - fm) < WGM ? (nM - fm) : WGM;
        u.pm = fm + ((wgid % nig) % gsz); u.pn = (wgid % nig) / gsz; return true;
    }
};

template <class E, class = void> struct is_ad { static constexpr bool value = false; };
template <class E> struct is_ad<E, decltype((void)E::AFTER_DRAIN)> { static constexpr bool value = true; };

template <class Epi>
__device__ __forceinline__ void gemm_phase(LAS unsigned char* lds, const Gemm g, const StaticOrder& S, const Epi& E) {
    const int tid = tidx(), wid = __builtin_amdgcn_readfirstlane(tid >> 6), lane = tid & 63, wr = wid >> 2, wc = wid & 3, fr = lane & 15, fq = lane >> 4;
    const int K = g.K, nt = K / BK;
    unsigned voffA[2], voffB[2];
#pragma unroll
    for (int i = 0; i < 2; ++i) { int R, C; stage_rc(tid * 16 + i * 8192, R, C);
        voffA[i] = (unsigned)(R * g.lda + C) * 2u; voffB[i] = (unsigned)(R * g.ldb + C) * 2u; }
    const size_t kstep = (size_t)(BK * 2);
    const size_t hstepA = (size_t)HALF * g.lda * 2, hstepB = (size_t)HALF * g.ldb * 2;
    const size_t tstepA = 2 * hstepA, tstepB = 2 * hstepB;
    const unsigned ldsw = (unsigned)wid * 1024u;
    const int aoff = lds_byte(wr * 64 + fr, fq * 8), boff = lds_byte(wc * 32 + fr, fq * 8);
#define PG8_SA(b, h) (((b) * 2 + (h)) * HTB)
#define PG8_SB(b, h) ((4 + (b) * 2 + (h)) * HTB)
#define PG8_STAGE(bufoff, gbase, voff) do { _Pragma("unroll") for (int _i = 0; _i < 2; ++_i) \
        __builtin_amdgcn_global_load_lds((const unsigned*)((const char*)(gbase) + (voff)[_i]), (LAS unsigned*)(lds + (bufoff) + ldsw + _i * 8192), 16, 0, 0); } while (0)
#define PG8_LDA(dst, b, h) do { _Pragma("unroll") for (int m = 0; m < 4; ++m) _Pragma("unroll") for (int k = 0; k < 2; ++k) dst[m][k] = *(const LAS bf16x8*)(lds + PG8_SA(b, h) + aoff + m * 2048 + k * 1024); } while (0)
#define PG8_LDB(dst, b, h) do { _Pragma("unroll") for (int n = 0; n < 2; ++n) _Pragma("unroll") for (int k = 0; k < 2; ++k) dst[n][k] = *(const LAS bf16x8*)(lds + PG8_SB(b, h) + boff + n * 2048 + k * 1024); } while (0)
#define PG8_MMA(ai, bj, At, Bt) do { __builtin_amdgcn_s_setprio(1); _Pragma("unroll") for (int m = 0; m < 4; ++m) _Pragma("unroll") for (int n = 0; n < 2; ++n) _Pragma("unroll") for (int k = 0; k < 2; ++k) \
        acc[ai][bj][m][n] = __builtin_amdgcn_mfma_f32_16x16x32_bf16(Bt[n][k], At[m][k], acc[ai][bj][m][n], 0, 0, 0); __builtin_amdgcn_s_setprio(0); } while (0)
#define PG8_WAIT_V(n) asm volatile("s_waitcnt vmcnt(" #n ")" ::: "memory")
#define PG8_WAIT_L(n) asm volatile("s_waitcnt lgkmcnt(" #n ")" ::: "memory")
#define PG8_BAR __builtin_amdgcn_s_barrier()
#define PG8_SCHED __builtin_amdgcn_sched_barrier(0)
#define PG8_KOFF(u) ((size_t)((((u).pn >> g.ksh) & g.kmask) * g.kmul) * 2)
    Unit cur, nxt; int ui = 0;
    if (!S.next(0, cur)) return;
    f32x4 acc[2][2][4][2];
#pragma unroll
    for (int a = 0; a < 2; ++a)
#pragma unroll
        for (int b = 0; b < 2; ++b)
#pragma unroll
            for (int m = 0; m < 4; ++m)
#pragma unroll
                for (int n = 0; n < 2; ++n) acc[a][b][m][n] = (f32x4){0.f, 0.f, 0.f, 0.f};
    bf16x8 At[4][2], B0[2][2], B1[2][2];
    const char* cA = (const char*)g.A + (size_t)cur.pm * tstepA + PG8_KOFF(cur); const char* cB = (const char*)g.Bt + (size_t)cur.pn * tstepB;
    PG8_STAGE(PG8_SB(0, 0), cB, voffB); PG8_STAGE(PG8_SA(0, 0), cA, voffA); PG8_STAGE(PG8_SB(0, 1), cB + hstepB, voffB); PG8_STAGE(PG8_SA(0, 1), cA + hstepA, voffA);
    if (wr == 1) PG8_BAR;
    PG8_WAIT_V(4); PG8_BAR;
    PG8_STAGE(PG8_SB(1, 0), cB + kstep, voffB); PG8_STAGE(PG8_SA(1, 0), cA + kstep, voffA); PG8_STAGE(PG8_SB(1, 1), cB + hstepB + kstep, voffB);
    PG8_WAIT_V(6); PG8_BAR;
    for (;;) {
        const bool has_next = S.next(ui + 1, nxt);
        const char* nA = has_next ? (const char*)g.A + (size_t)nxt.pm * tstepA + PG8_KOFF(nxt) : cA; const char* nB = has_next ? (const char*)g.Bt + (size_t)nxt.pn * tstepB : cB;
        for (int t = 0; t < nt; t += 2) {
            const bool last = (t == nt - 2);
            const char* a1 = cA + (size_t)(t + 1) * kstep;
            const char* a2 = last ? nA : cA + (size_t)(t + 2) * kstep; const char* b2 = last ? nB : cB + (size_t)(t + 2) * kstep;
            const char* a3 = a2 + kstep; const char* b3 = b2 + kstep;
            PG8_LDB(B0, 0, 0); PG8_SCHED; PG8_LDA(At, 0, 0); PG8_STAGE(PG8_SA(1, 1), a1 + hstepA, voffA);
            PG8_WAIT_L(8); PG8_BAR; PG8_WAIT_L(0); PG8_MMA(0, 0, At, B0); PG8_BAR; PG8_SCHED;
            PG8_LDB(B1, 0, 1); PG8_STAGE(PG8_SB(0, 0), b2, voffB);
            PG8_BAR; PG8_WAIT_L(0); PG8_MMA(0, 1, At, B1); PG8_BAR;
            PG8_LDA(At, 0, 1); PG8_STAGE(PG8_SA(0, 0), a2, voffA);
            PG8_BAR; PG8_WAIT_L(0); PG8_MMA(1, 0, At, B0); PG8_BAR; PG8_SCHED;
            PG8_STAGE(PG8_SB(0, 1), b2 + hstepB, voffB);
            PG8_WAIT_V(6); PG8_BAR; PG8_MMA(1, 1, At, B1); PG8_BAR;
            PG8_LDB(B0, 1, 0); PG8_SCHED; PG8_LDA(At, 1, 0); PG8_STAGE(PG8_SA(0, 1), a2 + hstepA, voffA);
            PG8_WAIT_L(8); PG8_BAR; PG8_WAIT_L(0); PG8_MMA(0, 0, At, B0); PG8_BAR; PG8_SCHED;
            PG8_LDB(B1, 1, 1); PG8_STAGE(PG8_SB(1, 0), b3, voffB);
            PG8_BAR; PG8_WAIT_L(0); PG8_MMA(0, 1, At, B1); PG8_BAR;
            PG8_LDA(At, 1, 1); PG8_STAGE(PG8_SA(1, 0), a3, voffA);
            PG8_BAR; PG8_WAIT_L(0); PG8_MMA(1, 0, At, B0); PG8_BAR; PG8_SCHED;
            PG8_STAGE(PG8_SB(1, 1), b3 + hstepB, voffB);
            PG8_WAIT_V(6); PG8_BAR; PG8_MMA(1, 1, At, B1); PG8_BAR;
        }
        if constexpr (!is_ad<Epi>::value) E(acc, cur, wr, wc, fr, fq);
        if (!has_next) break;
#pragma unroll
        for (int a = 0; a < 2; ++a)
#pragma unroll
            for (int b = 0; b < 2; ++b)
#pragma unroll
                for (int m = 0; m < 4; ++m)
#pragma unroll
                    for (int n = 0; n < 2; ++n) acc[a][b][m][n] = (f32x4){0.f, 0.f, 0.f, 0.f};
        cur = nxt; cA = nA; cB = nB; ++ui;
    }
    PG8_WAIT_V(0);
    if (wr == 0) PG8_BAR;
    PG8_BAR;
    if constexpr (is_ad<Epi>::value) E.fused(acc, cur, wr, wc, fr, fq, lds, wid, lane);
#undef PG8_SA
#undef PG8_SB
#undef PG8_STAGE
#undef PG8_LDA
#undef PG8_LDB
#undef PG8_MMA
#undef PG8_WAIT_V
#undef PG8_WAIT_L
#undef PG8_BAR
#undef PG8_SCHED
#undef PG8_KOFF
}
}
using pg8::Unit;
using pg8::Gemm;

#define EPI_ROWS(...) _Pragma("unroll") for (int ai = 0; ai < 2; ++ai) _Pragma("unroll") for (int m = 0; m < 4; ++m) { const int row = u.pm * 256 + ai * 128 + wr * 64 + m * 16 + fr; __VA_ARGS__ }
#define EPI_ALL(...) _Pragma("unroll") for (int ai = 0; ai < 2; ++ai) _Pragma("unroll") for (int m = 0; m < 4; ++m) _Pragma("unroll") for (int bj = 0; bj < 2; ++bj) _Pragma("unroll") for (int n = 0; n < 2; ++n) { \
        const int row = u.pm * 256 + ai * 128 + wr * 64 + m * 16 + fr; __VA_ARGS__ }
typedef const f32x4 (&AccRef)[2][2][4][2];

struct EpiUp {
    bf16_t* U;
    __device__ __forceinline__ void operator()(AccRef acc, const Unit& u, int wr, int wc, int fr, int fq) const {
        EPI_ROWS(
            _Pragma("unroll") for (int bj = 0; bj < 2; ++bj) {
                const f32x4 g = acc[ai][bj][m][0], v = acc[ai][bj][m][1];
                const int f0 = ((u.pn * 256 + bj * 128 + wc * 32) >> 1) + 4 * fq;
                u32x2 o; o.x = pk2(silu_f(g[0]) * v[0], silu_f(g[1]) * v[1]); o.y = pk2(silu_f(g[2]) * v[2], silu_f(g[3]) * v[3]);
                *(u32x2*)(U + (size_t)row * DFF + f0) = o; }
        )
    }
};
template <bool RB, bool OB> struct EpiRes {
    const float* res_f; const bf16_t* res_b; float* out_f; bf16_t* out_b; const float* mod; int gidx; float scale;
    __device__ __forceinline__ void operator()(AccRef acc, const Unit& u, int wr, int wc, int fr, int fq) const {
        u32x2 tv[2][4][2][2];
        if constexpr (RB) { EPI_ALL( const int col = u.pn * 256 + bj * 128 + wc * 32 + n * 16 + 4 * fq; tv[ai][m][bj][n] = *(const u32x2*)(res_b + (size_t)row * D + col); ) }
        EPI_ROWS(
            const float* gp = mod + (size_t)(row >> 12) * NMOD + gidx * D;
            _Pragma("unroll") for (int bj = 0; bj < 2; ++bj) _Pragma("unroll") for (int n = 0; n < 2; ++n) {
                const int col = u.pn * 256 + bj * 128 + wc * 32 + n * 16 + 4 * fq; const size_t off = (size_t)row * D + col;
                f32x4 r;
                if constexpr (RB) { const u32x2 t = tv[ai][m][bj][n]; r = (f32x4){bflo(t.x), bfhi(t.x), bflo(t.y), bfhi(t.y)}; } else r = *(const f32x4*)(res_f + off);
                const f32x4 gt = *(const f32x4*)(gp + col);
                const f32x4 o = r + scale * gt * acc[ai][bj][m][n];
                if constexpr (OB) { u32x2 w; w.x = pk2(o[0], o[1]); w.y = pk2(o[2], o[3]); *(u32x2*)(out_b + off) = w; } else *(f32x4*)(out_f + off) = o; }
        )
    }
};
struct EpiCtx {
    const float* res; float* out; const float* gate; float scale;
    __device__ __forceinline__ void operator()(AccRef acc, const Unit& u, int wr, int wc, int fr, int fq) const {
        EPI_ROWS(
            _Pragma("unroll") for (int bj = 0; bj < 2; ++bj) _Pragma("unroll") for (int n = 0; n < 2; ++n) {
                const int col = u.pn * 256 + bj * 128 + wc * 32 + n * 16 + 4 * fq; const size_t off = (size_t)row * D + col;
                const f32x4 gt = *(const f32x4*)(gate + col); f32x4 r = (f32x4){0.f, 0.f, 0.f, 0.f};
                if (res) r = *(const f32x4*)(res + off);
                *(f32x4*)(out + off) = r + scale * gt * acc[ai][bj][m][n]; }
        )
    }
};
struct EpiRw {
    bf16_t *RKV, *LIN, *GD;
    __device__ __forceinline__ void operator()(AccRef acc, const Unit& u, int wr, int wc, int fr, int fq) const {
        const int pn = u.pn;
        if (pn < 12) {
            bf16_t* base = RKV + (size_t)(pn >> 2) * ((size_t)MALL * D) + (pn & 3) * 256;
            EPI_ROWS(
                _Pragma("unroll") for (int bj = 0; bj < 2; ++bj) _Pragma("unroll") for (int n = 0; n < 2; ++n) {
                    const int cl = bj * 128 + wc * 32 + n * 16 + 4 * fq; const f32x4 a = acc[ai][bj][m][n];
                    u32x2 o; o.x = pk2(a[0], a[1]); o.y = pk2(a[2], a[3]);
                    *(u32x2*)(base + (size_t)row * D + cl) = o; }
            )
        } else if (pn == 12) {
            EPI_ROWS(
                _Pragma("unroll") for (int bj = 0; bj < 2; ++bj) _Pragma("unroll") for (int n = 0; n < 2; ++n) {
                    const int cl = bj * 128 + wc * 32 + n * 16 + 4 * fq; f32x4 a = acc[ai][bj][m][n];
                    if (bj == 0) { a[0] = tanh_f(a[0]); a[1] = tanh_f(a[1]); a[2] = tanh_f(a[2]); a[3] = tanh_f(a[3]); }
                    u32x2 o; o.x = pk2(a[0], a[1]); o.y = pk2(a[2], a[3]);
                    *(u32x2*)(LIN + (size_t)row * 256 + cl) = o; }
            )
        } else {
            EPI_ROWS(
                _Pragma("unroll") for (int bj = 0; bj < 2; ++bj) _Pragma("unroll") for (int n = 0; n < 2; ++n) {
                    const int cl = bj * 128 + wc * 32 + n * 16 + 4 * fq; const f32x4 a = acc[ai][bj][m][n];
                    u32x2 o; o.x = 0u; o.y = 0u;
                    if (bj == 0) { o.x = pk2(sigm(a[0]), sigm(a[1])); o.y = pk2(sigm(a[2]), sigm(a[3])); }
                    *(u32x2*)(GD + (size_t)row * 256 + cl) = o; }
            )
        }
    }
};
struct EpiBf {
    bf16_t* O; int ldo;
    __device__ __forceinline__ void operator()(AccRef acc, const Unit& u, int wr, int wc, int fr, int fq) const {
        EPI_ROWS(
            _Pragma("unroll") for (int bj = 0; bj < 2; ++bj) _Pragma("unroll") for (int n = 0; n < 2; ++n) {
                const int col = u.pn * 256 + bj * 128 + wc * 32 + n * 16 + 4 * fq; const f32x4 a = acc[ai][bj][m][n];
                u32x2 o; o.x = pk2(a[0], a[1]); o.y = pk2(a[2], a[3]);
                *(u32x2*)(O + (size_t)row * ldo + col) = o; }
        )
    }
};
struct EpiMul {
    bf16_t* T; const bf16_t* S2; int mode;
    __device__ __forceinline__ void operator()(AccRef acc, const Unit& u, int wr, int wc, int fr, int fq) const {
#pragma unroll
        for (int ai = 0; ai < 2; ++ai) {
            u32x2 tv[4][2][2], sv[4][2][2];
#pragma unroll
            for (int m = 0; m < 4; ++m)
#pragma unroll
                for (int bj = 0; bj < 2; ++bj)
#pragma unroll
                    for (int n = 0; n < 2; ++n) { const int row = u.pm * 256 + ai * 128 + wr * 64 + m * 16 + fr, col = u.pn * 256 + bj * 128 + wc * 32 + n * 16 + 4 * fq; const size_t off = (size_t)row * D + col;
                        tv[m][bj][n] = *(const u32x2*)(T + off); sv[m][bj][n] = (u32x2){0u, 0u}; if (mode != 0) sv[m][bj][n] = *(const u32x2*)(S2 + off); }
#pragma unroll
            for (int m = 0; m < 4; ++m)
#pragma unroll
                for (int bj = 0; bj < 2; ++bj)
#pragma unroll
                    for (int n = 0; n < 2; ++n) { const int row = u.pm * 256 + ai * 128 + wr * 64 + m * 16 + fr, col = u.pn * 256 + bj * 128 + wc * 32 + n * 16 + 4 * fq; const size_t off = (size_t)row * D + col;
                        const f32x4 a = acc[ai][bj][m][n]; const u32x2 t = tv[m][bj][n], q = sv[m][bj][n]; u32x2 o;
                        if (mode == 0) { o.x = pk2(bflo(t.x) * a[0], bfhi(t.x) * a[1]); o.y = pk2(bflo(t.y) * a[2], bfhi(t.y) * a[3]); }
                        else { o.x = pk2(bflo(t.x) + bflo(q.x) * a[0], bfhi(t.x) + bfhi(q.x) * a[1]); o.y = pk2(bflo(t.y) + bflo(q.y) * a[2], bfhi(t.y) + bfhi(q.y) * a[3]); }
                        *(u32x2*)(T + off) = o; }
        }
    }
};
struct EpiLru {
    const bf16_t* XC; bf16_t *GR0, *U0, *GR1, *U1; const float *ba, *bx, *cl;
    __device__ __forceinline__ void operator()(AccRef acc, const Unit& u, int wr, int wc, int fr, int fq) const {
        const int d = u.pn >> 3, pn8 = u.pn & 7;
        bf16_t* GR = GR0 + (size_t)d * ((size_t)(O_GRB - O_GRF) / 2); bf16_t* UU = U0 + (size_t)d * ((size_t)(O_UB - O_UF) / 2);
#pragma unroll
        for (int bj = 0; bj < 2; ++bj) { const int c0 = 128 * pn8 + 16 * (4 * bj + wc) + 4 * fq;
            const f32x4 vba = *(const f32x4*)(ba + d * D + c0), vbx = *(const f32x4*)(bx + d * D + c0), vcl = *(const f32x4*)(cl + d * D + c0);
            u32x2 xv[2][4];
            EPI_ROWS( xv[ai][m] = *(const u32x2*)(XC + (size_t)row * D + c0); )
            EPI_ROWS(
                const size_t off = (size_t)row * D + c0;
                const u32x2 xcv = xv[ai][m];
                const float xc[4] = {bflo(xcv.x), bfhi(xcv.x), bflo(xcv.y), bfhi(xcv.y)};
                float gr[4]; float uu[4];
                _Pragma("unroll") for (int j = 0; j < 4; ++j) {
                    gr[j] = sigm(acc[ai][bj][m][0][j] + vba[j]);
                    const float gi = sigm(acc[ai][bj][m][1][j] + vbx[j]);
                    const float x = 2.0f * gr[j] * vcl[j];
                    const float om = -x * (1.0f + 0.5f * x * (1.0f + (1.0f / 3.0f) * x * (1.0f + 0.25f * x)));
                    uu[j] = __builtin_amdgcn_sqrtf(om) * gi * xc[j]; }
                u32x2 o1; u32x2 o2; o1.x = pk2(gr[0], gr[1]); o1.y = pk2(gr[2], gr[3]); o2.x = pk2(uu[0], uu[1]); o2.y = pk2(uu[2], uu[3]);
                *(u32x2*)(GR + off) = o1; *(u32x2*)(UU + off) = o2;
            )
        }
    }
};
struct EpiLate {
    bf16_t *HS, *S1, *S2;
    __device__ __forceinline__ void operator()(AccRef acc, const Unit& u, int wr, int wc, int fr, int fq) const {
        const int part = u.pn >> 2;
        if (part == 0) {
            u32x2 tv[2][4][2][2];
            EPI_ALL( const int col = (u.pn & 3) * 256 + bj * 128 + wc * 32 + n * 16 + 4 * fq; tv[ai][m][bj][n] = *(const u32x2*)(HS + (size_t)row * D + col); )
            EPI_ALL( const int col = (u.pn & 3) * 256 + bj * 128 + wc * 32 + n * 16 + 4 * fq; const f32x4 a = acc[ai][bj][m][n]; const u32x2 t = tv[ai][m][bj][n]; u32x2 o;
                o.x = pk2(bflo(t.x) * gelu_f(a[0]), bfhi(t.x) * gelu_f(a[1])); o.y = pk2(bflo(t.y) * gelu_f(a[2]), bfhi(t.y) * gelu_f(a[3]));
                *(u32x2*)(HS + (size_t)row * D + col) = o; )
        } else {
            bf16_t* O = part == 1 ? S1 : S2;
            EPI_ALL( const int col = (u.pn & 3) * 256 + bj * 128 + wc * 32 + n * 16 + 4 * fq; const f32x4 a = acc[ai][bj][m][n]; u32x2 o;
                o.x = pk2(sigm(a[0]), sigm(a[1])); o.y = pk2(sigm(a[2]), sigm(a[3])); *(u32x2*)(O + (size_t)row * D + col) = o; )
        }
    }
};

struct EpiPostG {
    static constexpr bool AFTER_DRAIN = true;
    bf16_t* YF; const bf16_t* YB; const bf16_t* V; const float* cb; const float* lnw; const float* lnb;
    __device__ __forceinline__ void fused(f32x4 (&acc)[2][2][4][2], const Unit& u, int wr, int wc, int fr, int fq, LAS unsigned char* lds, int wid, int lane) const {
        LAS f32x2* P = (LAS f32x2*)lds;
#pragma unroll
        for (int ai = 0; ai < 2; ++ai)
#pragma unroll
            for (int bj = 0; bj < 2; ++bj) { const int qd = ai * 2 + bj;
                u32x2 a[4][2], b[4][2], vv[4][2];
#pragma unroll
                for (int m = 0; m < 4; ++m)
#pragma unroll
                    for (int n = 0; n < 2; ++n) { const size_t off = (size_t)(u.pm * 256 + ai * 128 + wr * 64 + m * 16 + fr) * D + u.pn * 256 + bj * 128 + wc * 32 + n * 16 + 4 * fq;
                        a[m][n] = *(const u32x2*)(YF + off); b[m][n] = *(const u32x2*)(YB + off); vv[m][n] = *(const u32x2*)(V + off); }
                f32x4 y[4][2];
#pragma unroll
                for (int m = 0; m < 4; ++m) { float s1 = 0.f, s2 = 0.f;
#pragma unroll
                    for (int n = 0; n < 2; ++n) { const f32x4 t = (f32x4){bflo(a[m][n].x) + bflo(b[m][n].x), bfhi(a[m][n].x) + bfhi(b[m][n].x), bflo(a[m][n].y) + bflo(b[m][n].y), bfhi(a[m][n].y) + bfhi(b[m][n].y)};
                        y[m][n] = t; s1 += (t[0] + t[1]) + (t[2] + t[3]); s2 += (t[0] * t[0] + t[1] * t[1]) + (t[2] * t[2] + t[3] * t[3]); }
                    s1 += __shfl_xor(s1, 16); s1 += __shfl_xor(s1, 32); s2 += __shfl_xor(s2, 16); s2 += __shfl_xor(s2, 32);
                    if (fq == 0) P[(qd * 128 + wr * 64 + m * 16 + fr) * 4 + wc] = (f32x2){s1, s2}; }
                __syncthreads();
                const int head = 4 * u.pn + 2 * bj + (wc >> 1);
#pragma unroll
                for (int m = 0; m < 4; ++m) { const int rl = wr * 64 + m * 16 + fr, row = u.pm * 256 + ai * 128 + rl;
                    const f32x2 p0 = P[(qd * 128 + rl) * 4 + wc], p1 = P[(qd * 128 + rl) * 4 + (wc ^ 1)];
                    const float mean = (p0[0] + p1[0]) * (1.0f / 64.0f), var = fmaxf((p0[1] + p1[1]) * (1.0f / 64.0f) - mean * mean, 0.f), rs = rsqrtf(var + 64e-5f);
                    const float cbs = cb[(size_t)row * 16 + head];
#pragma unroll
                    for (int n = 0; n < 2; ++n) { const int col = u.pn * 256 + bj * 128 + wc * 32 + n * 16 + 4 * fq; const size_t off = (size_t)row * D + col;
                        const f32x4 w = *(const f32x4*)(lnw + col), bb = *(const f32x4*)(lnb + col), g = acc[ai][bj][m][n];
                        const f32x4 v4 = (f32x4){bflo(vv[m][n].x), bfhi(vv[m][n].x), bflo(vv[m][n].y), bfhi(vv[m][n].y)};
                        const f32x4 o = ((y[m][n] - mean) * rs * w + bb + cbs * v4) * g;
                        u32x2 q; q.x = pk2(o[0], o[1]); q.y = pk2(o[2], o[3]); *(u32x2*)(YF + off) = q; } }
            }
        __syncthreads();
    }
};
struct RowX { unsigned* slots; unsigned* cnt; };
__device__ __forceinline__ void row_rstd_exchange(f32x4 (&v)[2][2][4][2], const Unit& u, int wr, int wc, int fr, int fq, LAS unsigned char* lds, int wid, int lane, const RowX& X) {
    LAS float* P = (LAS float*)lds; LAS float* S = (LAS float*)(lds + 4096);
#pragma unroll
    for (int ai = 0; ai < 2; ++ai)
#pragma unroll
        for (int m = 0; m < 4; ++m) { float q = 0.f;
#pragma unroll
            for (int bj = 0; bj < 2; ++bj)
#pragma unroll
                for (int n = 0; n < 2; ++n) { const f32x4 x = v[ai][bj][m][n]; q += (x[0] * x[0] + x[1] * x[1]) + (x[2] * x[2] + x[3] * x[3]); }
            q += __shfl_xor(q, 16); q += __shfl_xor(q, 32);
            if (fq == 0) P[(ai * 128 + wr * 64 + m * 16 + fr) * 4 + wc] = q; }
    __syncthreads();
    const int row = wid * 32 + (lane & 31);
    if (lane < 32) { const float t = (P[row * 4] + P[row * 4 + 1]) + (P[row * 4 + 2] + P[row * 4 + 3]);
        __hip_atomic_store(X.slots + ((size_t)(u.pm * 256 + row) * 4 + u.pn), __float_as_uint(t), __ATOMIC_RELAXED, __HIP_MEMORY_SCOPE_AGENT); }
    asm volatile("s_waitcnt vmcnt(0)" ::: "memory");
    if (lane == 0) __hip_atomic_fetch_add(X.cnt + 64 * u.pm, 1u, __ATOMIC_RELAXED, __HIP_MEMORY_SCOPE_AGENT);
    if (wid == 0) { unsigned sp = 0u;
        while ((unsigned)__builtin_amdgcn_readfirstlane(__hip_atomic_load(X.cnt + 64 * u.pm, __ATOMIC_RELAXED, __HIP_MEMORY_SCOPE_AGENT)) < 32u) { __builtin_amdgcn_s_sleep(1); if (++sp > (1u << 22)) break; } }
    __syncthreads();
    if (lane < 32) { const unsigned* sl = X.slots + (size_t)(u.pm * 256 + row) * 4; float t = 0.f;
#pragma unroll
        for (int q = 0; q < 4; ++q) t += __uint_as_float(__hip_atomic_load(sl + q, __ATOMIC_RELAXED, __HIP_MEMORY_SCOPE_AGENT));
        S[row] = rsqrtf(t * (1.0f / D) + 1e-6f); }
    __syncthreads();
}
struct EpiOutNorm {
    static constexpr bool AFTER_DRAIN = true;
    const bf16_t* res_b; bf16_t* x2b; bf16_t* hn; const float* mod; const float* g2; RowX X;
    __device__ __forceinline__ void fused(f32x4 (&acc)[2][2][4][2], const Unit& u, int wr, int wc, int fr, int fq, LAS unsigned char* lds, int wid, int lane) const {
        const float* mb = mod + (size_t)((u.pm * 256) >> 12) * NMOD;
#pragma unroll
        for (int ai = 0; ai < 2; ++ai) { u32x2 tv[4][2][2];
#pragma unroll
            for (int m = 0; m < 4; ++m)
#pragma unroll
                for (int bj = 0; bj < 2; ++bj)
#pragma unroll
                    for (int n = 0; n < 2; ++n) { const int row = u.pm * 256 + ai * 128 + wr * 64 + m * 16 + fr, col = u.pn * 256 + bj * 128 + wc * 32 + n * 16 + 4 * fq; tv[m][bj][n] = *(const u32x2*)(res_b + (size_t)row * D + col); }
#pragma unroll
            for (int m = 0; m < 4; ++m)
#pragma unroll
                for (int bj = 0; bj < 2; ++bj)
#pragma unroll
                    for (int n = 0; n < 2; ++n) { const int row = u.pm * 256 + ai * 128 + wr * 64 + m * 16 + fr, col = u.pn * 256 + bj * 128 + wc * 32 + n * 16 + 4 * fq; const u32x2 t = tv[m][bj][n];
                        const f32x4 gt = *(const f32x4*)(mb + 5 * D + col);
                        const f32x4 o = (f32x4){bflo(t.x), bfhi(t.x), bflo(t.y), bfhi(t.y)} + gt * acc[ai][bj][m][n];
                        acc[ai][bj][m][n] = o;
                        u32x2 w; w.x = pk2(o[0], o[1]); w.y = pk2(o[2], o[3]); *(u32x2*)(x2b + (size_t)row * D + col) = w; }
        }
        row_rstd_exchange(acc, u, wr, wc, fr, fq, lds, wid, lane, X);
        const LAS float* S = (const LAS float*)(lds + 4096);
#pragma unroll
        for (int bj = 0; bj < 2; ++bj)
#pragma unroll
            for (int n = 0; n < 2; ++n) { const int col = u.pn * 256 + bj * 128 + wc * 32 + n * 16 + 4 * fq;
                const f32x4 mul = *(const f32x4*)(g2 + col) * (1.0f + *(const f32x4*)(mb + 7 * D + col)), sh = *(const f32x4*)(mb + 6 * D + col);
#pragma unroll
                for (int ai = 0; ai < 2; ++ai)
#pragma unroll
                    for (int m = 0; m < 4; ++m) { const int rl = ai * 128 + wr * 64 + m * 16 + fr; const float rs = S[rl];
                        const f32x4 y = acc[ai][bj][m][n] * rs * mul + sh;
                        u32x2 w; w.x = pk2(y[0], y[1]); w.y = pk2(y[2], y[3]); *(u32x2*)(hn + (size_t)(u.pm * 256 + rl) * D + col) = w; } }
    }
};
struct EpiDn1Norm {
    static constexpr bool AFTER_DRAIN = true;
    const float* res_f; bf16_t* x1b; bf16_t* xnxs; bf16_t* xnp; const float* mod; const float* gm; RowX X;
    __device__ __forceinline__ void fused(f32x4 (&acc)[2][2][4][2], const Unit& u, int wr, int wc, int fr, int fq, LAS unsigned char* lds, int wid, int lane) const {
        const float* mb = mod + (size_t)((u.pm * 256) >> 12) * NMOD;
        f32x4 gt[2][2];
#pragma unroll
        for (int bj = 0; bj < 2; ++bj)
#pragma unroll
            for (int n = 0; n < 2; ++n) gt[bj][n] = 0.5f * *(const f32x4*)(mb + 2 * D + u.pn * 256 + bj * 128 + wc * 32 + n * 16 + 4 * fq);
#pragma unroll
        for (int ai = 0; ai < 2; ++ai)
#pragma unroll
            for (int mh = 0; mh < 2; ++mh) { f32x4 rv[2][2][2];
#pragma unroll
                for (int mm = 0; mm < 2; ++mm)
#pragma unroll
                    for (int bj = 0; bj < 2; ++bj)
#pragma unroll
                        for (int n = 0; n < 2; ++n) { const int m = 2 * mh + mm, row = u.pm * 256 + ai * 128 + wr * 64 + m * 16 + fr, col = u.pn * 256 + bj * 128 + wc * 32 + n * 16 + 4 * fq; rv[mm][bj][n] = *(const f32x4*)(res_f + (size_t)row * D + col); }
#pragma unroll
                for (int mm = 0; mm < 2; ++mm)
#pragma unroll
                    for (int bj = 0; bj < 2; ++bj)
#pragma unroll
                        for (int n = 0; n < 2; ++n) { const int m = 2 * mh + mm, row = u.pm * 256 + ai * 128 + wr * 64 + m * 16 + fr, col = u.pn * 256 + bj * 128 + wc * 32 + n * 16 + 4 * fq;
                            const f32x4 o = rv[mm][bj][n] + gt[bj][n] * acc[ai][bj][m][n]; acc[ai][bj][m][n] = o;
                            u32x2 w; w.x = pk2(o[0], o[1]); w.y = pk2(o[2], o[3]); *(u32x2*)(x1b + (size_t)row * D + col) = w; }
            }
        row_rstd_exchange(acc, u, wr, wc, fr, fq, lds, wid, lane, X);
        const LAS float* S = (const LAS float*)(lds + 4096);
#pragma unroll
        for (int bj = 0; bj < 2; ++bj)
#pragma unroll
            for (int n = 0; n < 2; ++n) { const int col = u.pn * 256 + bj * 128 + wc * 32 + n * 16 + 4 * fq;
                const f32x4 mul = *(const f32x4*)(gm + col) * (1.0f + *(const f32x4*)(mb + 4 * D + col)), sh = *(const f32x4*)(mb + 3 * D + col);
#pragma unroll
                for (int ai = 0; ai < 2; ++ai)
#pragma unroll
                    for (int m = 0; m < 4; ++m) { const int rl = ai * 128 + wr * 64 + m * 16 + fr; const float rs = S[rl]; const size_t row = (size_t)(u.pm * 256 + rl);
                        const f32x4 y = acc[ai][bj][m][n] * rs * mul + sh;
                        u32x2 w; w.x = pk2(y[0], y[1]); w.y = pk2(y[2], y[3]); *(u32x2*)(xnp + row * D + col) = w; } }
        __syncthreads();
    }
};
struct EpiFinalNorm {
    static constexpr bool AFTER_DRAIN = true;
    const bf16_t* res_b; float* out; const float* mod; const float* gfin; RowX X;
    __device__ __forceinline__ void fused(f32x4 (&acc)[2][2][4][2], const Unit& u, int wr, int wc, int fr, int fq, LAS unsigned char* lds, int wid, int lane) const {
        const float* mb = mod + (size_t)((u.pm * 256) >> 12) * NMOD;
#pragma unroll
        for (int ai = 0; ai < 2; ++ai) { u32x2 tv[4][2][2];
#pragma unroll
            for (int m = 0; m < 4; ++m)
#pragma unroll
                for (int bj = 0; bj < 2; ++bj)
#pragma unroll
                    for (int n = 0; n < 2; ++n) { const int row = u.pm * 256 + ai * 128 + wr * 64 + m * 16 + fr, col = u.pn * 256 + bj * 128 + wc * 32 + n * 16 + 4 * fq; tv[m][bj][n] = *(const u32x2*)(res_b + (size_t)row * D + col); }
#pragma unroll
            for (int m = 0; m < 4; ++m)
#pragma unroll
                for (int bj = 0; bj < 2; ++bj)
#pragma unroll
                    for (int n = 0; n < 2; ++n) { const int col = u.pn * 256 + bj * 128 + wc * 32 + n * 16 + 4 * fq; const u32x2 t = tv[m][bj][n];
                        const f32x4 gt = 0.5f * *(const f32x4*)(mb + 8 * D + col);
                        acc[ai][bj][m][n] = (f32x4){bflo(t.x), bfhi(t.x), bflo(t.y), bfhi(t.y)} + gt * acc[ai][bj][m][n]; }
        }
        row_rstd_exchange(acc, u, wr, wc, fr, fq, lds, wid, lane, X);
        const LAS float* S = (const LAS float*)(lds + 4096);
#pragma unroll
        for (int bj = 0; bj < 2; ++bj)
#pragma unroll
            for (int n = 0; n < 2; ++n) { const int col = u.pn * 256 + bj * 128 + wc * 32 + n * 16 + 4 * fq;
                const f32x4 gg = *(const f32x4*)(gfin + col);
#pragma unroll
                for (int ai = 0; ai < 2; ++ai)
#pragma unroll
                    for (int m = 0; m < 4; ++m) { const int rl = ai * 128 + wr * 64 + m * 16 + fr; const float rs = S[rl];
                        *(f32x4*)(out + (size_t)(u.pm * 256 + rl) * D + col) = acc[ai][bj][m][n] * rs * gg; } }
    }
};

enum { CV_PLAIN = 0, CV_UPI = 1, CV_RW = 2, CV_LRU = 3 };
__device__ __forceinline__ void cvt_store(const LAS float* scr, int tid, int k0, int n0, bf16_t* dst, int ldd, int mode, int p0, const float* sc) {
    const int nl = tid >> 3, kc = (tid & 7) * 8, n = n0 + nl;
    float s[8];
#pragma unroll
    for (int j = 0; j < 8; ++j) s[j] = scr[(kc + j) * 65 + nl];
    int row = n;
    if (mode == CV_UPI) row = 32 * (n >> 4) + 16 * p0 + (n & 15);
    else if (mode == CV_LRU) { const int dd = p0 >> 3, nb = (p0 >> 1) & 3, which = p0 & 1, c = 256 * nb + n; row = dd * 2048 + (c >> 7) * 256 + ((c & 127) >> 4) * 32 + which * 16 + (c & 15); }
    bf16_t* dp = dst + (size_t)row * ldd + k0 + kc;
    if (mode == CV_RW) { const float mu = sc[n], om = 1.0f - mu;
        u32x4 o; o.x = pk2(s[0] * om, s[1] * om); o.y = pk2(s[2] * om, s[3] * om); o.z = pk2(s[4] * om, s[5] * om); o.w = pk2(s[6] * om, s[7] * om);
        *(u32x4*)dp = o;
        o.x = pk2(s[0] * mu, s[1] * mu); o.y = pk2(s[2] * mu, s[3] * mu); o.z = pk2(s[4] * mu, s[5] * mu); o.w = pk2(s[6] * mu, s[7] * mu);
        *(u32x4*)(dp + 1024) = o;
    } else { u32x4 o; o.x = pk2(s[0], s[1]); o.y = pk2(s[2], s[3]); o.z = pk2(s[4], s[5]); o.w = pk2(s[6], s[7]); *(u32x4*)dp = o; }
}
__device__ __forceinline__ void cvt_run2(const float* src, int lds_, int K, int N, bf16_t* dst, int ldd, int mode, int p0, const float* sc, LAS float* scr, int bid, int nb) {
    const int tid = tidx(), ntn = N >> 6, nt = (K >> 6) * ntn;
    for (int t = bid; t < nt; t += 2 * nb) {
        const int t2 = t + nb; const bool has2 = t2 < nt;
        const int k0 = (t / ntn) << 6, n0 = (t % ntn) << 6, k1 = has2 ? (t2 / ntn) << 6 : k0, n1 = has2 ? (t2 % ntn) << 6 : n0;
        float va[8], vb[8];
#pragma unroll
        for (int j = 0; j < 8; ++j) { const int kk = (tid >> 6) + 8 * j, nn = tid & 63; va[j] = src[(size_t)(k0 + kk) * lds_ + n0 + nn]; vb[j] = src[(size_t)(k1 + kk) * lds_ + n1 + nn]; }
#pragma unroll
        for (int j = 0; j < 8; ++j) { const int kk = (tid >> 6) + 8 * j, nn = tid & 63; scr[kk * 65 + nn] = va[j]; scr[4160 + kk * 65 + nn] = vb[j]; }
        __syncthreads();
        cvt_store(scr, tid, k0, n0, dst, ldd, mode, p0, sc);
        if (has2) cvt_store(scr + 4160, tid, k1, n1, dst, ldd, mode, p0, sc);
        __syncthreads();
    }
}
__device__ __forceinline__ void cvt_run(const float* src, int lds_, int K, int N, bf16_t* dst, int ldd, int mode, int p0, const float* sc, LAS float* scr) {
    cvt_run2(src, lds_, K, N, dst, ldd, mode, p0, sc, scr, blockIdx.x, gridDim.x);
}
__device__ __forceinline__ void zero_fill(unsigned char* p, size_t row_bytes, size_t pitch, int rows) {
    const size_t per = row_bytes / 16, tot = per * rows;
    const int ztid = tidx();
    for (size_t i = (size_t)blockIdx.x * NTHREADS + ztid; i < tot; i += (size_t)gridDim.x * NTHREADS) {
        const size_t r = i / per, c = i % per; *(u32x4*)(p + r * pitch + c * 16) = (u32x4){0u, 0u, 0u, 0u}; }
}

__device__ __forceinline__ void mod_phase(const Params& p, float* mod, LAS float* red) {
    const int tid = tidx(), kq = tid >> 4, cq = tid & 15;
    const float* c = p.in[1]; const float* cc = p.in[3]; const float* wm = p.in[4]; const float* bm = p.in[5];
    for (int it = blockIdx.x; it < NMOD / 64; it += gridDim.x) {
        const int j0 = it * 64 + 4 * cq;
        f32x4 acc[5];
#pragma unroll
        for (int b = 0; b < 5; ++b) acc[b] = (f32x4){0.f, 0.f, 0.f, 0.f};
#pragma unroll 4
        for (int i = 0; i < 32; ++i) { const int k = kq + 32 * i;
            const f32x4 w = *(const f32x4*)(wm + (size_t)k * NMOD + j0);
            acc[0] += silu_f(c[k]) * w; acc[1] += silu_f(c[D + k]) * w; acc[2] += silu_f(c[2 * D + k]) * w; acc[3] += silu_f(c[3 * D + k]) * w; acc[4] += silu_f(cc[k]) * w; }
#pragma unroll
        for (int b = 0; b < 5; ++b)
#pragma unroll
            for (int j = 0; j < 4; ++j) red[(kq * 5 + b) * 64 + 4 * cq + j] = acc[b][j];
        __syncthreads();
        if (tid < 320) { const int b = tid >> 6, cl = tid & 63; float s = 0.f;
            for (int q = 0; q < 32; ++q) s += red[(q * 5 + b) * 64 + cl];
            mod[(size_t)b * NMOD + it * 64 + cl] = s + bm[it * 64 + cl]; }
        __syncthreads();
    }
}

template <bool LATB = false> __device__ __forceinline__ void norm_phase(const float* lat, const float* ctx, int nrows, const float* g, const float* mod, int ish, int isc, bf16_t* dst, int ldd, const float* ctx2 = nullptr, const bf16_t* latb = nullptr, bf16_t* dst2 = nullptr, int mstart = 0) {
    const int tid = tidx(), lane = tid & 63, gw = blockIdx.x * 8 + (tid >> 6), ngw = gridDim.x * 8;
    for (int m0 = mstart + gw; m0 < nrows; m0 += 2 * ngw) {
        const int m1 = m0 + ngw; const bool has1 = m1 < nrows; const int mb = has1 ? m1 : m0;
        const float* srca = m0 < MLAT ? lat + (size_t)m0 * D : ctx + (size_t)(m0 - MLAT) * D;
        const float* srcb = mb < MLAT ? lat + (size_t)mb * D : ctx + (size_t)(mb - MLAT) * D;
        f32x4 va[4], vb[4]; float sa = 0.f, sb = 0.f;
#pragma unroll
        for (int j = 0; j < 4; ++j) {
            if (LATB && m0 < MLAT) { const u32x2 t = *(const u32x2*)(latb + (size_t)m0 * D + 4 * lane + 256 * j); va[j] = (f32x4){bflo(t.x), bfhi(t.x), bflo(t.y), bfhi(t.y)}; } else va[j] = *(const f32x4*)(srca + 4 * lane + 256 * j);
            if (LATB && mb < MLAT) { const u32x2 t = *(const u32x2*)(latb + (size_t)mb * D + 4 * lane + 256 * j); vb[j] = (f32x4){bflo(t.x), bfhi(t.x), bflo(t.y), bfhi(t.y)}; } else vb[j] = *(const f32x4*)(srcb + 4 * lane + 256 * j); }
        if (ctx2) {
            if (m0 >= MLAT) { _Pragma("unroll") for (int j = 0; j < 4; ++j) va[j] += *(const f32x4*)(ctx2 + (size_t)(m0 - MLAT) * D + 4 * lane + 256 * j); }
            if (mb >= MLAT) { _Pragma("unroll") for (int j = 0; j < 4; ++j) vb[j] += *(const f32x4*)(ctx2 + (size_t)(mb - MLAT) * D + 4 * lane + 256 * j); } }
#pragma unroll
        for (int j = 0; j < 4; ++j) { sa += va[j][0] * va[j][0] + va[j][1] * va[j][1] + va[j][2] * va[j][2] + va[j][3] * va[j][3]; sb += vb[j][0] * vb[j][0] + vb[j][1] * vb[j][1] + vb[j][2] * vb[j][2] + vb[j][3] * vb[j][3]; }
#pragma unroll
        for (int o = 1; o < 64; o <<= 1) { sa += __shfl_xor(sa, o); sb += __shfl_xor(sb, o); }
        const float ra = rsqrtf(sa * (1.0f / D) + 1e-6f), rb = rsqrtf(sb * (1.0f / D) + 1e-6f);
        const int ba = m0 < MLAT ? (m0 >> 12) : 4, bb = mb < MLAT ? (mb >> 12) : 4;
        const float* sha = mod + (size_t)ba * NMOD + ish * D; const float* sca = mod + (size_t)ba * NMOD + isc * D;
        const float* shb = mod + (size_t)bb * NMOD + ish * D; const float* scb = mod + (size_t)bb * NMOD + isc * D;
#pragma unroll
        for (int j = 0; j < 4; ++j) { const int c = 4 * lane + 256 * j;
            const f32x4 gg = *(const f32x4*)(g + c);
            { const f32x4 s1 = *(const f32x4*)(sha + c), s2 = *(const f32x4*)(sca + c); const f32x4 y = va[j] * ra * gg * (1.0f + s2) + s1;
              u32x2 o; o.x = pk2(y[0], y[1]); o.y = pk2(y[2], y[3]); *(u32x2*)(dst + (size_t)m0 * ldd + c) = o; if (dst2 && m0 < MLAT) *(u32x2*)(dst2 + (size_t)m0 * D + c) = o; }
            if (has1) { const f32x4 s1 = *(const f32x4*)(shb + c), s2 = *(const f32x4*)(scb + c); const f32x4 y = vb[j] * rb * gg * (1.0f + s2) + s1;
              u32x2 o; o.x = pk2(y[0], y[1]); o.y = pk2(y[2], y[3]); *(u32x2*)(dst + (size_t)m1 * ldd + c) = o; if (dst2 && m1 < MLAT) *(u32x2*)(dst2 + (size_t)m1 * D + c) = o; } }
    }
}
__device__ __forceinline__ void final_norm_phase(float* x, const float* g) {
    const int tid = tidx(), lane = tid & 63, gw = blockIdx.x * 8 + (tid >> 6), ngw = gridDim.x * 8;
    for (int m0 = gw; m0 < MLAT; m0 += 2 * ngw) {
        const int m1 = m0 + ngw; const bool has1 = m1 < MLAT;
        float* sa_ = x + (size_t)m0 * D; float* sb_ = x + (size_t)(has1 ? m1 : m0) * D;
        f32x4 va[4], vb[4]; float sa = 0.f, sb = 0.f;
#pragma unroll
        for (int j = 0; j < 4; ++j) { va[j] = *(const f32x4*)(sa_ + 4 * lane + 256 * j); vb[j] = *(const f32x4*)(sb_ + 4 * lane + 256 * j); }
#pragma unroll
        for (int j = 0; j < 4; ++j) { sa += va[j][0] * va[j][0] + va[j][1] * va[j][1] + va[j][2] * va[j][2] + va[j][3] * va[j][3]; sb += vb[j][0] * vb[j][0] + vb[j][1] * vb[j][1] + vb[j][2] * vb[j][2] + vb[j][3] * vb[j][3]; }
#pragma unroll
        for (int o = 1; o < 64; o <<= 1) { sa += __shfl_xor(sa, o); sb += __shfl_xor(sb, o); }
        const float ra = rsqrtf(sa * (1.0f / D) + 1e-6f), rb = rsqrtf(sb * (1.0f / D) + 1e-6f);
#pragma unroll
        for (int j = 0; j < 4; ++j) { const int c = 4 * lane + 256 * j; const f32x4 gg = *(const f32x4*)(g + c);
            *(f32x4*)(sa_ + c) = va[j] * ra * gg; if (has1) *(f32x4*)(sb_ + c) = vb[j] * rb * gg; }
    }
}
__device__ __forceinline__ void add4(f32x4& a, const bf16_t* p) { const u32x2 t = *(const u32x2*)p; a[0] += bflo(t.x); a[1] += bfhi(t.x); a[2] += bflo(t.y); a[3] += bfhi(t.y); }
__device__ __forceinline__ void xs_phase(bf16_t* xnxs, const bf16_t* xnp, int nrows) {
    const int tid = tidx(), lane = tid & 63, gw = blockIdx.x * 8 + (tid >> 6), ngw = gridDim.x * 8;
    for (int m = gw; m < nrows; m += ngw) {
        int n0, n1, n2, n3; bool v0, v1, v2, v3; float wgt;
        if (m < MLAT) { const int t = m & 4095, gr = t >> 6, gc = t & 63; wgt = 0.25f; v0 = gr > 0; v1 = gr < 63; v2 = gc > 0; v3 = gc < 63; n0 = m - 64; n1 = m + 64; n2 = m - 1; n3 = m + 1; }
        else { const int j = (m - MLAT) & 255; wgt = 0.5f; v0 = false; v1 = false; v2 = j > 0; v3 = j < 255; n0 = m; n1 = m; n2 = m - 1; n3 = m + 1; }
        if (!v0) n0 = m; if (!v1) n1 = m; if (!v2) n2 = m; if (!v3) n3 = m;
        const float w0 = v0 ? wgt : 0.f, w1 = v1 ? wgt : 0.f, w2 = v2 ? wgt : 0.f, w3 = v3 ? wgt : 0.f;
        const bool plain = xnp != nullptr && m < MLAT;
        const bf16_t* sb = plain ? xnp : xnxs; const size_t ld = plain ? (size_t)D : (size_t)2048;
        u32x2 q0[4], q1[4], q2[4], q3[4], qs[4];
#pragma unroll
        for (int j = 0; j < 4; ++j) { const int c = 4 * lane + 256 * j;
            q0[j] = *(const u32x2*)(sb + (size_t)n0 * ld + c); q1[j] = *(const u32x2*)(sb + (size_t)n1 * ld + c);
            q2[j] = *(const u32x2*)(sb + (size_t)n2 * ld + c); q3[j] = *(const u32x2*)(sb + (size_t)n3 * ld + c); qs[j] = *(const u32x2*)(sb + (size_t)m * ld + c); }
#pragma unroll
        for (int j = 0; j < 4; ++j) { const int c = 4 * lane + 256 * j;
            const float a0 = w0 * bflo(q0[j].x) + w1 * bflo(q1[j].x) + w2 * bflo(q2[j].x) + w3 * bflo(q3[j].x);
            const float a1 = w0 * bfhi(q0[j].x) + w1 * bfhi(q1[j].x) + w2 * bfhi(q2[j].x) + w3 * bfhi(q3[j].x);
            const float a2 = w0 * bflo(q0[j].y) + w1 * bflo(q1[j].y) + w2 * bflo(q2[j].y) + w3 * bflo(q3[j].y);
            const float a3 = w0 * bfhi(q0[j].y) + w1 * bfhi(q1[j].y) + w2 * bfhi(q2[j].y) + w3 * bfhi(q3[j].y);
            u32x2 o; o.x = pk2(a0, a1); o.y = pk2(a2, a3);
            *(u32x2*)(xnxs + (size_t)m * 2048 + 1024 + c) = o;
            if (plain) *(u32x2*)(xnxs + (size_t)m * 2048 + c) = qs[j]; }
    }
}
__device__ __forceinline__ void xs_ctx_phase(const float* c1, const float* c2, const float* g, const float* mod, bf16_t* xnxs) {
    const int tid = tidx(), lane = tid & 63, gw = (int)gridDim.x * 8 - 1 - ((int)blockIdx.x * 8 + (tid >> 6)), ngw = gridDim.x * 8;
    const float* sh = mod + (size_t)4 * NMOD + 3 * D; const float* sc = mod + (size_t)4 * NMOD + 4 * D;
    for (int r = gw; r < MCTX; r += ngw) {
        const int j = r & 255; const bool vp = j > 0, vn = j < 255;
        const int rr[3] = {vp ? r - 1 : r, r, vn ? r + 1 : r};
        f32x4 x[3][4];
#pragma unroll
        for (int q = 0; q < 3; ++q)
#pragma unroll
            for (int i = 0; i < 4; ++i) { const size_t off = (size_t)rr[q] * D + 4 * lane + 256 * i; x[q][i] = *(const f32x4*)(c1 + off) + *(const f32x4*)(c2 + off); }
        float ss[3];
#pragma unroll
        for (int q = 0; q < 3; ++q) { float t = 0.f;
#pragma unroll
            for (int i = 0; i < 4; ++i) t += (x[q][i][0] * x[q][i][0] + x[q][i][1] * x[q][i][1]) + (x[q][i][2] * x[q][i][2] + x[q][i][3] * x[q][i][3]);
            ss[q] = t; }
#pragma unroll
        for (int o = 1; o < 64; o <<= 1) { ss[0] += __shfl_xor(ss[0], o); ss[1] += __shfl_xor(ss[1], o); ss[2] += __shfl_xor(ss[2], o); }
        const float r0 = rsqrtf(ss[0] * (1.0f / D) + 1e-6f) * (vp ? 0.5f : 0.f), r1 = rsqrtf(ss[1] * (1.0f / D) + 1e-6f), r2 = rsqrtf(ss[2] * (1.0f / D) + 1e-6f) * (vn ? 0.5f : 0.f);
        const float wsh = (vp ? 0.5f : 0.f) + (vn ? 0.5f : 0.f);
#pragma unroll
        for (int i = 0; i < 4; ++i) { const int c = 4 * lane + 256 * i;
            const f32x4 mul = *(const f32x4*)(g + c) * (1.0f + *(const f32x4*)(sc + c)), s0 = *(const f32x4*)(sh + c);
            const f32x4 xn = x[1][i] * r1 * mul + s0;
            const f32x4 xs = (x[0][i] * r0 + x[2][i] * r2) * mul + wsh * s0;
            u32x2 o; o.x = pk2(xn[0], xn[1]); o.y = pk2(xn[2], xn[3]); *(u32x2*)(xnxs + (size_t)(MLAT + r) * 2048 + c) = o;
            o.x = pk2(xs[0], xs[1]); o.y = pk2(xs[2], xs[3]); *(u32x2*)(xnxs + (size_t)(MLAT + r) * 2048 + 1024 + c) = o; }
    }
}
__device__ __forceinline__ void conv_phase(const bf16_t* plx, const bf16_t* plxc, bf16_t* xc, const float* cw, const float* cb) {
    const int tid = tidx(), lane = tid & 63, gw = blockIdx.x * 8 + (tid >> 6), ngw = gridDim.x * 8;
    f32x4 wv[4][4], bv[4];
#pragma unroll
    for (int j = 0; j < 4; ++j) { bv[j] = *(const f32x4*)(cb + 4 * lane + 256 * j);
#pragma unroll
        for (int q = 0; q < 4; ++q) wv[q][j] = *(const f32x4*)(cw + q * D + 4 * lane + 256 * j); }
    for (int m = gw; m < MALL; m += ngw) {
        int t, len; if (m < MLAT) { t = m & 4095; len = 4096; } else { t = (m - MLAT) & 255; len = 256; }
        const bf16_t* pb = m < MLAT ? plx : plxc - (size_t)MLAT * D;
        int rq[4]; float wq[4];
#pragma unroll
        for (int q = 0; q < 4; ++q) { const int tt = t + q - 1; const bool ok = tt >= 0 && tt < len; rq[q] = ok ? m + q - 1 : m; wq[q] = ok ? 1.f : 0.f; }
        u32x2 x[4][4];
#pragma unroll
        for (int q = 0; q < 4; ++q)
#pragma unroll
            for (int j = 0; j < 4; ++j) x[q][j] = *(const u32x2*)(pb + (size_t)rq[q] * D + 4 * lane + 256 * j);
#pragma unroll
        for (int j = 0; j < 4; ++j) { const int c = 4 * lane + 256 * j; f32x4 a = bv[j];
#pragma unroll
            for (int q = 0; q < 4; ++q) { const f32x4 w = wv[q][j] * wq[q];
                a[0] += w[0] * bflo(x[q][j].x); a[1] += w[1] * bfhi(x[q][j].x); a[2] += w[2] * bflo(x[q][j].y); a[3] += w[3] * bfhi(x[q][j].y); }
            u32x2 o; o.x = pk2(a[0], a[1]); o.y = pk2(a[2], a[3]);
            *(u32x2*)(xc + (size_t)m * D + c) = o; }
    }
}
__device__ __forceinline__ void rncb_phase(const bf16_t* R, const bf16_t* Kk, const float* k_k, const float* r_k, float* rn, float* cbv) {
    const int tid = tidx(), g16 = (blockIdx.x * NTHREADS + tid) >> 4, ng = (gridDim.x * NTHREADS) >> 4, l = tid & 15;
    for (int it0 = g16; it0 < MALL * 16; it0 += 4 * ng) {
        u32x2 kv[4], rv[4];
#pragma unroll
        for (int u = 0; u < 4; ++u) { const int it = it0 + u * ng; kv[u] = (u32x2){0u, 0u}; rv[u] = (u32x2){0u, 0u};
            if (it < MALL * 16) { const size_t off = (size_t)(it >> 4) * D + (it & 15) * 64 + 4 * l; kv[u] = *(const u32x2*)(Kk + off); rv[u] = *(const u32x2*)(R + off); } }
#pragma unroll
        for (int u = 0; u < 4; ++u) { const int it = it0 + u * ng;
            if (it < MALL * 16) { const int c = (it & 15) * 64 + 4 * l;
                const f32x4 kk = *(const f32x4*)(k_k + c), rk = *(const f32x4*)(r_k + c);
                const float k0 = bflo(kv[u].x), k1 = bfhi(kv[u].x), k2 = bflo(kv[u].y), k3 = bfhi(kv[u].y);
                float s1 = k0 * kk[0] * k0 * kk[0] + k1 * kk[1] * k1 * kk[1] + k2 * kk[2] * k2 * kk[2] + k3 * kk[3] * k3 * kk[3];
                float s2 = bflo(rv[u].x) * k0 * rk[0] + bfhi(rv[u].x) * k1 * rk[1] + bflo(rv[u].y) * k2 * rk[2] + bfhi(rv[u].y) * k3 * rk[3];
                s1 = red16(s1); s2 = red16(s2);
                if (l == 0) { rn[it] = __builtin_amdgcn_rsqf(fmaxf(s1, 1e-24f)); cbv[it] = s2; } } }
    }
}
__device__ __forceinline__ void post_phase(bf16_t* YF, const bf16_t* YB, const bf16_t* V, const float* cbv, const float* lnw, const float* lnb) {
    const int tid = tidx(), g16 = (blockIdx.x * NTHREADS + tid) >> 4, ng = (gridDim.x * NTHREADS) >> 4, l = tid & 15;
    for (int it0 = g16; it0 < MLAT * 16; it0 += 4 * ng) {
        u32x2 av[4], bv[4], vv[4]; float cbs[4];
#pragma unroll
        for (int u = 0; u < 4; ++u) { const int it = it0 + u * ng; av[u] = (u32x2){0u, 0u}; bv[u] = av[u]; vv[u] = av[u]; cbs[u] = 0.f;
            if (it < MLAT * 16) { const size_t off = (size_t)(it >> 4) * D + (it & 15) * 64 + 4 * l; av[u] = *(const u32x2*)(YF + off); bv[u] = *(const u32x2*)(YB + off); vv[u] = *(const u32x2*)(V + off); cbs[u] = cbv[it]; } }
#pragma unroll
        for (int u = 0; u < 4; ++u) { const int it = it0 + u * ng;
            if (it < MLAT * 16) { const int c = (it & 15) * 64 + 4 * l; const size_t off = (size_t)(it >> 4) * D + c;
                float y[4] = {bflo(av[u].x) + bflo(bv[u].x), bfhi(av[u].x) + bfhi(bv[u].x), bflo(av[u].y) + bflo(bv[u].y), bfhi(av[u].y) + bfhi(bv[u].y)};
                const float mu = red16(y[0] + y[1] + y[2] + y[3]) * (1.0f / 64.0f);
                float q = 0.f;
#pragma unroll
                for (int j = 0; j < 4; ++j) { y[j] -= mu; q += y[j] * y[j]; }
                const float rs = rsqrtf(red16(q) * (1.0f / 64.0f) + 64e-5f);
                const f32x4 w = *(const f32x4*)(lnw + c), bb = *(const f32x4*)(lnb + c);
                const float v4[4] = {bflo(vv[u].x), bfhi(vv[u].x), bflo(vv[u].y), bfhi(vv[u].y)};
                float o[4];
#pragma unroll
                for (int j = 0; j < 4; ++j) o[j] = y[j] * rs * w[j] + bb[j] + cbs[u] * v4[j];
                u32x2 ov; ov.x = pk2(o[0], o[1]); ov.y = pk2(o[2], o[3]);
                *(u32x2*)(YF + off) = ov; } }
    }
}

constexpr int RS_STRIDE = 324;
constexpr int RS_BUF = 32 * RS_STRIDE + 1024 + 4096;
__device__ __forceinline__ int scan_row(int b, int dir, int s) {
    if (s < 256) return MLAT + b * 256 + (dir ? 255 - s : s);
    return b * 4096 + (dir ? 4095 - (s - 256) : (s - 256));
}
struct ScanIn { bf16x8 afr[2][2]; unsigned short xv[8]; float rnv[8]; unsigned vpair; };
__device__ __forceinline__ void rwkv_scan_phase(const Params& p, LAS float* lds) {
    unsigned char* ws = p.ws;
    const bf16_t* R = (const bf16_t*)(ws + O_R); const bf16_t* Kk = (const bf16_t*)(ws + O_K); const bf16_t* V = (const bf16_t*)(ws + O_V);
    const bf16_t* LIN = (const bf16_t*)(ws + O_LIN); const float* rn = (const float*)(ws + O_RN);
    const int tid = tidx(), lane = tid & 63, w = __builtin_amdgcn_readfirstlane(tid >> 6), fr = lane & 15, fq = lane >> 4;
    const int cgp = lane & 15, rw = lane >> 4;
    for (int unit = blockIdx.x; unit < 256; unit += gridDim.x) {
        const int xcd = unit & 7, slot = unit >> 3, half = slot & 1, chain = (slot >> 1) * 8 + xcd, dir = chain & 1, h = (chain >> 1) & 15, b = chain >> 5;
        bf16_t* Y = (bf16_t*)(ws + (dir ? O_YB : O_YF));
        const int lora = w >> 2, ct = w & 3, col = h * 64 + 16 * ct + fr;
        bf16x8 bfr[2];
        { const bf16_t* wt = (const bf16_t*)(ws + (lora ? O_LSCA : O_LSCW)) + (size_t)(dir * 1024 + col) * 64 + 8 * fq;
          bfr[0] = *(const bf16x8*)(wt); bfr[1] = *(const bf16x8*)(wt + 32); }
        const float c_bias = lora ? p.in[15][dir * D + col] : p.in[13][dir * D + col];
        const float c_kk = p.in[18][col], c_ka = p.in[19][col];
        const int lcol0 = (lora ? 128 : 0) + dir * 64;
        const int sgn = dir ? -1 : 1;
        f32x2 SA = (f32x2){0.f, 0.f}, SB = (f32x2){0.f, 0.f};
        ScanIn in;
#define SCAN_LOAD(c) do { const int m0 = scan_row(b, dir, 32 * (c)); \
            _Pragma("unroll") for (int tt = 0; tt < 2; ++tt) { const size_t mr = (size_t)(m0 + sgn * (16 * tt + fr)); \
                _Pragma("unroll") for (int ks = 0; ks < 2; ++ks) in.afr[tt][ks] = *(const bf16x8*)(LIN + mr * 256 + lcol0 + 32 * ks + 8 * fq); } \
            _Pragma("unroll") for (int tt = 0; tt < 2; ++tt) _Pragma("unroll") for (int j = 0; j < 4; ++j) { const size_t mr = (size_t)(m0 + sgn * (16 * tt + 4 * fq + j)); \
                in.xv[tt * 4 + j] = (lora ? Kk : R)[mr * D + col]; in.rnv[tt * 4 + j] = rn[mr * 16 + h]; } \
            { const size_t mr = (size_t)(m0 + sgn * (tid >> 4)); in.vpair = *(const unsigned*)(V + mr * D + h * 64 + half * 32 + 2 * (tid & 15)); } } while (0)
#define SCAN_PRODUCE(bufi) do { LAS float* sb = lds + (bufi) * RS_BUF; \
            _Pragma("unroll") for (int tt = 0; tt < 2; ++tt) { f32x4 acc = (f32x4){0.f, 0.f, 0.f, 0.f}; \
                acc = __builtin_amdgcn_mfma_f32_16x16x32_bf16(in.afr[tt][0], bfr[0], acc, 0, 0, 0); acc = __builtin_amdgcn_mfma_f32_16x16x32_bf16(in.afr[tt][1], bfr[1], acc, 0, 0, 0); \
                _Pragma("unroll") for (int j = 0; j < 4; ++j) { LAS float* rec = sb + (16 * tt + 4 * fq + j) * RS_STRIDE + 16 * ct + fr; const float x = bf2f(in.xv[tt * 4 + j]); \
                    if (lora == 0) { rec[0] = __expf(-0.60653066f * sigm(c_bias + acc[j])); rec[256] = x; } \
                    else { const float a = sigm(c_bias + acc[j]), kkv = x * c_kk * in.rnv[tt * 4 + j]; rec[64] = x * (1.0f + (a - 1.0f) * c_ka); rec[128] = -kkv; rec[192] = kkv * a; } } } \
            { LAS float* vb = sb + 32 * RS_STRIDE + (tid >> 4) * 32 + 2 * (tid & 15); vb[0] = bflo(in.vpair); vb[1] = bfhi(in.vpair); } } while (0)
#define SCAN_YOUT(c, bufi) do { if ((c) >= 8) { const LAS float* yb_ = lds + (bufi) * RS_BUF + 32 * RS_STRIDE + 1024 + ((tid >> 4) * 32 + 2 * (tid & 15)) * 4; \
            const f32x4 ya = *(const LAS f32x4*)(yb_), yc = *(const LAS f32x4*)(yb_ + 4); \
            const size_t mr = (size_t)(scan_row(b, dir, 32 * (c)) + sgn * (tid >> 4)); \
            *(unsigned*)(Y + mr * D + h * 64 + half * 32 + 2 * (tid & 15)) = pk2((ya[0] + ya[1]) + (ya[2] + ya[3]), (yc[0] + yc[1]) + (yc[2] + yc[3])); } } while (0)
        SCAN_LOAD(0);
        SCAN_PRODUCE(0);
        __syncthreads();
        for (int c = 0; c < 136; ++c) {
            const int cur = c & 1;
            if (c + 1 < 136) SCAN_LOAD(c + 1);
            if (c > 0 && w >= 4) SCAN_YOUT(c - 1, cur ^ 1);
            const LAS float* sp0 = lds + cur * RS_BUF + 4 * cgp;
            const LAS float* vb = lds + cur * RS_BUF + 32 * RS_STRIDE + w * 4 + rw;
            LAS float* yb = lds + cur * RS_BUF + 32 * RS_STRIDE + 1024 + (w * 4 + rw) * 4 + (cgp >> 2);
            f32x4 w4 = *(const LAS f32x4*)(sp0), kd4 = *(const LAS f32x4*)(sp0 + 64), ka4 = *(const LAS f32x4*)(sp0 + 192), r4 = *(const LAS f32x4*)(sp0 + 256);
            f32x4 nk1 = *(const LAS f32x4*)(sp0 + RS_STRIDE + 128);
            float vv = vb[0];
            float sa;
            { const f32x4 nk0 = *(const LAS f32x4*)(sp0 + 128); const f32x2 q = SA * (f32x2){nk0[0], nk0[1]} + SB * (f32x2){nk0[2], nk0[3]}; sa = red16(q[0] + q[1]); }
#define SCAN_STEPS(i0, cnt, YON) _Pragma("unroll") for (int ii = 0; ii < (cnt); ++ii) { const int i = (i0) + ii; \
                f32x4 w4n = w4, kd4n = kd4, ka4n = ka4, r4n = r4, nk2 = nk1; float vvn = vv; \
                if (i + 1 < 32) { const LAS float* spn = sp0 + (i + 1) * RS_STRIDE; \
                    w4n = *(const LAS f32x4*)(spn); kd4n = *(const LAS f32x4*)(spn + 64); ka4n = *(const LAS f32x4*)(spn + 192); r4n = *(const LAS f32x4*)(spn + 256); vvn = vb[(i + 1) * 32]; } \
                if (i + 2 < 32) nk2 = *(const LAS f32x4*)(sp0 + (i + 2) * RS_STRIDE + 128); \
                { const f32x2 ba = SA * (f32x2){w4[0], w4[1]} + vv * (f32x2){kd4[0], kd4[1]}, bb = SB * (f32x2){w4[2], w4[3]} + vv * (f32x2){kd4[2], kd4[3]};     \
                  SA = sa * (f32x2){ka4[0], ka4[1]} + ba; SB = sa * (f32x2){ka4[2], ka4[3]} + bb; }                                                     \
                float sn = 0.f; \
                if (i + 1 < 32) { const f32x2 ps = SA * (f32x2){nk1[0], nk1[1]} + SB * (f32x2){nk1[2], nk1[3]}; sn = ps[0] + ps[1]; } \
                if (YON) { const f32x2 py = SA * (f32x2){r4[0], r4[1]} + SB * (f32x2){r4[2], r4[3]}; float yp = py[0] + py[1]; \
                    sn += dppf<0xB1>(sn); yp += dppf<0xB1>(yp); sn += dppf<0x4E>(sn); yp += dppf<0x4E>(yp); sn += dppf<0x141>(sn); sn += dppf<0x140>(sn); \
                    if ((cgp & 3) == 0) yb[i * 128] = yp; } \
                else { sn += dppf<0xB1>(sn); sn += dppf<0x4E>(sn); sn += dppf<0x141>(sn); sn += dppf<0x140>(sn); }     \
                sa = sn; w4 = w4n; kd4 = kd4n; ka4 = ka4n; r4 = r4n; vv = vvn; nk1 = nk2; }
            __builtin_amdgcn_s_setprio(2);
#define SCAN_CHUNK(YON) \
            SCAN_STEPS(0, 8, YON) \
            if (c + 1 < 136 && w < 4) { __builtin_amdgcn_s_setprio(0); SCAN_PRODUCE(cur ^ 1); __builtin_amdgcn_s_setprio(2); }     \
            SCAN_STEPS(8, 8, YON) \
            if (c > 0 && w < 4) SCAN_YOUT(c - 1, cur ^ 1); \
            SCAN_STEPS(16, 8, YON) \
            if (c + 1 < 136 && w >= 4) { __builtin_amdgcn_s_setprio(0); SCAN_PRODUCE(cur ^ 1); __builtin_amdgcn_s_setprio(2); } \
            SCAN_STEPS(24, 8, YON)
            if (c < 8) { SCAN_CHUNK(false) } else { SCAN_CHUNK(true) }
#undef SCAN_CHUNK
            __builtin_amdgcn_s_setprio(0);
#undef SCAN_STEPS
            __syncthreads();
        }
        SCAN_YOUT(135, 1);
        __syncthreads();
#undef SCAN_LOAD
#undef SCAN_PRODUCE
#undef SCAN_YOUT
    }
}

__device__ __forceinline__ void lru_p1_phase(const Params& p) {
    unsigned char* ws = p.ws; const float* lam = (const float*)(ws + O_CL);
    float* PQ = (float*)(ws + O_PQ);
    const int tid = tidx(), lane = tid & 63, half = lane >> 5, l32 = lane & 31, gw = blockIdx.x * 8 + (tid >> 6), ngw = gridDim.x * 8;
    for (int it = gw; it < 2 * 4 * 68 * 16; it += ngw) {
        const int cb16 = it & 15, j = (it >> 4) % 68, b = ((it >> 4) / 68) & 3, d = (it >> 4) / 272;
        const int c = cb16 * 64 + 2 * l32;
        const bf16_t* GR = (const bf16_t*)(ws + (d ? O_GRB : O_GRF)); const bf16_t* UU = (const bf16_t*)(ws + (d ? O_UB : O_UF));
        const float cl0 = lam[d * D + c], cl1 = lam[d * D + c + 1];
        float P0 = 1.f, P1 = 1.f, Q0 = 0.f, Q1 = 0.f;
        const int sgn = d ? -1 : 1, m0 = scan_row(b, d, 64 * j) + sgn * 32 * half;
#pragma unroll 8
        for (int i = 0; i < 32; ++i) { const size_t off = (size_t)(m0 + sgn * i) * D + c;
            const unsigned g = *(const unsigned*)(GR + off), uv = *(const unsigned*)(UU + off);
            const float a0 = __expf(bflo(g) * cl0), a1 = __expf(bfhi(g) * cl1);
            P0 *= a0; P1 *= a1; Q0 = a0 * Q0 + bflo(uv); Q1 = a1 * Q1 + bfhi(uv); }
        const float oP0 = __shfl_xor(P0, 32), oP1 = __shfl_xor(P1, 32), oQ0 = __shfl_xor(Q0, 32), oQ1 = __shfl_xor(Q1, 32);
        if (half == 0) { const size_t o = ((size_t)((d * 4 + b) * 68 + j)) * D + c;
            *(f32x2*)(PQ + o) = (f32x2){P0 * oP0, P1 * oP1}; *(f32x2*)(PQ + (size_t)2 * 4 * 68 * D + o) = (f32x2){oP0 * Q0 + oQ0, oP1 * Q1 + oQ1}; }
    }
}
__device__ __forceinline__ void lru_p3_phase(const Params& p) {
    unsigned char* ws = p.ws; const float* lam = (const float*)(ws + O_CL);
    const float* PQ = (const float*)(ws + O_PQ); const float* QQ = PQ + (size_t)2 * 4 * 68 * D;
    bf16_t* HS = (bf16_t*)(ws + O_HSUM);
    const int tid = tidx(), lane = tid & 63, gw = blockIdx.x * 8 + (tid >> 6), ngw = gridDim.x * 8;
    for (int it = gw; it < 4 * 64 * 8; it += ngw) {
        const int cb8 = it & 7, T = (it >> 3) & 63, b = it >> 9, c = cb8 * 128 + 2 * lane;
        {
            const bf16_t* GR = (const bf16_t*)(ws + O_GRF); const bf16_t* UU = (const bf16_t*)(ws + O_UF);
            const float cl0 = lam[c], cl1 = lam[c + 1];
            float h0 = 0.f, h1 = 0.f;
#pragma unroll 8
            for (int jj = 0; jj < 4 + T; ++jj) { const size_t o = ((size_t)(b * 68 + jj)) * D + c; const f32x2 P = *(const f32x2*)(PQ + o), Q = *(const f32x2*)(QQ + o); h0 = P[0] * h0 + Q[0]; h1 = P[1] * h1 + Q[1]; }
            for (int i0 = 0; i0 < 64; i0 += 8) {
                unsigned g[8], uv[8];
#pragma unroll
                for (int i = 0; i < 8; ++i) { const size_t off = (size_t)(b * 4096 + 64 * T + i0 + i) * D + c; g[i] = *(const unsigned*)(GR + off); uv[i] = *(const unsigned*)(UU + off); }
#pragma unroll
                for (int i = 0; i < 8; ++i) { const size_t off = (size_t)(b * 4096 + 64 * T + i0 + i) * D + c;
                    h0 = __expf(bflo(g[i]) * cl0) * h0 + bflo(uv[i]); h1 = __expf(bfhi(g[i]) * cl1) * h1 + bfhi(uv[i]);
                    *(unsigned*)(HS + off) = pk2(h0, h1); }
            }
        }
        {
            const bf16_t* GR = (const bf16_t*)(ws + O_GRB); const bf16_t* UU = (const bf16_t*)(ws + O_UB);
            const float cl0 = lam[D + c], cl1 = lam[D + c + 1];
            float h0 = 0.f, h1 = 0.f;
#pragma unroll 8
            for (int jj = 0; jj < 67 - T; ++jj) { const size_t o = ((size_t)((4 + b) * 68 + jj)) * D + c; const f32x2 P = *(const f32x2*)(PQ + o), Q = *(const f32x2*)(QQ + o); h0 = P[0] * h0 + Q[0]; h1 = P[1] * h1 + Q[1]; }
            for (int i0 = 0; i0 < 64; i0 += 8) {
                unsigned g[8], uv[8], f[8];
#pragma unroll
                for (int i = 0; i < 8; ++i) { const size_t off = (size_t)(b * 4096 + 64 * T + 63 - i0 - i) * D + c; g[i] = *(const unsigned*)(GR + off); uv[i] = *(const unsigned*)(UU + off); f[i] = *(const unsigned*)(HS + off); }
#pragma unroll
                for (int i = 0; i < 8; ++i) { const size_t off = (size_t)(b * 4096 + 64 * T + 63 - i0 - i) * D + c;
                    h0 = __expf(bflo(g[i]) * cl0) * h0 + bflo(uv[i]); h1 = __expf(bfhi(g[i]) * cl1) * h1 + bfhi(uv[i]);
                    *(unsigned*)(HS + off) = pk2(bflo(f[i]) + h0, bfhi(f[i]) + h1); }
            }
        }
    }
}

#define XB_XCNT(j) (64 * (j))
#define XB_XSUB(j) (1024 + 64 * (j))
#define XB_XGEN(j) (2048 + 64 * (j))
#define XB_TOP 3072
#define XB_TOPGEN 3136
#define XB_WORDS 3200
__device__ __forceinline__ unsigned xb_ld(unsigned* p) { return __hip_atomic_load(p, __ATOMIC_RELAXED, __HIP_MEMORY_SCOPE_AGENT); }
__device__ __forceinline__ unsigned xb_add(unsigned* p, unsigned v) { return __hip_atomic_fetch_add(p, v, __ATOMIC_RELAXED, __HIP_MEMORY_SCOPE_AGENT); }
__device__ __forceinline__ void xb_st(unsigned* p, unsigned v) { __hip_atomic_store(p, v, __ATOMIC_RELAXED, __HIP_MEMORY_SCOPE_AGENT); }
struct XBar { unsigned* bar; unsigned x, nloc, nx, k; };
__device__ __forceinline__ void xbar_init(XBar& B, unsigned* bar) {
    B.bar = bar; B.x = (unsigned)__builtin_amdgcn_s_getreg((3 << 11) | 20) & 0xFu; B.nloc = 0u; B.nx = 0u; B.k = 0u;
    if (threadIdx.x == 0) (void)xb_add(&bar[XB_XCNT(B.x)], 1u);
}
__device__ __forceinline__ void gbar(XBar& B) {
    asm volatile("s_waitcnt vmcnt(0)" ::: "memory");
    __syncthreads();
    B.k += 1u;
    if (threadIdx.x == 0) {
        unsigned* bar = B.bar;
        if (B.nloc == 0u) {
            unsigned sum, cnt, mine;
            for (;;) { sum = 0u; cnt = 0u; mine = 0u;
#pragma unroll
                for (unsigned j = 0; j < 16; ++j) { const unsigned c = xb_ld(&bar[XB_XCNT(j)]); sum += c; cnt += (c > 0u) ? 1u : 0u; mine = (j == B.x) ? c : mine; }
                if (sum == gridDim.x) break;
                __builtin_amdgcn_s_sleep(1); }
            B.nloc = mine; B.nx = cnt;
        }
        const unsigned old = xb_add(&bar[XB_XSUB(B.x)], 1u);
        if (old + 1u == B.k * B.nloc) {
            __builtin_amdgcn_fence(__ATOMIC_RELEASE, "agent");
            asm volatile("s_waitcnt vmcnt(0)" ::: "memory");
            const unsigned t = xb_add(&bar[XB_TOP], 1u);
            if (t + 1u == B.k * B.nx) xb_st(&bar[XB_TOPGEN], B.k);
            else while (xb_ld(&bar[XB_TOPGEN]) < B.k) __builtin_amdgcn_s_sleep(1);
        } else {
            while (xb_ld(&bar[XB_TOPGEN]) < B.k) __builtin_amdgcn_s_sleep(1);
        }
        __builtin_amdgcn_fence(__ATOMIC_ACQUIRE, "agent");
        asm volatile("s_waitcnt vmcnt(0)" ::: "memory");
    }
    __syncthreads();
}

__device__ __forceinline__ Gemm mk_gemm(const void* A, const void* Bt, int M, int N, int K, int lda, int ldb) { Gemm g; g.A = (const bf16_t*)A; g.Bt = (const bf16_t*)Bt; g.M = M; g.N = N; g.K = K; g.lda = lda; g.ldb = ldb; g.ksh = 0; g.kmask = 0; g.kmul = 0; return g; }

__global__ void __launch_bounds__(NTHREADS, 2) mega(Params p) {
    extern __shared__ __attribute__((aligned(16))) unsigned char shm[];
    LAS unsigned char* lds = (LAS unsigned char*)shm;
    LAS float* ldsf = (LAS float*)shm;
    cg::grid_group grid = cg::this_grid();
    unsigned char* ws = p.ws;
    float* mod = (float*)(ws + O_MOD);
    bf16_t* X1B = (bf16_t*)p.out;
    bf16_t* XNP = (bf16_t*)p.out + (size_t)MLAT * D;
    pg8::StaticOrder S;
    XBar XB; xbar_init(XB, (unsigned*)(ws + O_BAR));
#define BF(off) ((bf16_t*)(ws + (off)))
#define GSYNC() gbar(XB)
    if (p.ws == nullptr) grid.sync();
    cvt_run(p.in[7], DFF, D, DFF, BF(O_UP1), D, CV_UPI, 0, nullptr, ldsf);
    cvt_run(p.in[8], DFF, D, DFF, BF(O_UP1), D, CV_UPI, 1, nullptr, ldsf);
    cvt_run(p.in[9], D, DFF, D, BF(O_DN1), DFF, CV_PLAIN, 0, nullptr, ldsf);
    mod_phase(p, mod, ldsf);
    GSYNC();
    norm_phase(p.in[0], p.in[2], MALL, p.in[6], mod, 0, 1, BF(O_HN), D);
    GSYNC();
    { S.init(MALL, 2 * DFF, gridDim.x, blockIdx.x); EpiUp E{BF(O_U)}; pg8::gemm_phase(lds, mk_gemm(BF(O_HN), BF(O_UP1), MALL, 2 * DFF, D, D, D), S, E); }
    GSYNC();
    const bool fuse_ok = gridDim.x == 256;
    if (fuse_ok) { S.init(MLAT, D, gridDim.x, blockIdx.x); EpiDn1Norm E{p.in[0], X1B, BF(O_XNXS), XNP, mod, p.in[10], RowX{(unsigned*)(ws + O_XSLOT_C), (unsigned*)(ws + O_XCNT_C)}};
        pg8::gemm_phase(lds, mk_gemm(BF(O_U), BF(O_DN1), MLAT, D, DFF, DFF, DFF), S, E); }
    else { S.init(MLAT, D, gridDim.x, blockIdx.x); EpiRes<false, true> E{p.in[0], nullptr, nullptr, X1B, mod, 2, 0.5f}; pg8::gemm_phase(lds, mk_gemm(BF(O_U), BF(O_DN1), MLAT, D, DFF, DFF, DFF), S, E); }
    { const float* gate = mod + (size_t)4 * NMOD + 2 * D; const bf16_t* Uc = BF(O_U) + (size_t)MLAT * DFF;
      { S.init(MCTX, D, gridDim.x, blockIdx.x); EpiCtx E{p.in[2], (float*)(ws + O_CTXX1), gate, 0.5f}; pg8::gemm_phase(lds, mk_gemm(Uc, BF(O_DN1), MCTX, D, DFF / 2, DFF, DFF), S, E); }
      { S.init(MCTX, D, gridDim.x, ((int)blockIdx.x + (int)gridDim.x - 16) % (int)gridDim.x); EpiCtx E{nullptr, (float*)(ws + O_CTXP2), gate, 0.5f}; pg8::gemm_phase(lds, mk_gemm(Uc + DFF / 2, BF(O_DN1) + DFF / 2, MCTX, D, DFF / 2, DFF, DFF), S, E); } }
    { const int cnb = gridDim.x > 64 ? (int)gridDim.x - 32 : (int)gridDim.x, cbid = gridDim.x > 64 ? (int)blockIdx.x - 32 : (int)blockIdx.x;
      if (cbid >= 0) {
        cvt_run2(p.in[11], 7552, D, 3456, BF(O_RW), 2048, CV_RW, 0, p.in[12], ldsf, cbid, cnb);
        for (int d = 0; d < 2; ++d) { cvt_run2(p.in[14] + (size_t)d * 64 * D, D, 64, D, BF(O_LSCW) + (size_t)d * D * 64, 64, CV_PLAIN, 0, nullptr, ldsf, cbid, cnb);
                                      cvt_run2(p.in[16] + (size_t)d * 64 * D, D, 64, D, BF(O_LSCA) + (size_t)d * D * 64, 64, CV_PLAIN, 0, nullptr, ldsf, cbid, cnb); }
        cvt_run2(p.in[17], D, 128, D, BF(O_GUP), 256, CV_PLAIN, 0, nullptr, ldsf, cbid, cnb);
        cvt_run2(p.in[11] + 3456, 7552, D, D, BF(O_LX), D, CV_PLAIN, 0, nullptr, ldsf, cbid, cnb);
        for (int q = 0; q < 8; ++q) { cvt_run2(p.in[27] + (size_t)q * 65536, 256, 256, 256, BF(O_LRUW), 256, CV_LRU, q * 2 + 0, nullptr, ldsf, cbid, cnb);
                                      cvt_run2(p.in[29] + (size_t)q * 65536, 256, 256, 256, BF(O_LRUW), 256, CV_LRU, q * 2 + 1, nullptr, ldsf, cbid, cnb); }
      } }
    zero_fill(ws + O_RW + (size_t)3456 * 2048 * 2, 128 * 2048 * 2, 128 * 2048 * 2, 1);
    zero_fill(ws + O_GUP + 256, 256, 512, 1024);
    { const int t = tidx(); if (blockIdx.x == 20) for (int i = t; i < 2 * D; i += NTHREADS) ((float*)(ws + O_CL))[i] = -8.0f * log1pf(expf(-p.in[26][i])); }
    GSYNC();
    if (fuse_ok) {
        xs_phase(BF(O_XNXS), XNP, MLAT);
        xs_ctx_phase((const float*)(ws + O_CTXX1), (const float*)(ws + O_CTXP2), p.in[10], mod, BF(O_XNXS));
    } else {
        norm_phase<true>(p.in[0], (const float*)(ws + O_CTXX1), MALL, p.in[10], mod, 3, 4, BF(O_XNXS), 2048, (const float*)(ws + O_CTXP2), X1B, XNP, 0);
        GSYNC();
        xs_phase(BF(O_XNXS), nullptr, MALL);
    }
    GSYNC();
    { S.init(MALL, 3584, gridDim.x, blockIdx.x); EpiRw E{BF(O_R), BF(O_LIN), BF(O_GD)}; pg8::gemm_phase(lds, mk_gemm(BF(O_XNXS), BF(O_RW), MALL, 3584, 2048, 2048, 2048), S, E); }
    { const int sh = ((MALL / 256) * 14) % (int)gridDim.x; S.init(MCTX, D, gridDim.x, ((int)blockIdx.x + (int)gridDim.x - sh) % (int)gridDim.x); EpiBf E{BF(O_PLXC), D};
      pg8::gemm_phase(lds, mk_gemm(BF(O_XNXS) + (size_t)MLAT * 2048, BF(O_LX), MCTX, D, D, 2048, D), S, E); }
    GSYNC();
    rncb_phase(BF(O_R), BF(O_K), p.in[18], p.in[20], (float*)(ws + O_RN), (float*)(ws + O_CB));
    cvt_run(p.in[11] + 4480, 7552, D, 3072, BF(O_LATE), D, CV_PLAIN, 0, nullptr, ldsf);
    cvt_run(p.in[23], D, D, D, BF(O_PRW), D, CV_PLAIN, 0, nullptr, ldsf);
    cvt_run(p.in[31], D, D, D, BF(O_PLRU), D, CV_PLAIN, 0, nullptr, ldsf);
    cvt_run(p.in[32], D, D, D, BF(O_WOUT), D, CV_PLAIN, 0, nullptr, ldsf);
    cvt_run(p.in[36], D, DFF, D, BF(O_DN2), DFF, CV_PLAIN, 0, nullptr, ldsf);
    GSYNC();
    rwkv_scan_phase(p, ldsf);
    GSYNC();
    if (gridDim.x == 256) {
        S.init(MLAT, D, gridDim.x, blockIdx.x); EpiPostG E{BF(O_YF), BF(O_YB), BF(O_V), (const float*)(ws + O_CB), p.in[21], p.in[22]};
        pg8::gemm_phase(lds, mk_gemm(BF(O_GD), BF(O_GUP), MLAT, D, 256, 256, 256), S, E);
    } else {
        post_phase(BF(O_YF), BF(O_YB), BF(O_V), (const float*)(ws + O_CB), p.in[21], p.in[22]);
        GSYNC();
        { S.init(MLAT, D, gridDim.x, blockIdx.x); EpiMul E{BF(O_YF), nullptr, 0}; pg8::gemm_phase(lds, mk_gemm(BF(O_GD), BF(O_GUP), MLAT, D, 256, 256, 256), S, E); }
    }
    { S.init(MLAT, D, gridDim.x, blockIdx.x); EpiBf E{BF(O_PLX), D}; pg8::gemm_phase(lds, mk_gemm(XNP, BF(O_LX), MLAT, D, D, D, D), S, E); }
    GSYNC();
    conv_phase(BF(O_PLX), BF(O_PLXC), BF(O_XC), p.in[24], p.in[25]);
    GSYNC();
    { S.init(MALL, 4096, gridDim.x, blockIdx.x); EpiLru E{BF(O_XC), BF(O_GRF), BF(O_UF), BF(O_GRB), BF(O_UB), p.in[28], p.in[30], (const float*)(ws + O_CL)};
      Gemm g = mk_gemm(BF(O_XC), BF(O_LRUW), MALL, 4096, 256, D, 256); g.ksh = 1; g.kmask = 3; g.kmul = 256; pg8::gemm_phase(lds, g, S, E); }
    GSYNC();
    lru_p1_phase(p);
    cvt_run(p.in[34], DFF, D, DFF, BF(O_UP2), D, CV_UPI, 0, nullptr, ldsf);
    cvt_run(p.in[35], DFF, D, DFF, BF(O_UP2), D, CV_UPI, 1, nullptr, ldsf);
    GSYNC();
    lru_p3_phase(p);
    GSYNC();
    { S.init(MLAT, 3072, gridDim.x, blockIdx.x); EpiLate E{BF(O_HSUM), BF(O_SMRW), BF(O_SMLRU)}; pg8::gemm_phase(lds, mk_gemm(XNP, BF(O_LATE), MLAT, 3072, D, D, D), S, E); }
    GSYNC();
    { S.init(MLAT, D, gridDim.x, blockIdx.x); EpiMul E{BF(O_SMRW), nullptr, 0}; pg8::gemm_phase(lds, mk_gemm(BF(O_YF), BF(O_PRW), MLAT, D, D, D, D), S, E); }
    { S.init(MLAT, D, gridDim.x, blockIdx.x); EpiMul E{BF(O_SMRW), BF(O_SMLRU), 1}; pg8::gemm_phase(lds, mk_gemm(BF(O_HSUM), BF(O_PLRU), MLAT, D, D, D, D), S, E); }
    GSYNC();
    if (gridDim.x == 256) {
        S.init(MLAT, D, gridDim.x, blockIdx.x); EpiOutNorm E{X1B, BF(O_X2B), BF(O_HN2), mod, p.in[33], RowX{(unsigned*)(ws + O_XSLOT_B), (unsigned*)(ws + O_XCNT_B)}};
        pg8::gemm_phase(lds, mk_gemm(BF(O_SMRW), BF(O_WOUT), MLAT, D, D, D, D), S, E);
        GSYNC();
    } else {
        { S.init(MLAT, D, gridDim.x, blockIdx.x); EpiRes<true, true> E{nullptr, X1B, nullptr, BF(O_X2B), mod, 5, 1.0f}; pg8::gemm_phase(lds, mk_gemm(BF(O_SMRW), BF(O_WOUT), MLAT, D, D, D, D), S, E); }
        GSYNC();
        norm_phase<true>(p.in[0], (const float*)(ws + O_CTXX1), MLAT, p.in[33], mod, 6, 7, BF(O_HN2), D, nullptr, BF(O_X2B));
        GSYNC();
    }
    { S.init(MLAT, 2 * DFF, gridDim.x, blockIdx.x); EpiUp E{BF(O_U2)}; pg8::gemm_phase(lds, mk_gemm(BF(O_HN2), BF(O_UP2), MLAT, 2 * DFF, D, D, D), S, E); }
    GSYNC();
    if (gridDim.x == 256) {
        S.init(MLAT, D, gridDim.x, blockIdx.x); EpiFinalNorm E{BF(O_X2B), p.out, mod, p.in[37], RowX{(unsigned*)(ws + O_XSLOT_A), (unsigned*)(ws + O_XCNT_A)}};
        pg8::gemm_phase(lds, mk_gemm(BF(O_U2), BF(O_DN2), MLAT, D, DFF, DFF, DFF), S, E);
    } else {
        { S.init(MLAT, D, gridDim.x, blockIdx.x); EpiRes<true, false> E{nullptr, BF(O_X2B), p.out, nullptr, mod, 8, 0.5f}; pg8::gemm_phase(lds, mk_gemm(BF(O_U2), BF(O_DN2), MLAT, D, DFF, DFF, DFF), S, E); }
        GSYNC();
        final_norm_phase(p.out, p.in[37]);
    }
}

extern "C" void kernel_launch(void* const* d_in, const int* in_sizes, int n_in, void* d_out, int out_size, void* d_ws, size_t ws_size, hipStream_t stream) {
    static int grid = 0;
    if (grid == 0) {
        if (n_in != 38 || out_size != MLAT * D || ws_size < WS_NEED) { fprintf(stderr, "kernel_launch: unexpected shapes (n_in %d, out %d, ws %zu); nothing launched\n", n_in, out_size, ws_size); grid = -1; return; }
        int dev = 0, cus = 0, per_cu = 0;
        hipGetDevice(&dev);
        hipDeviceGetAttribute(&cus, hipDeviceAttributeMultiprocessorCount, dev);
        if (hipFuncSetAttribute((const void*)mega, hipFuncAttributeMaxDynamicSharedMemorySize, LDS_BYTES) != hipSuccess) { fprintf(stderr, "kernel_launch: hipFuncSetAttribute failed\n"); grid = -1; return; }
        if (hipOccupancyMaxActiveBlocksPerMultiprocessor(&per_cu, (const void*)mega, NTHREADS, LDS_BYTES) != hipSuccess || per_cu < 1) { fprintf(stderr, "kernel_launch: occupancy query failed (%d)\n", per_cu); per_cu = 1; }
        (void)hipGetLastError();
        grid = cus * (per_cu > 1 ? 1 : per_cu);
    }
    if (grid < 0) return;
    Params p{};
    for (int i = 0; i < 38; ++i) p.in[i] = (const float*)d_in[i];
    p.out = (float*)d_out; p.ws = (unsigned char*)d_ws;
    if (hipMemsetAsync((unsigned char*)d_ws + O_BAR, 0, 65536, stream) != hipSuccess) { fprintf(stderr, "kernel_launch: memset failed\n"); return; }
    void* args[] = {&p};
    hipError_t e = hipLaunchCooperativeKernel((const void*)mega, dim3(grid), dim3(NTHREADS), args, LDS_BYTES, stream);
    if (e != hipSuccess) fprintf(stderr, "kernel_launch: cooperative launch failed: %s (grid %d)\n", hipGetErrorString(e), grid);
}
```
